# Optimizing an MI355X kernel written in HIP

```python
import math
import jax
import jax.numpy as jnp
from jax import lax
import numpy as np

D_MODEL = 1024
BATCH = 2
SEQ = 8192
DEPTH = 2

GRID_W = 64
CTX_LEN = 256
EPS = 1e-6

CONV_CH = 256
CONV_WIDTH = 31
GDN_HEADS = 4
GDN_DK = 64
GDN_DV = 64
GDN_WIDTH = GDN_HEADS * GDN_DV
GDN_QKV = 2 * GDN_HEADS * GDN_DK + GDN_WIDTH
SHORT_CONV = 5
GDN_CHUNK = 64
HEAD_DIM = 64
ATTN_Q_HEADS = 8
ATTN_KV_HEADS = 2
ATTN_GROUP = ATTN_Q_HEADS // ATTN_KV_HEADS
ATTN_WIDTH = ATTN_Q_HEADS * HEAD_DIM
Q_BLOCK = 128
ROPE_THETA = 10000.0
MIX_WIDTH = CONV_CH + GDN_WIDTH + ATTN_WIDTH
N_GROUPS = 4
EXPERTS_PER_GROUP = 8
N_EXPERTS = N_GROUPS * EXPERTS_PER_GROUP
TOP_K = 2
D_EXPERT = 512
MOE_BLOCK = 128

IN_SIZES = (GDN_QKV, 2 * GDN_HEADS, 2 * GDN_HEADS,
            ATTN_KV_HEADS * HEAD_DIM, ATTN_KV_HEADS * HEAD_DIM,
            CONV_CH, CONV_CH, GDN_WIDTH, ATTN_WIDTH)
CTX_STATE_COLS = GDN_QKV + 4 * GDN_HEADS + 2 * ATTN_KV_HEADS * HEAD_DIM
D_IN = CTX_STATE_COLS + 2 * CONV_CH + GDN_WIDTH + ATTN_WIDTH

kernel_name = "hybrid_conv_deltanet_gqa_hmoe_dit"


def split_cols(t, sizes):
    out, off = [], 0
    for s in sizes:
        out.append(t[..., off:off + s])
        off += s
    return out


def rms_norm(x, g):
    xf = x.astype(jnp.float32)
    y = xf * lax.rsqrt(jnp.mean(xf * xf, axis=-1, keepdims=True) + EPS)
    return (y * g.astype(jnp.float32)).astype(x.dtype)


def layer_norm(x, g, b):
    xf = x.astype(jnp.float32)
    mu = jnp.mean(xf, axis=-1, keepdims=True)
    xc = xf - mu
    y = xc * lax.rsqrt(jnp.mean(xc * xc, axis=-1, keepdims=True) + EPS)
    return (y * g.astype(jnp.float32) + b.astype(jnp.float32)).astype(x.dtype)


def l2_norm(x):
    return x * lax.rsqrt(jnp.sum(x * x, axis=-1, keepdims=True) + EPS)


def depthwise_conv(x, w):
    pad = w.shape[0] // 2
    return lax.conv_general_dilated(
        x, w[:, None, :].astype(x.dtype), window_strides=(1,), padding=[(pad, pad)],
        dimension_numbers=("NWC", "WIO", "NWC"), feature_group_count=x.shape[-1])


def axial_rope_tables(n_tokens):
    rows = n_tokens // GRID_W
    row = jnp.repeat(jnp.arange(rows), GRID_W).astype(jnp.float32)
    col = (jnp.arange(rows * GRID_W) % GRID_W).astype(jnp.float32)
    n_freq = HEAD_DIM // 4
    inv = ROPE_THETA ** (-jnp.arange(n_freq, dtype=jnp.float32) / n_freq)
    ang = jnp.concatenate([row[:, None] * inv, col[:, None] * inv], axis=-1)
    return jnp.cos(ang), jnp.sin(ang)


def apply_axial_rope(x, cos, sin):
    L = x.shape[1]
    xr = x.astype(jnp.float32).reshape(*x.shape[:-1], 2, 2, HEAD_DIM // 4)
    x1, x2 = xr[..., 0, :], xr[..., 1, :]
    c = cos.reshape(L, 2, HEAD_DIM // 4)[None, :, None]
    s = sin.reshape(L, 2, HEAD_DIM // 4)[None, :, None]
    out = jnp.stack([x1 * c - x2 * s, x2 * c + x1 * s], axis=-2)
    return out.reshape(x.shape).astype(x.dtype)


def conformer_conv(val, gate, dw_w, dw_b, ln_g, ln_b, pw_w, pw_b):
    h = val * jax.nn.sigmoid(gate)
    h = depthwise_conv(h, dw_w) + dw_b
    h = jax.nn.silu(layer_norm(h, ln_g, ln_b))
    return h @ pw_w + pw_b


def gdn_features(qkv, a_in, b_in, conv_w, a_log, dt_bias):
    B, L, _ = qkv.shape
    qkv = jax.nn.silu(depthwise_conv(qkv, conv_w)).astype(jnp.float32)
    q, k, v = split_cols(qkv, (GDN_HEADS * GDN_DK, GDN_HEADS * GDN_DK, GDN_WIDTH))
    q = l2_norm(q.reshape(B, L, GDN_HEADS, GDN_DK)) * (GDN_DK ** -0.5)
    k = l2_norm(k.reshape(B, L, GDN_HEADS, GDN_DK))
    v = v.reshape(B, L, GDN_HEADS, GDN_DV)
    a_in = a_in.astype(jnp.float32).reshape(B, L, 2, GDN_HEADS)
    b_in = b_in.astype(jnp.float32).reshape(B, L, 2, GDN_HEADS)
    g = -jnp.exp(a_log.astype(jnp.float32)) * jax.nn.softplus(a_in + dt_bias.astype(jnp.float32))
    beta = jax.nn.sigmoid(b_in)
    return q, k, v, g, beta


def gdn_direction(q, k, v, g, beta, s0, with_out):
    B, L, H, _ = q.shape
    dv = v.shape[-1]
    n = L // GDN_CHUNK

    def chunks(t):
        return jnp.moveaxis(t.reshape(B, n, GDN_CHUNK, H, *t.shape[3:]), 3, 1)

    q, k, v, g, beta = (chunks(t) for t in (q, k, v, g, beta))
    gam = jnp.cumsum(g, axis=-1)
    idx = jnp.arange(GDN_CHUNK)
    incl = idx[:, None] >= idx[None, :]
    strict = idx[:, None] > idx[None, :]
    decay = jnp.exp(jnp.where(incl, gam[..., :, None] - gam[..., None, :], -jnp.inf))
    kb = k * beta[..., None]
    a = jnp.where(strict, jnp.einsum("bhncd,bhnsd->bhncs", kb, k) * decay, 0.0)
    rhs = jnp.concatenate([v * beta[..., None], kb * jnp.exp(gam)[..., None]], axis=-1)
    sol = lax.linalg.triangular_solve(a, rhs, left_side=True, lower=True, unit_diagonal=True)
    u, w = sol[..., :dv], sol[..., dv:]
    last = gam[..., -1]
    kd = k * jnp.exp(last[..., None] - gam)[..., None]
    xs = [u, w, kd, jnp.exp(last)]
    if with_out:
        p = jnp.einsum("bhncd,bhnsd->bhncs", q, k) * decay
        xs += [p, q * jnp.exp(gam)[..., None]]
    xs = tuple(jnp.moveaxis(t, 2, 0) for t in xs)

    def step(s, inp):
        u_n, w_n, kd_n, gl_n = inp[:4]
        v_new = u_n - jnp.einsum("bhck,bhkv->bhcv", w_n, s)
        s_new = s * gl_n[..., None, None] + jnp.einsum("bhck,bhcv->bhkv", kd_n, v_new)
        if with_out:
            p_n, qg_n = inp[4:]
            o = jnp.einsum("bhck,bhkv->bhcv", qg_n, s) + jnp.einsum("bhcs,bhsv->bhcv", p_n, v_new)
            return s_new, o
        return s_new, None

    s_fin, o = lax.scan(step, s0, xs)
    if not with_out:
        return None, s_fin
    o = jnp.transpose(o, (1, 0, 3, 2, 4)).reshape(B, L, H, dv)
    return o, s_fin


def gdn_bidirectional(feats_c, feats_l, with_ctx_out):
    qc, kc, vc, gc, bc = feats_c
    ql, kl, vl, gl, bl = feats_l
    B = ql.shape[0]
    s0 = jnp.zeros((B, GDN_HEADS, GDN_DK, GDN_DV), jnp.float32)
    o_lat, o_ctx = 0.0, 0.0
    for d in range(2):
        flip = (lambda t: jnp.flip(t, axis=1)) if d == 1 else (lambda t: t)
        oc, sc = gdn_direction(flip(qc), flip(kc), flip(vc), flip(gc[:, :, d]), flip(bc[:, :, d]), s0, with_ctx_out)
        ol, _ = gdn_direction(flip(ql), flip(kl), flip(vl), flip(gl[:, :, d]), flip(bl[:, :, d]), sc, True)
        o_lat = o_lat + flip(ol)
        if with_ctx_out:
            o_ctx = o_ctx + flip(oc)
    return o_lat, (o_ctx if with_ctx_out else None)


def gdn_output(o, z, norm_g, dtype):
    B, L = o.shape[:2]
    zf = z.astype(jnp.float32).reshape(B, L, GDN_HEADS, GDN_DV)
    y = rms_norm(o, norm_g) * jax.nn.silu(zf)
    return y.reshape(B, L, GDN_WIDTH).astype(dtype)


def attend(qb, keys, vals):
    s = jnp.einsum("bqkgd,bskd->bkgqs", qb, keys, preferred_element_type=jnp.float32) * (HEAD_DIM ** -0.5)
    p = jax.nn.softmax(s, axis=-1)
    return jnp.einsum("bkgqs,bskd->bqkgd", p.astype(vals.dtype), vals)


def gqa_attention(q_l, k_l, v_l, q_c, k_c, v_c, q_norm_g, k_norm_g, cos, sin):
    B, L, _ = q_l.shape
    Lc = k_c.shape[1]

    def heads(t, h):
        return t.reshape(t.shape[0], t.shape[1], h, HEAD_DIM)

    ql = apply_axial_rope(rms_norm(heads(q_l, ATTN_Q_HEADS), q_norm_g), cos, sin)
    kl = apply_axial_rope(rms_norm(heads(k_l, ATTN_KV_HEADS), k_norm_g), cos, sin)
    kc = rms_norm(heads(k_c, ATTN_KV_HEADS), k_norm_g)
    vc = heads(v_c, ATTN_KV_HEADS)
    keys = jnp.concatenate([kc, kl], axis=1)
    vals = jnp.concatenate([vc, heads(v_l, ATTN_KV_HEADS)], axis=1)
    nb = L // Q_BLOCK
    qb = ql.reshape(B, nb, Q_BLOCK, ATTN_KV_HEADS, ATTN_GROUP, HEAD_DIM).transpose(1, 0, 2, 3, 4, 5)
    ob = lax.map(lambda t: attend(t, keys, vals), qb)
    o_l = ob.transpose(1, 0, 2, 3, 4, 5).reshape(B, L, ATTN_WIDTH)
    if q_c is None:
        return o_l, None
    qc = rms_norm(heads(q_c, ATTN_Q_HEADS), q_norm_g).reshape(B, Lc, ATTN_KV_HEADS, ATTN_GROUP, HEAD_DIM)
    o_c = attend(qc, kc, vc).reshape(B, Lc, ATTN_WIDTH)
    return o_l, o_c


def hierarchical_moe(x, wr_g, br_g, wr_e, br_e, w_gate, w_up, w_down):
    T, D = x.shape
    xf = x.astype(jnp.float32)
    pg = jax.nn.softmax(xf @ wr_g.astype(jnp.float32) + br_g.astype(jnp.float32), axis=-1)
    grp = jnp.argmax(pg, axis=-1)
    pg_sel = jnp.take_along_axis(pg, grp[:, None], axis=-1)
    le = (xf @ wr_e.astype(jnp.float32) + br_e.astype(jnp.float32)).reshape(T, N_GROUPS, EXPERTS_PER_GROUP)
    le = jnp.take_along_axis(le, grp[:, None, None], axis=1)[:, 0]
    top_p, top_i = lax.top_k(jax.nn.softmax(le, axis=-1), TOP_K)
    wts = pg_sel * top_p / jnp.sum(top_p, axis=-1, keepdims=True)
    eid = grp[:, None] * EXPERTS_PER_GROUP + top_i
    flat_e = eid.reshape(-1)
    flat_t = jnp.repeat(jnp.arange(T, dtype=jnp.int32), TOP_K)
    flat_w = wts.reshape(-1)
    order = jnp.argsort(flat_e)
    se, st, sw = flat_e[order], flat_t[order], flat_w[order]
    counts = jnp.bincount(flat_e, length=N_EXPERTS)
    starts = jnp.cumsum(counts) - counts
    pcounts = (counts + MOE_BLOCK - 1) // MOE_BLOCK * MOE_BLOCK
    pends = jnp.cumsum(pcounts)
    pstarts = pends - pcounts
    slot = pstarts[se] + jnp.arange(T * TOP_K) - starts[se]
    n_slots = -(-(T * TOP_K) // MOE_BLOCK) * MOE_BLOCK + N_EXPERTS * MOE_BLOCK
    slot_tok = jnp.full((n_slots,), T, jnp.int32).at[slot].set(st)
    slot_w = jnp.zeros((n_slots,), x.dtype).at[slot].set(sw.astype(x.dtype))
    nblk = n_slots // MOE_BLOCK
    blk_e = jnp.minimum(jnp.searchsorted(pends, jnp.arange(nblk) * MOE_BLOCK, side="right"), N_EXPERTS - 1)
    xpad = jnp.concatenate([x, jnp.zeros((1, D), x.dtype)], axis=0)
    xb = xpad[slot_tok].reshape(nblk, MOE_BLOCK, D)

    def expert_block(args):
        xe, e = args
        h = jax.nn.silu(xe @ w_gate[e]) * (xe @ w_up[e])
        return h @ w_down[e]

    yb = lax.map(expert_block, (xb, blk_e)).reshape(n_slots, D)
    out = jnp.zeros_like(xpad).at[slot_tok].add(yb * slot_w[:, None])
    return out[:T]


def trunk_layer(x, ctx, c, c_ctx, cos, sin, with_ctx_out,
                mod_w, mod_b, norm1_g, norm2_g, w_in,
                conv_dw_w, conv_dw_b, conv_ln_g, conv_ln_b, conv_pw_w, conv_pw_b,
                gdn_conv_w, gdn_a_log, gdn_dt_bias, gdn_norm_g,
                attn_q_norm_g, attn_k_norm_g, w_out,
                router_group_w, router_group_b, router_expert_w, router_expert_b,
                expert_w_gate, expert_w_up, expert_w_down):
    B, L, D = x.shape
    Lc = ctx.shape[1]
    mod_l = (jax.nn.silu(c) @ mod_w + mod_b)[:, None, :]
    mod_c = (jax.nn.silu(c_ctx) @ mod_w + mod_b)[None, None, :]
    sh1_l, sc1_l, g1_l, sh2_l, sc2_l, g2_l = split_cols(mod_l, (D,) * 6)
    sh1_c, sc1_c, g1_c, sh2_c, sc2_c, g2_c = split_cols(mod_c, (D,) * 6)

    h_l = rms_norm(x, norm1_g) * (1 + sc1_l) + sh1_l
    h_c = rms_norm(ctx, norm1_g) * (1 + sc1_c) + sh1_c
    qkv_l, a_l, b_l, k_l, v_l, gv_l, gg_l, z_l, q_l = split_cols(h_l @ w_in, IN_SIZES)
    if with_ctx_out:
        qkv_c, a_c, b_c, k_c, v_c, gv_c, gg_c, z_c, q_c = split_cols(h_c @ w_in, IN_SIZES)
    else:
        qkv_c, a_c, b_c, k_c, v_c = split_cols(h_c @ w_in[:, :CTX_STATE_COLS], IN_SIZES[:5])
        q_c = None

    conv_args = (conv_dw_w, conv_dw_b, conv_ln_g, conv_ln_b, conv_pw_w, conv_pw_b)
    conv_out_l = conformer_conv(gv_l, gg_l, *conv_args)
    feats_c = gdn_features(qkv_c, a_c, b_c, gdn_conv_w, gdn_a_log, gdn_dt_bias)
    feats_l = gdn_features(qkv_l, a_l, b_l, gdn_conv_w, gdn_a_log, gdn_dt_bias)
    o_gdn_l, o_gdn_c = gdn_bidirectional(feats_c, feats_l, with_ctx_out)
    gdn_out_l = gdn_output(o_gdn_l, z_l, gdn_norm_g, x.dtype)
    attn_l, attn_c = gqa_attention(q_l, k_l, v_l, q_c, k_c, v_c, attn_q_norm_g, attn_k_norm_g, cos, sin)
    x = x + g1_l * (jnp.concatenate([conv_out_l, gdn_out_l, attn_l], axis=-1) @ w_out)
    if with_ctx_out:
        conv_out_c = conformer_conv(gv_c, gg_c, *conv_args)
        gdn_out_c = gdn_output(o_gdn_c, z_c, gdn_norm_g, ctx.dtype)
        ctx = ctx + g1_c * (jnp.concatenate([conv_out_c, gdn_out_c, attn_c], axis=-1) @ w_out)

    moe_args = (router_group_w, router_group_b, router_expert_w, router_expert_b,
                expert_w_gate, expert_w_up, expert_w_down)
    h2_l = (rms_norm(x, norm2_g) * (1 + sc2_l) + sh2_l).reshape(B * L, D)
    if with_ctx_out:
        h2_c = (rms_norm(ctx, norm2_g) * (1 + sc2_c) + sh2_c).reshape(B * Lc, D)
        y = hierarchical_moe(jnp.concatenate([h2_l, h2_c], axis=0), *moe_args)
        x = x + g2_l * y[:B * L].reshape(B, L, D)
        ctx = ctx + g2_c * y[B * L:].reshape(B, Lc, D)
        return x, ctx
    y = hierarchical_moe(h2_l, *moe_args)
    return x + g2_l * y.reshape(B, L, D), None


def setup_inputs(seed: int = 0) -> dict:
    key = jax.random.key(seed)
    ks = jax.random.split(key, 32)
    f32 = jnp.float32
    D = D_MODEL

    def nrm(k, shape, scale):
        return jax.random.normal(k, shape, f32) * scale

    def gain(k, shape):
        return 1.0 + 0.1 * jax.random.normal(k, shape, f32)

    dt = jnp.exp(jax.random.uniform(ks[17], (DEPTH, 2, GDN_HEADS), f32, math.log(1e-3), math.log(1e-1)))
    return {
        "x": nrm(ks[0], (BATCH, SEQ, D), 1.0),
        "c": nrm(ks[1], (BATCH, D), 1.0),
        "ctx": nrm(ks[2], (BATCH, CTX_LEN, D), 1.0),
        "c_ctx": nrm(ks[3], (D,), 1.0),
        "mod_w": nrm(ks[4], (DEPTH, D, 6 * D), 0.5 * D ** -0.5),
        "mod_b": nrm(ks[5], (DEPTH, 6 * D), 0.02),
        "norm1_g": gain(ks[6], (DEPTH, D)),
        "norm2_g": gain(ks[7], (DEPTH, D)),
        "w_in": nrm(ks[8], (DEPTH, D, D_IN), D ** -0.5),
        "conv_dw_w": nrm(ks[9], (DEPTH, CONV_WIDTH, CONV_CH), CONV_WIDTH ** -0.5),
        "conv_dw_b": nrm(ks[10], (DEPTH, CONV_CH), 0.02),
        "conv_ln_g": gain(ks[11], (DEPTH, CONV_CH)),
        "conv_ln_b": nrm(ks[12], (DEPTH, CONV_CH), 0.02),
        "conv_pw_w": nrm(ks[13], (DEPTH, CONV_CH, CONV_CH), CONV_CH ** -0.5),
        "conv_pw_b": nrm(ks[14], (DEPTH, CONV_CH), 0.02),
        "gdn_conv_w": nrm(ks[15], (DEPTH, SHORT_CONV, GDN_QKV), SHORT_CONV ** -0.5),
        "gdn_a_log": jnp.log(jax.random.uniform(ks[16], (DEPTH, 2, GDN_HEADS), f32, 1.0, 16.0)),
        "gdn_dt_bias": dt + jnp.log(-jnp.expm1(-dt)),
        "gdn_norm_g": gain(ks[18], (DEPTH, GDN_DV)),
        "attn_q_norm_g": gain(ks[19], (DEPTH, HEAD_DIM)),
        "attn_k_norm_g": gain(ks[20], (DEPTH, HEAD_DIM)),
        "w_out": nrm(ks[21], (DEPTH, MIX_WIDTH, D), MIX_WIDTH ** -0.5),
        "router_group_w": nrm(ks[22], (DEPTH, D, N_GROUPS), D ** -0.5),
        "router_group_b": nrm(ks[23], (DEPTH, N_GROUPS), 0.01),
        "router_expert_w": nrm(ks[24], (DEPTH, D, N_EXPERTS), D ** -0.5),
        "router_expert_b": nrm(ks[25], (DEPTH, N_EXPERTS), 0.01),
        "expert_w_gate": nrm(ks[26], (DEPTH, N_EXPERTS, D, D_EXPERT), D ** -0.5),
        "expert_w_up": nrm(ks[27], (DEPTH, N_EXPERTS, D, D_EXPERT), D ** -0.5),
        "expert_w_down": nrm(ks[28], (DEPTH, N_EXPERTS, D_EXPERT, D), D_EXPERT ** -0.5),
        "final_norm_g": gain(ks[29], (D,)),
    }


def reference(x, c, ctx, c_ctx, mod_w, mod_b, norm1_g, norm2_g, w_in,
              conv_dw_w, conv_dw_b, conv_ln_g, conv_ln_b, conv_pw_w, conv_pw_b,
              gdn_conv_w, gdn_a_log, gdn_dt_bias, gdn_norm_g,
              attn_q_norm_g, attn_k_norm_g, w_out,
              router_group_w, router_group_b, router_expert_w, router_expert_b,
              expert_w_gate, expert_w_up, expert_w_down, final_norm_g):
    cos, sin = axial_rope_tables(x.shape[1])
    for layer in range(DEPTH):
        x, ctx = trunk_layer(
            x, ctx, c, c_ctx, cos, sin, layer < DEPTH - 1,
            mod_w[layer], mod_b[layer], norm1_g[layer], norm2_g[layer], w_in[layer],
            conv_dw_w[layer], conv_dw_b[layer], conv_ln_g[layer], conv_ln_b[layer],
            conv_pw_w[layer], conv_pw_b[layer],
            gdn_conv_w[layer], gdn_a_log[layer], gdn_dt_bias[layer], gdn_norm_g[layer],
            attn_q_norm_g[layer], attn_k_norm_g[layer], w_out[layer],
            router_group_w[layer], router_group_b[layer], router_expert_w[layer], router_expert_b[layer],
            expert_w_gate[layer], expert_w_up[layer], expert_w_down[layer])
    return rms_norm(x, final_norm_g)
```

```cpp
#include <hip/hip_runtime.h>
#include <hip/hip_bf16.h>
#include <hip/hip_cooperative_groups.h>
#include <cstdio>
#include <cstdint>
#include <cmath>
namespace cg = cooperative_groups;
__device__ __forceinline__ int opaque_tid() { int t = threadIdx.x; asm volatile("" : "+v"(t)); return t; }

namespace pg8 {
#define PG8_LAS __attribute__((address_space(3)))
typedef unsigned short bf16_t;
typedef short bf16x8 __attribute__((ext_vector_type(8)));
typedef float f32x4 __attribute__((ext_vector_type(4)));
typedef unsigned u32x4 __attribute__((ext_vector_type(4)));
constexpr int BM = 256, BK = 64, HALF = 128, HTB = HALF * BK * 2  , STAGE_BYTES = 8 * HTB, NXCD = 8, WGM = 8;

__host__ __device__ __forceinline__ int lds_byte(int r, int c) { const int st = (r >> 4) * 2 + (c >> 5), rr = r & 15, cc = c & 31, ob = rr * 64 + cc * 2; return st * 1024 + (ob ^ (((ob >> 9) & 1) << 5)); }
__host__ __device__ __forceinline__ void stage_rc(int b, int& R, int& C) { const int st = b / 1024, sb = b % 1024, swz = sb ^ (((sb >> 9) & 1) << 5); R = (st >> 1) * 16 + swz / 64; C = (st & 1) * 32 + (swz % 64) / 2; }
__host__ __device__ __forceinline__ int perm32(int rho) { const int n = rho >> 4, i = rho & 15; return 8 * (i >> 2) + 4 * n + (i & 3); }

struct Unit { int pm, pn, pc; };
struct Gemm { const bf16_t* A; const bf16_t* Bt; int M, N, K; const int* gather; };

struct StaticOrder {
    int nM, nN, nwg, G, c;
    __host__ __device__ void init(int M, int N, int G_, int c_) { nM = M / BM; nN = N / BM; nwg = nM * nN; G = G_; c = c_; }
    __host__ __device__ bool next(int i, Unit& u) const {
        if (c < 0) return false;
        const long L = (long)i * G + c; if (L >= nwg) return false;
        int wgid = (int)L; { const int q = nwg / NXCD, r = nwg % NXCD, xcd = wgid % NXCD, off = wgid / NXCD; wgid = (xcd < r ? xcd * (q + 1) : r * (q + 1) + (xcd - r) * q) + off; }
        const int nig = WGM * nN, gid = wgid / nig, fm = gid * WGM, gsz = (nM - fm) < WGM ? (nM - fm) : WGM;
        u.pm = fm + ((wgid % nig) % gsz); u.pn = (wgid % nig) / gsz; u.pc = u.pn; return true;
    }
    __device__ __forceinline__ void a_ready(const Unit&) const {}
    __device__ __forceinline__ void done(const Unit&) const {}
};
struct MoeOrder {
    const int* tile_expert; int ntiles, G, c;
    __device__ __forceinline__ bool next(int i, Unit& u) const {
        const long L = (long)i * G + c; if (L >= (long)ntiles * 4) return false;
        const int t = (int)(L >> 2), j = (int)(L & 3);
        const int e = __builtin_amdgcn_readfirstlane(__hip_atomic_load(tile_expert + t, __ATOMIC_RELAXED, __HIP_MEMORY_SCOPE_AGENT));
        u.pm = t; u.pn = e * 4 + j; u.pc = j; return true;
    }
    __device__ __forceinline__ void a_ready(const Unit&) const {}
    __device__ __forceinline__ void done(const Unit&) const {}
};

typedef float f32x2_t __attribute__((ext_vector_type(2))); typedef __bf16 bf16x2_t __attribute__((ext_vector_type(2)));
__device__ __forceinline__ unsigned cvt_pk_bf16(float lo, float hi) { f32x2_t v = {lo, hi}; bf16x2_t b = __builtin_convertvector(v, bf16x2_t); return __builtin_bit_cast(unsigned, b); }

template <bool BIAS> struct EpiBf16 {
    static constexpr bool PERM = true, AFTER_DRAIN = false;
    bf16_t* O; int ldc; const float* bias;
    __device__ __forceinline__ void init(f32x4 (&acc)[2][2][4][2], const Unit& u, int wr, int wc, int fr, int fq) const {
        const int col0 = u.pc * BM + wc * 32 + 8 * fq;
#pragma unroll
        for (int bj = 0; bj < 2; ++bj)
#pragma unroll
            for (int n = 0; n < 2; ++n) { const f32x4 b = BIAS ? *(const f32x4*)(bias + col0 + bj * HALF + 4 * n) : (f32x4){0.f, 0.f, 0.f, 0.f};
#pragma unroll
                for (int ai = 0; ai < 2; ++ai)
#pragma unroll
                    for (int m = 0; m < 4; ++m) acc[ai][bj][m][n] = b; }
    }
    __device__ __forceinline__ void operator()(const f32x4 (&acc)[2][2][4][2], const Unit& u, int wr, int wc, int fr, int fq) const {
        const int row0 = u.pm * BM + wr * 64 + fr; const int col0 = u.pc * BM + wc * 32 + 8 * fq;
#pragma unroll
        for (int ai = 0; ai < 2; ++ai)
#pragma unroll
            for (int m = 0; m < 4; ++m) { bf16_t* rowp = O + (size_t)(row0 + ai * HALF + m * 16) * ldc + col0;
#pragma unroll
                for (int bj = 0; bj < 2; ++bj) { const f32x4 v0 = acc[ai][bj][m][0], v1 = acc[ai][bj][m][1];
                    u32x4 w; w.x = cvt_pk_bf16(v0[0], v0[1]); w.y = cvt_pk_bf16(v0[2], v0[3]); w.z = cvt_pk_bf16(v1[0], v1[1]); w.w = cvt_pk_bf16(v1[2], v1[3]);
                    *(u32x4*)(rowp + bj * HALF) = w; } }
    }
};
__device__ __forceinline__ float silu_f(float x) { return x * __builtin_amdgcn_rcpf(1.0f + __builtin_amdgcn_exp2f(-1.4426950408889634f * x)); }
struct EpiSwiGLU {
    static constexpr bool PERM = true, AFTER_DRAIN = false;
    bf16_t* O; int ldc;
    __device__ __forceinline__ void init(f32x4 (&acc)[2][2][4][2], const Unit&, int, int, int, int) const {
#pragma unroll
        for (int a = 0; a < 2; ++a)
#pragma unroll
            for (int b = 0; b < 2; ++b)
#pragma unroll
                for (int m = 0; m < 4; ++m)
#pragma unroll
                    for (int n = 0; n < 2; ++n) acc[a][b][m][n] = (f32x4){0.f, 0.f, 0.f, 0.f};
    }
    __device__ __forceinline__ void operator()(const f32x4 (&acc)[2][2][4][2], const Unit& u, int wr, int wc, int fr, int fq) const {
        const int row0 = u.pm * BM + wr * 64 + fr; const int col0 = u.pc * HALF + wc * 32 + 8 * fq;
#pragma unroll
        for (int ai = 0; ai < 2; ++ai)
#pragma unroll
            for (int m = 0; m < 4; ++m) { bf16_t* rowp = O + (size_t)(row0 + ai * HALF + m * 16) * ldc + col0;
                const f32x4 g0 = acc[ai][0][m][0], g1 = acc[ai][0][m][1], u0 = acc[ai][1][m][0], u1 = acc[ai][1][m][1];
                u32x4 w; w.x = cvt_pk_bf16(silu_f(g0[0]) * u0[0], silu_f(g0[1]) * u0[1]); w.y = cvt_pk_bf16(silu_f(g0[2]) * u0[2], silu_f(g0[3]) * u0[3]);
                w.z = cvt_pk_bf16(silu_f(g1[0]) * u1[0], silu_f(g1[1]) * u1[1]); w.w = cvt_pk_bf16(silu_f(g1[2]) * u1[2], silu_f(g1[3]) * u1[3]);
                *(u32x4*)rowp = w; }
    }
};
template <bool BASE_F32> struct EpiResid {
    static constexpr bool PERM = true, AFTER_DRAIN = false;
    __device__ __forceinline__ void init(f32x4 (&acc)[2][2][4][2], const Unit&, int, int, int, int) const {
#pragma unroll
        for (int a = 0; a < 2; ++a)
#pragma unroll
            for (int b = 0; b < 2; ++b)
#pragma unroll
                for (int m = 0; m < 4; ++m)
#pragma unroll
                    for (int n = 0; n < 2; ++n) acc[a][b][m][n] = (f32x4){0.f, 0.f, 0.f, 0.f};
    }
    const void* base_l; const void* base_c; bf16_t* out_l; bf16_t* out_c; const float* gate;
    __device__ __forceinline__ void operator()(const f32x4 (&acc)[2][2][4][2], const Unit& u, int wr, int wc, int fr, int fq) const {
        const bool isc = u.pm >= 64; const int msel = isc ? 2 : (u.pm >> 5);
        const void* base = isc ? base_c : base_l; bf16_t* out = isc ? out_c : out_l; const int rbase = isc ? (u.pm - 64) * BM : u.pm * BM;
        const float* gp = gate + msel * 6144;
        const int col0 = u.pc * BM + wc * 32 + 8 * fq;
        f32x4 gv[2][2];
#pragma unroll
        for (int bj = 0; bj < 2; ++bj)
#pragma unroll
            for (int n = 0; n < 2; ++n) gv[bj][n] = *(const f32x4*)(gp + col0 + bj * HALF + 4 * n);
#pragma unroll
        for (int ai = 0; ai < 2; ++ai)
#pragma unroll
            for (int m = 0; m < 4; ++m) { const size_t off = (size_t)(rbase + ai * HALF + wr * 64 + m * 16 + fr) * 1024 + col0;
#pragma unroll
                for (int bj = 0; bj < 2; ++bj) { f32x4 b0, b1;
                    if constexpr (BASE_F32) { b0 = __builtin_nontemporal_load((const f32x4*)((const float*)base + off + bj * HALF)); b1 = __builtin_nontemporal_load((const f32x4*)((const float*)base + off + bj * HALF + 4)); }
                    else { const u32x4 w = *(const u32x4*)((const bf16_t*)base + off + bj * HALF);
                        b0 = (f32x4){__uint_as_float(w.x << 16), __uint_as_float(w.x & 0xffff0000u), __uint_as_float(w.y << 16), __uint_as_float(w.y & 0xffff0000u)};
                        b1 = (f32x4){__uint_as_float(w.z << 16), __uint_as_float(w.z & 0xffff0000u), __uint_as_float(w.w << 16), __uint_as_float(w.w & 0xffff0000u)}; }
                    const f32x4 v0 = b0 + gv[bj][0] * acc[ai][bj][m][0], v1 = b1 + gv[bj][1] * acc[ai][bj][m][1];
                    u32x4 o; o.x = cvt_pk_bf16(v0[0], v0[1]); o.y = cvt_pk_bf16(v0[2], v0[3]); o.z = cvt_pk_bf16(v1[0], v1[1]); o.w = cvt_pk_bf16(v1[2], v1[3]);
                    *(u32x4*)(out + off + bj * HALF) = o; } }
    }
};

template <class Epi, class Sched, bool ALIGN_EPI = false, bool SP2 = false, bool GATHER = false>
__device__ __forceinline__ void gemm_phase(PG8_LAS unsigned char* lds, const Gemm g, const Sched& S, const Epi& E) {
    const int tid = opaque_tid(), wid = __builtin_amdgcn_readfirstlane(tid >> 6), lane = tid & 63, wr = wid >> 2, wc = wid & 3, fr = lane & 15, fq = lane >> 4;
    const int K = g.K, nt = K / BK;
    unsigned voffA[2], voffB[2]; int Rr[2], Cc[2];
#pragma unroll
    for (int i = 0; i < 2; ++i) { int R, C; stage_rc(tid * 16 + i * 8192, R, C); const int Rb = Epi::PERM ? ((R & ~31) + perm32(R & 31)) : R; Rr[i] = R; Cc[i] = C;
        voffA[i] = (unsigned)(R * K + C) * 2u; voffB[i] = (unsigned)(Rb * K + C) * 2u; }
    const size_t kstep = (size_t)(BK * 2);
    const size_t hstep = (size_t)HALF * K * 2;
    const size_t tstep = 2 * hstep;
    const unsigned ldsw = (unsigned)wid * 1024u;
    const int aoff = lds_byte(wr * 64 + fr, fq * 8), boff = lds_byte(wc * 32 + fr, fq * 8);
#define PG8_SA(b, h) (((b) * 2 + (h)) * HTB)
#define PG8_SB(b, h) ((4 + (b) * 2 + (h)) * HTB)
#define PG8_STAGE(bufoff, gbase, voff) do { _Pragma("unroll") for (int _i = 0; _i < 2; ++_i) \
        __builtin_amdgcn_global_load_lds((const unsigned*)((const char*)(gbase) + (voff)[_i]), (PG8_LAS unsigned*)(lds + (bufoff) + ldsw + _i * 8192), 16, 0, 0); } while (0)
#define PG8_LDA(dst, b, h) do { _Pragma("unroll") for (int m = 0; m < 4; ++m) _Pragma("unroll") for (int k = 0; k < 2; ++k) dst[m][k] = *(const PG8_LAS bf16x8*)(lds + PG8_SA(b, h) + aoff + m * 2048 + k * 1024); } while (0)
#define PG8_LDB(dst, b, h) do { _Pragma("unroll") for (int n = 0; n < 2; ++n) _Pragma("unroll") for (int k = 0; k < 2; ++k) dst[n][k] = *(const PG8_LAS bf16x8*)(lds + PG8_SB(b, h) + boff + n * 2048 + k * 1024); } while (0)
#define PG8_MMA(ai, bj, At, Bt) do { __builtin_amdgcn_s_setprio(1); _Pragma("unroll") for (int m = 0; m < 4; ++m) _Pragma("unroll") for (int n = 0; n < 2; ++n) _Pragma("unroll") for (int k = 0; k < 2; ++k) \
        acc[ai][bj][m][n] = __builtin_amdgcn_mfma_f32_16x16x32_bf16(Bt[n][k], At[m][k], acc[ai][bj][m][n], 0, 0, 0); __builtin_amdgcn_s_setprio(0); } while (0)
#define PG8_WAIT_V(n) asm volatile("s_waitcnt vmcnt(" #n ")" ::: "memory")
#define PG8_WAIT_L(n) asm volatile("s_waitcnt lgkmcnt(" #n ")" ::: "memory")
#define PG8_BAR __builtin_amdgcn_s_barrier()
#define PG8_SCHED __builtin_amdgcn_sched_barrier(0)
    Unit cur, nxt; int ui = 0;
    if (!S.next(0, cur)) return;
    f32x4 acc[2][2][4][2];
    E.init(acc, cur, wr, wc, fr, fq);
    bf16x8 At[4][2], B0[2][2], B1[2][2];
    const char* cA = GATHER ? (const char*)g.A : (const char*)g.A + (size_t)cur.pm * tstep; const char* cB = (const char*)g.Bt + (size_t)cur.pn * tstep;
    unsigned cv0[2], cv1[2], nv0[2], nv1[2];
#pragma unroll
    for (int i = 0; i < 2; ++i) {
        if constexpr (GATHER) { cv0[i] = (unsigned)(g.gather[cur.pm * BM + Rr[i]] * K + Cc[i]) * 2u; cv1[i] = (unsigned)(g.gather[cur.pm * BM + HALF + Rr[i]] * K + Cc[i]) * 2u; }
        else { cv0[i] = voffA[i]; cv1[i] = voffA[i] + (unsigned)hstep; }
        nv0[i] = cv0[i]; nv1[i] = cv1[i]; }
    S.a_ready(cur);
    if constexpr (SP2) {
        PG8_STAGE(PG8_SB(0, 0), cB, voffB); PG8_STAGE(PG8_SB(0, 1), cB + hstep, voffB); PG8_STAGE(PG8_SA(0, 0), cA, cv0); PG8_STAGE(PG8_SA(0, 1), cA, cv1);
        if (wr == 1) PG8_BAR;
        PG8_WAIT_V(2); PG8_BAR;
        PG8_STAGE(PG8_SB(1, 0), cB + kstep, voffB); PG8_STAGE(PG8_SA(1, 0), cA + kstep, cv0); PG8_STAGE(PG8_SB(1, 1), cB + hstep + kstep, voffB);
        PG8_WAIT_V(6); PG8_BAR;
    } else {
        PG8_STAGE(PG8_SB(0, 0), cB, voffB); PG8_STAGE(PG8_SA(0, 0), cA, cv0); PG8_STAGE(PG8_SB(0, 1), cB + hstep, voffB); PG8_STAGE(PG8_SA(0, 1), cA, cv1);
        if (wr == 1) PG8_BAR;
        PG8_WAIT_V(4); PG8_BAR;
        PG8_STAGE(PG8_SB(1, 0), cB + kstep, voffB); PG8_STAGE(PG8_SA(1, 0), cA + kstep, cv0); PG8_STAGE(PG8_SB(1, 1), cB + hstep + kstep, voffB);
        PG8_WAIT_V(6); PG8_BAR;
    }
    for (;;) {
        const bool has_next = S.next(ui + 1, nxt);
        const char* nA = (has_next && !GATHER) ? (const char*)g.A + (size_t)nxt.pm * tstep : cA; const char* nB = has_next ? (const char*)g.Bt + (size_t)nxt.pn * tstep : cB;
        if constexpr (GATHER) { if (has_next) {
#pragma unroll
            for (int i = 0; i < 2; ++i) { nv0[i] = (unsigned)(g.gather[nxt.pm * BM + Rr[i]] * K + Cc[i]) * 2u; nv1[i] = (unsigned)(g.gather[nxt.pm * BM + HALF + Rr[i]] * K + Cc[i]) * 2u; } } }
        for (int t = 0; t < nt; t += 2) {
            const bool last = (t == nt - 2);
            const char* a1 = cA + (size_t)(t + 1) * kstep;
            const char* a2 = last ? nA : cA + (size_t)(t + 2) * kstep; const char* b2 = last ? nB : cB + (size_t)(t + 2) * kstep;
            const char* a3 = a2 + kstep; const char* b3 = b2 + kstep;
            unsigned sv0[2], sv1[2];
#pragma unroll
            for (int i = 0; i < 2; ++i) { sv0[i] = last ? nv0[i] : cv0[i]; sv1[i] = last ? nv1[i] : cv1[i]; }
            if (last && has_next) S.a_ready(nxt);
            if constexpr (SP2) {
            PG8_LDB(B0, 0, 0); PG8_LDB(B1, 0, 1); PG8_SCHED; PG8_LDA(At, 0, 0); PG8_STAGE(PG8_SA(1, 1), a1, cv1);
            PG8_WAIT_V(8); PG8_WAIT_L(0); PG8_BAR; PG8_MMA(0, 0, At, B0); PG8_MMA(0, 1, At, B1); PG8_BAR; PG8_SCHED;
            PG8_LDA(At, 0, 1); PG8_STAGE(PG8_SB(0, 0), b2, voffB); PG8_STAGE(PG8_SB(0, 1), b2 + hstep, voffB); PG8_STAGE(PG8_SA(0, 0), a2, sv0);
            PG8_WAIT_V(8); PG8_WAIT_L(0); PG8_BAR; PG8_MMA(1, 0, At, B0); PG8_MMA(1, 1, At, B1); PG8_BAR; PG8_SCHED;
            PG8_LDB(B0, 1, 0); PG8_LDB(B1, 1, 1); PG8_SCHED; PG8_LDA(At, 1, 0); PG8_STAGE(PG8_SA(0, 1), a2, sv1);
            PG8_WAIT_V(8); PG8_WAIT_L(0); PG8_BAR; PG8_MMA(0, 0, At, B0); PG8_MMA(0, 1, At, B1); PG8_BAR; PG8_SCHED;
            PG8_LDA(At, 1, 1); PG8_STAGE(PG8_SB(1, 0), b3, voffB); PG8_STAGE(PG8_SB(1, 1), b3 + hstep, voffB); PG8_STAGE(PG8_SA(1, 0), a3, sv0);
            PG8_WAIT_V(8); PG8_WAIT_L(0); PG8_BAR; PG8_MMA(1, 0, At, B0); PG8_MMA(1, 1, At, B1); PG8_BAR; PG8_SCHED;
            } else {
            PG8_LDB(B0, 0, 0); PG8_SCHED; PG8_LDA(At, 0, 0); PG8_STAGE(PG8_SA(1, 1), a1, cv1);
            PG8_WAIT_L(8); PG8_BAR; PG8_WAIT_L(0); PG8_MMA(0, 0, At, B0); PG8_BAR; PG8_SCHED;
            PG8_LDB(B1, 0, 1); PG8_STAGE(PG8_SB(0, 0), b2, voffB);
            PG8_BAR; PG8_WAIT_L(0); PG8_MMA(0, 1, At, B1); PG8_BAR;
            PG8_LDA(At, 0, 1); PG8_STAGE(PG8_SA(0, 0), a2, sv0);
            PG8_BAR; PG8_WAIT_L(0); PG8_MMA(1, 0, At, B0); PG8_BAR; PG8_SCHED;
            PG8_STAGE(PG8_SB(0, 1), b2 + hstep, voffB);
            PG8_WAIT_V(6); PG8_BAR; PG8_MMA(1, 1, At, B1); PG8_BAR;
            PG8_LDB(B0, 1, 0); PG8_SCHED; PG8_LDA(At, 1, 0); PG8_STAGE(PG8_SA(0, 1), a2, sv1);
            PG8_WAIT_L(8); PG8_BAR; PG8_WAIT_L(0); PG8_MMA(0, 0, At, B0); PG8_BAR; PG8_SCHED;
            PG8_LDB(B1, 1, 1); PG8_STAGE(PG8_SB(1, 0), b3, voffB);
            PG8_BAR; PG8_WAIT_L(0); PG8_MMA(0, 1, At, B1); PG8_BAR;
            PG8_LDA(At, 1, 1); PG8_STAGE(PG8_SA(1, 0), a3, sv0);
            PG8_BAR; PG8_WAIT_L(0); PG8_MMA(1, 0, At, B0); PG8_BAR; PG8_SCHED;
            PG8_STAGE(PG8_SB(1, 1), b3 + hstep, voffB);
            PG8_WAIT_V(6); PG8_BAR; PG8_MMA(1, 1, At, B1); PG8_BAR;
            }
        }
        if constexpr (ALIGN_EPI) { if (wr == 0) PG8_BAR; }
        if constexpr (!Epi::AFTER_DRAIN) { E(acc, cur, wr, wc, fr, fq); S.done(cur); }
        if (!has_next) break;
        E.init(acc, nxt, wr, wc, fr, fq);
        cur = nxt; cA = nA; cB = nB; ++ui;
#pragma unroll
        for (int i = 0; i < 2; ++i) { cv0[i] = nv0[i]; cv1[i] = nv1[i]; }
        if constexpr (ALIGN_EPI) { if (wr == 1) PG8_BAR; }
    }
    PG8_WAIT_V(0);
    if constexpr (!ALIGN_EPI) { if (wr == 0) PG8_BAR; }
    PG8_BAR;
    if constexpr (Epi::AFTER_DRAIN) { E.fused(acc, cur, wr, wc, fr, fq, lds, wid, lane); S.done(cur); }
#undef PG8_SA
#undef PG8_SB
#undef PG8_STAGE
#undef PG8_LDA
#undef PG8_LDB
#undef PG8_MMA
#undef PG8_WAIT_V
#undef PG8_WAIT_L
#undef PG8_BAR
#undef PG8_SCHED
}
}
namespace attn_body {
using bf16=__hip_bfloat16;
using bf16x8=__attribute__((ext_vector_type(8)))short;
using s16x4=__attribute__((ext_vector_type(4)))short;
using f32x16=__attribute__((ext_vector_type(16)))float;
using u32x4=__attribute__((ext_vector_type(4)))unsigned;
constexpr int D=64,QP=512,KP=128;
constexpr int NW=8,QBLK=32,QB=QBLK*NW,KVBLK=64;
constexpr int ATTN_UNIT_ROWS=QB;
__device__ __forceinline__ int crow(int r,int hi){return (r&3)+8*(r>>2)+4*hi;}
#define SBAR() __builtin_amdgcn_sched_barrier(0)
__device__ __forceinline__ void cmask(f32x16&p0,f32x16&p1,int jb,int qrel,int hi){
  const float NEG=-INFINITY; int kb=64*jb+4*hi;
  #pragma unroll
  for(int r=0;r<16;++r){int kv=kb+(r&3)+8*(r>>2); if(kv>qrel)p0[r]=NEG; if(kv+32>qrel)p1[r]=NEG;}
}

constexpr int NSLOT=3, SLOTB=8192;
constexpr int LDS_K=0, LDS_V=NSLOT*SLOTB, LDS_WS=2*NSLOT*SLOTB, LDS_OST=LDS_WS+NW*64*4, LDS_BYTES=LDS_OST+NW*4096;
constexpr float C2=0.125f*1.4426950408889634f;
__device__ __forceinline__ void glds16(const void*gsrc,unsigned lds_dst){unsigned keep;
  asm volatile("s_mov_b32 %0, m0\n\ts_mov_b32 m0, %2\n\ts_nop 0\n\tglobal_load_lds_dwordx4 %1, off\n\ts_mov_b32 m0, %0":"=&s"(keep):"v"(gsrc),"s"(lds_dst):"memory");}
__device__ __forceinline__ float max3f(float a,float b,float c){float r;asm("v_max3_f32 %0, %1, %2, %3":"=v"(r):"v"(a),"v"(b),"v"(c));return r;}
__device__ __forceinline__ float max2f(float a,float b){float r;asm("v_max_f32_e32 %0, %1, %2":"=v"(r):"v"(a),"v"(b));return r;}
__device__ __forceinline__ float fadd_s(float a,float b){float r;asm("v_add_f32_e32 %0, %1, %2":"=v"(r):"v"(a),"v"(b));return r;}
__device__ __forceinline__ float fsub_s(float a,float b){float r;asm("v_sub_f32_e32 %0, %1, %2":"=v"(r):"v"(a),"v"(b));return r;}
typedef float f32x2_t __attribute__((ext_vector_type(2))); typedef __bf16 bf16x2_t __attribute__((ext_vector_type(2)));
__device__ __forceinline__ unsigned cvtpk_s(float lo,float hi){f32x2_t v={lo,hi};bf16x2_t b=__builtin_convertvector(v,bf16x2_t);return __builtin_bit_cast(unsigned,b);}
#define WAIT_BAR(N) asm volatile("s_waitcnt vmcnt(" #N ") lgkmcnt(0)\n\ts_barrier":::"memory")

__device__ __forceinline__ void qkt(f32x16&p0,f32x16&p1,const char*Kslot,const bf16x8*qr,const f32x16&negm,int r32,int hi){
  const char*kb=Kslot+hi*1024+r32*16;
  #pragma unroll
  for(int d0=0;d0<4;++d0){
    const bf16x8 b0=*reinterpret_cast<const bf16x8*>(kb+d0*2048);
    const bf16x8 b1=*reinterpret_cast<const bf16x8*>(kb+d0*2048+512);
    if(d0==0){p0=__builtin_amdgcn_mfma_f32_32x32x16_bf16(b0,qr[0],negm,0,0,0);p1=__builtin_amdgcn_mfma_f32_32x32x16_bf16(b1,qr[0],negm,0,0,0);}
    else{p0=__builtin_amdgcn_mfma_f32_32x32x16_bf16(b0,qr[d0],p0,0,0,0);p1=__builtin_amdgcn_mfma_f32_32x32x16_bf16(b1,qr[d0],p1,0,0,0);}}
}
typedef __attribute__((address_space(3))) const char* lds_cptr;
typedef short v4i16_t __attribute__((ext_vector_type(4)));
__device__ __forceinline__ void kload8(bf16x8*kf,lds_cptr kp){
  kf[0]=*(const __attribute__((address_space(3))) bf16x8*)(kp);      kf[1]=*(const __attribute__((address_space(3))) bf16x8*)(kp+512);
  kf[2]=*(const __attribute__((address_space(3))) bf16x8*)(kp+2048); kf[3]=*(const __attribute__((address_space(3))) bf16x8*)(kp+2560);
  kf[4]=*(const __attribute__((address_space(3))) bf16x8*)(kp+4096); kf[5]=*(const __attribute__((address_space(3))) bf16x8*)(kp+4608);
  kf[6]=*(const __attribute__((address_space(3))) bf16x8*)(kp+6144); kf[7]=*(const __attribute__((address_space(3))) bf16x8*)(kp+6656);
}
__device__ __forceinline__ void kload2(bf16x8*kf,lds_cptr kp,int j){ kf[2*j]=*(const __attribute__((address_space(3))) bf16x8*)(kp+j*2048); kf[2*j+1]=*(const __attribute__((address_space(3))) bf16x8*)(kp+j*2048+512); }
__device__ __forceinline__ s16x4 vtr(lds_cptr p){ return __builtin_bit_cast(s16x4,__builtin_amdgcn_ds_read_tr16_b64_v4i16((__attribute__((address_space(3))) v4i16_t*)p)); }
__device__ __forceinline__ float rowmax(const f32x16&p0,const f32x16&p1){
  float a=max3f(p0[0],p0[1],p1[0]),b=max3f(p0[2],p0[3],p1[1]);a=max3f(a,p1[2],p1[3]);
  #pragma unroll
  for(int r=4;r<16;r+=4){a=max3f(a,p0[r],p0[r+1]);b=max3f(b,p0[r+2],p0[r+3]);a=max3f(a,p1[r],p1[r+1]);b=max3f(b,p1[r+2],p1[r+3]);}
  const float m=max2f(a,b);
  auto rr=__builtin_amdgcn_permlane32_swap(__float_as_uint(m),__float_as_uint(m),false,false);
  return max2f(__uint_as_float(rr[0]),__uint_as_float(rr[1]));
}
__device__ __forceinline__ void pv(f32x16*o,int vb,bf16x8 pa0,bf16x8 pa1,bf16x8 pa2,bf16x8 pa3){
  #pragma unroll
  for(int d0=0;d0<2;++d0){s16x4 lo[4],hi[4];
    #pragma unroll
    for(int ks=0;ks<4;++ks){
      asm volatile("ds_read_b64_tr_b16 %0,%1 offset:%c2":"=&v"(lo[ks]):"v"(vb),"i"(d0*4096+ks*1024):"memory");
      asm volatile("ds_read_b64_tr_b16 %0,%1 offset:%c2":"=&v"(hi[ks]):"v"(vb),"i"(d0*4096+ks*1024+512):"memory");}
    asm volatile("s_waitcnt lgkmcnt(0)":::"memory");SBAR();
    #define PK(k) (bf16x8){lo[k][0],lo[k][1],lo[k][2],lo[k][3],hi[k][0],hi[k][1],hi[k][2],hi[k][3]}
    o[d0]=__builtin_amdgcn_mfma_f32_32x32x16_bf16(pa0,PK(0),o[d0],0,0,0);
    o[d0]=__builtin_amdgcn_mfma_f32_32x32x16_bf16(pa1,PK(1),o[d0],0,0,0);
    o[d0]=__builtin_amdgcn_mfma_f32_32x32x16_bf16(pa2,PK(2),o[d0],0,0,0);
    o[d0]=__builtin_amdgcn_mfma_f32_32x32x16_bf16(pa3,PK(3),o[d0],0,0,0);
    #undef PK
  }
}

#ifndef ATTN_STORE16
#define ATTN_STORE16(p,v) (*(u32x4*)(p)=(v))
#endif
template<int THRL,int OP,bool NOMAX,int DV=0> __device__ __forceinline__ void attn_unit(const bf16*Qu,const bf16*Kh,const bf16*Vh,bf16*Ou,const int NT,char*shm,float*lse_out,const float M0){
  const int tid=opaque_tid(),lane=tid&63,r32=lane&31,hi=lane>>5; const int wid=__builtin_amdgcn_readfirstlane(tid>>6);
  const bf16*Qw=Qu+(long)(wid*QBLK)*QP;
  const unsigned lds0=(unsigned)(uintptr_t)shm;
  float*wsf=(float*)(shm+LDS_WS)+wid*64;
  const bf16*ksrc=Kh+(long)lane*KP+wid*8;
  const bf16*vsrc=Vh+(long)(16*(wid&3)+(lane>>2))*KP+(wid>>2)*32+(lane&3)*8;
  const unsigned kdst=lds0+LDS_K+wid*1024, vdst=lds0+LDS_V+wid*1024;
  #define DMA_K(t,slot) glds16(ksrc+(long)(t)*KVBLK*KP,(unsigned)__builtin_amdgcn_readfirstlane(kdst+(slot)))
  #define DMA_V(t,slot) glds16(vsrc+(long)(t)*KVBLK*KP,(unsigned)__builtin_amdgcn_readfirstlane(vdst+(slot)))
  const int vb0=(int)(lds0+LDS_V)+((lane>>4)&1)*32+(lane&3)*8+(4*hi+((lane&15)>>2))*64;
  const char*Kbase=shm+LDS_K; bf16x8 kf[8];
  const lds_cptr shm3=(lds_cptr)shm; const lds_cptr kp0=shm3+LDS_K+hi*1024+r32*16; const lds_cptr vp0=shm3+LDS_V+((lane>>4)&1)*32+(lane&3)*8+(4*hi+((lane&15)>>2))*64;
  DMA_K(0,0);DMA_V(0,0);DMA_K(1,SLOTB);
  bf16x8 qr[4];
  #pragma unroll
  for(int d0=0;d0<4;++d0)qr[d0]=*reinterpret_cast<const bf16x8*>(&Qw[(long)r32*QP+d0*16+hi*8]);
  float mhat=NOMAX?M0:0.f,l_reg=0.f;f32x16 o[2];o[0]=f32x16{};o[1]=f32x16{};f32x16 negm=f32x16{};
  if(NOMAX){_Pragma("unroll") for(int r=0;r<16;++r)negm[r]=-M0;} asm volatile("":"+v"(negm));
  #define CMASK(P0,P1,t) do{}while(0)
  bool resc=false;
  #define START(P0,P1) do{ resc=false; \
    if(!NOMAX){ const float rm=rowmax(P0,P1); const float dl=rm; mhat=fadd_s(mhat,dl); \
      _Pragma("unroll") for(int r=0;r<16;++r){P0[r]=fsub_s(P0[r],dl);P1[r]=fsub_s(P1[r],dl);} \
      _Pragma("unroll") for(int r=0;r<16;++r)negm[r]=-mhat; asm volatile("":"+v"(negm)); } \
    _Pragma("unroll") for(int r=0;r<16;++r)P0[r]=__builtin_amdgcn_exp2f(P0[r]); }while(0)
  #define RESC() do{ if(!NOMAX&&resc){ asm volatile("s_waitcnt lgkmcnt(0)":::"memory"); \
      _Pragma("unroll") for(int d_=0;d_<2;++d_) _Pragma("unroll") for(int r=0;r<16;++r)o[d_][r]*=wsf[crow(r,hi)]; } }while(0)
  f32x16 pA0,pA1,pB0,pB1;
  int sl_prev=0,sl_cur=0,sl_next=SLOTB;
  #define ROT() do{sl_prev=sl_cur;sl_cur=sl_next;sl_next=(sl_next==(NSLOT-1)*SLOTB)?0:sl_next+SLOTB;}while(0)
  DMA_K(2,2*SLOTB);
  WAIT_BAR(3);
  qkt(pA0,pA1,Kbase,qr,negm,r32,hi);asm volatile("s_nop 15\n\ts_nop 7":"+v"(pA0),"+v"(pA1));CMASK(pA0,pA1,0);
  START(pA0,pA1);
  _Pragma("unroll") for(int r=0;r<16;++r)pA1[r]=__builtin_amdgcn_exp2f(pA1[r]);
  WAIT_BAR(0);
  DMA_K(3,0);DMA_V(1,SLOTB);
  ROT();
  kload8(kf,kp0+sl_cur);
  WAIT_BAR(2);
  s16x4 vlo[8],vhi[8]; u32x4 pw0,pw1,pw2,pw3;
  if(DV==5||DV==6){_Pragma("unroll") for(int i=0;i<8;++i){vlo[i]=(s16x4){kf[i][0],kf[i][1],kf[i][2],kf[i][3]};vhi[i]=(s16x4){kf[i][4],kf[i][5],kf[i][6],kf[i][7]};asm volatile("":"+v"(vlo[i]),"+v"(vhi[i]));}}
  #define PKW(P,B) cvtpk_s(P[B],P[B+1])
  #define PAF(k) __builtin_bit_cast(bf16x8,pw##k)
  #define VFR(i) (bf16x8){vlo[i][0],vlo[i][1],vlo[i][2],vlo[i][3],vhi[i][0],vhi[i][1],vhi[i][2],vhi[i][3]}
  #define PIN(x) asm volatile("":"+v"(x))
  #define MX3(a,b,c) __builtin_fmaxf(__builtin_fmaxf((a),(b)),(c))
  #define GAPA(MF,A0,A1,A2,A3,W0,W1,PW) do{ MF; if(DV!=2){sacc+=A0; sacc+=A1; sacc+=A2; sacc+=A3;} PIN(sacc); if(DV!=4){W0; W1;} PIN(PW); SBAR(); }while(0)
  #define EX(v) (DV==1?(v)*0.5f:__builtin_amdgcn_exp2f(v))
  #define GAPB(MF,X,B) do{ if(DV!=9){MF;} X[B]=EX(X[B]); X[B+1]=EX(X[B+1]); X[B+2]=EX(X[B+2]); X[B+3]=EX(X[B+3]); PIN(X); SBAR(); }while(0)
  #define VRD(i) do{ if(DV==5||DV==6)break; vlo[i]=vtr(vp_+(((i)>>2)*4096+((i)&3)*1024)); vhi[i]=vtr(vp_+(((i)>>2)*4096+((i)&3)*1024+512)); }while(0)
  #define KRD(G,j) do{ if((G)&&DV!=5&&DV!=8){ kload2(kf,kp0+sl_next,j); SBAR(); } }while(0)
  #define STEP(C0,C1,P0,P1,t,GK,GV,GL) do{ SBAR(); \
    const lds_cptr vp_=vp0+sl_prev; \
    VRD(0); SBAR(); float sacc=(P0[0]+P0[1]); \
    GAPA(C0=__builtin_amdgcn_mfma_f32_32x32x16_bf16(kf[0],qr[0],negm,0,0,0), P0[2],P0[3],P0[4],P0[5],     pw0[0]=PKW(P0,0), pw0[1]=PKW(P0,2), pw0); \
    VRD(4); SBAR(); GAPA(C1=__builtin_amdgcn_mfma_f32_32x32x16_bf16(kf[1],qr[0],negm,0,0,0), P0[6],P0[7],P0[8],P0[9],     pw0[2]=PKW(P0,4), pw0[3]=PKW(P0,6), pw0); \
    VRD(1); SBAR(); GAPA(C0=__builtin_amdgcn_mfma_f32_32x32x16_bf16(kf[2],qr[1],C0,0,0,0),   P0[10],P0[11],P0[12],P0[13], pw1[0]=PKW(P0,8), pw1[1]=PKW(P0,10), pw1); \
    VRD(5); SBAR(); GAPA(C1=__builtin_amdgcn_mfma_f32_32x32x16_bf16(kf[3],qr[1],C1,0,0,0),   P0[14],P0[15],P1[0],P1[1],   pw1[2]=PKW(P0,12),pw1[3]=PKW(P0,14), pw1); \
    VRD(2); SBAR(); GAPA(C0=__builtin_amdgcn_mfma_f32_32x32x16_bf16(kf[4],qr[2],C0,0,0,0),   P1[2],P1[3],P1[4],P1[5],     pw2[0]=PKW(P1,0), pw2[1]=PKW(P1,2), pw2); \
    VRD(6); SBAR(); GAPA(C1=__builtin_amdgcn_mfma_f32_32x32x16_bf16(kf[5],qr[2],C1,0,0,0),   P1[6],P1[7],P1[8],P1[9],     pw2[2]=PKW(P1,4), pw2[3]=PKW(P1,6), pw2); \
    VRD(3); SBAR(); GAPA(C0=__builtin_amdgcn_mfma_f32_32x32x16_bf16(kf[6],qr[3],C0,0,0,0),   P1[10],P1[11],P1[12],P1[13], pw3[0]=PKW(P1,8), pw3[1]=PKW(P1,10), pw3); \
    VRD(7); SBAR(); GAPA(C1=__builtin_amdgcn_mfma_f32_32x32x16_bf16(kf[7],qr[3],C1,0,0,0),   P1[14],P1[15],0.f,0.f,       pw3[2]=PKW(P1,12),pw3[3]=PKW(P1,14), pw3); \
    l_reg+=sacc; \
    if((GK)&&DV!=7){DMA_K((t)+3,sl_cur);} if((GV)&&DV!=7){DMA_V((t)+1,sl_next);} \
    CMASK(C0,C1,t); \
    if(!NOMAX){ float a=MX3(C0[0],C0[1],C1[0]),b=MX3(C0[2],C0[3],C1[1]); a=MX3(a,C1[2],C1[3]); \
      _Pragma("unroll") for(int r=4;r<16;r+=4){a=MX3(a,C0[r],C0[r+1]);b=MX3(b,C0[r+2],C0[r+3]);a=MX3(a,C1[r],C1[r+1]);b=MX3(b,C1[r+2],C1[r+3]);} \
      float rm=__builtin_fmaxf(a,b); { auto rr=__builtin_amdgcn_permlane32_swap(__float_as_uint(rm),__float_as_uint(rm),false,false); rm=__builtin_fmaxf(__uint_as_float(rr[0]),__uint_as_float(rr[1])); } \
      resc=false; \
      if(__builtin_expect(__any(rm>(float)THRL),0)){ const float dl=__builtin_fmaxf(rm,0.f); mhat+=dl; \
        _Pragma("unroll") for(int r=0;r<16;++r){C0[r]-=dl;C1[r]-=dl;} \
        _Pragma("unroll") for(int r=0;r<16;++r)negm[r]=-mhat; asm volatile("":"+v"(negm)); \
        const float f=__builtin_amdgcn_exp2f(-dl); l_reg*=f; if(hi==0)wsf[r32]=f; resc=true; } } \
    SBAR(); \
    GAPB(o[0]=__builtin_amdgcn_mfma_f32_32x32x16_bf16(PAF(0),VFR(0),o[0],0,0,0), C0,0); \
    GAPB(o[1]=__builtin_amdgcn_mfma_f32_32x32x16_bf16(PAF(0),VFR(4),o[1],0,0,0), C0,4); \
    KRD(GL,0); GAPB(o[0]=__builtin_amdgcn_mfma_f32_32x32x16_bf16(PAF(1),VFR(1),o[0],0,0,0), C0,8); \
    KRD(GL,1); GAPB(o[1]=__builtin_amdgcn_mfma_f32_32x32x16_bf16(PAF(1),VFR(5),o[1],0,0,0), C0,12); \
    KRD(GL,2); GAPB(o[0]=__builtin_amdgcn_mfma_f32_32x32x16_bf16(PAF(2),VFR(2),o[0],0,0,0), C1,0); \
    KRD(GL,3); GAPB(o[1]=__builtin_amdgcn_mfma_f32_32x32x16_bf16(PAF(2),VFR(6),o[1],0,0,0), C1,4); \
    GAPB(o[0]=__builtin_amdgcn_mfma_f32_32x32x16_bf16(PAF(3),VFR(3),o[0],0,0,0), C1,8); \
    GAPB(o[1]=__builtin_amdgcn_mfma_f32_32x32x16_bf16(PAF(3),VFR(7),o[1],0,0,0), C1,12); \
    }while(0)
  int t=1;
  #undef CMASK
  #define CMASK(P0,P1,t) do{}while(0)
  for(;t+5<NT;t+=2){
    STEP(pB0,pB1,pA0,pA1,t,true,true,true);     if(DV==3){asm volatile("s_waitcnt vmcnt(2) lgkmcnt(0)":::"memory");}else{WAIT_BAR(2);} RESC(); ROT();
    STEP(pA0,pA1,pB0,pB1,t+1,true,true,true);   if(DV==3){asm volatile("s_waitcnt vmcnt(2) lgkmcnt(0)":::"memory");}else{WAIT_BAR(2);} RESC(); ROT();
  }
  #undef CMASK
  #define CMASK(P0,P1,t) do{}while(0)
  #define ENDW(tt) do{ if((tt)+3<NT){WAIT_BAR(2);} else if((tt)+2<NT){WAIT_BAR(1);} else {WAIT_BAR(0);} }while(0)
  for(;t+1<NT;t+=2){
    STEP(pB0,pB1,pA0,pA1,t,(t+3<NT),(t+1<NT),(t+1<NT));       ENDW(t);   RESC(); ROT();
    STEP(pA0,pA1,pB0,pB1,t+1,(t+4<NT),(t+2<NT),(t+2<NT));     ENDW(t+1); RESC(); ROT();
  }
  STEP(pB0,pB1,pA0,pA1,NT-1,false,false,false); RESC();
  { float sacc=pB0[0]+pB0[1]; _Pragma("unroll") for(int r=2;r<16;++r)sacc+=pB0[r]; _Pragma("unroll") for(int r=0;r<16;++r)sacc+=pB1[r]; l_reg+=sacc;
    pw0=(u32x4){PKW(pB0,0),PKW(pB0,2),PKW(pB0,4),PKW(pB0,6)};pw1=(u32x4){PKW(pB0,8),PKW(pB0,10),PKW(pB0,12),PKW(pB0,14)};pw2=(u32x4){PKW(pB1,0),PKW(pB1,2),PKW(pB1,4),PKW(pB1,6)};pw3=(u32x4){PKW(pB1,8),PKW(pB1,10),PKW(pB1,12),PKW(pB1,14)};
    SBAR(); pv(o,vb0+sl_cur,PAF(0),PAF(1),PAF(2),PAF(3)); }
  #undef PKW
  #undef PAF
  #undef VFR
  #undef PIN
  #undef MX3
  #undef GAPA
  #undef GAPB
  #undef EX
  #undef VRD
  #undef KRD
  #undef STEP
  #undef ENDW
  {auto rr=__builtin_amdgcn_permlane32_swap(__float_as_uint(l_reg),__float_as_uint(l_reg),false,false);l_reg=__uint_as_float(rr[0])+__uint_as_float(rr[1]);}
  if(lse_out!=nullptr&&hi==0)lse_out[wid*QBLK+r32]=mhat+__log2f(l_reg);
  if(hi==0)wsf[32+r32]=l_reg;asm volatile("s_waitcnt lgkmcnt(0)":::"memory");
  float rli[16];
  #pragma unroll
  for(int r=0;r<16;++r)rli[r]=__builtin_amdgcn_rcpf(wsf[32+crow(r,hi)]);
  bf16*Ow=Ou+(long)(wid*QBLK)*OP;
  { bf16*stg=(bf16*)(shm+LDS_OST)+wid*2048;
    #pragma unroll
    for(int r=0;r<16;++r){const int orow=crow(r,hi);
      #pragma unroll
      for(int d0=0;d0<2;++d0)stg[orow*64+d0*32+r32]=__float2bfloat16(o[d0][r]*rli[r]);}
    asm volatile("s_waitcnt lgkmcnt(0)":::"memory");
    #pragma unroll
    for(int i=0;i<4;++i){const int row=i*8+(lane>>3),ch=lane&7; const u32x4 v=*(const u32x4*)(stg+row*64+ch*8); ATTN_STORE16(Ow+(long)row*OP+ch*8,v);} }
  asm volatile("s_waitcnt lgkmcnt(0)\n\ts_barrier":::"memory");
  #undef DMA_K
  #undef DMA_V
  #undef CMASK
  #undef START
  #undef RESC
  #undef ROT
}
constexpr int ATTN_LDS_BYTES=LDS_BYTES;
#undef SBAR
#undef WAIT_BAR
}

#define XLAS __attribute__((address_space(3)))
#define XB_TMO      128
#define XB_XCNT(j)  (256  + 64 * (j))
#define XB_XSUB(j)  (1280 + 64 * (j))
#define XB_XGEN(j)  (2304 + 64 * (j))
#define XB_TOP      3328
#define XB_TOPGEN   3392
#define XCD_BAR_WORDS 3456
#define XB_SPIN_CAP (1u << 18)

__device__ __forceinline__ unsigned xb_ld(unsigned* p)              { return __hip_atomic_load(p, __ATOMIC_RELAXED, __HIP_MEMORY_SCOPE_AGENT); }
__device__ __forceinline__ unsigned xb_add(unsigned* p, unsigned v) { return __hip_atomic_fetch_add(p, v, __ATOMIC_RELAXED, __HIP_MEMORY_SCOPE_AGENT); }
__device__ __forceinline__ unsigned xb_xcc_id() { return (unsigned)__builtin_amdgcn_s_getreg((3 << 11) | 20) & 0xFu; }
#define XB_SPIN(cond, bar) do { unsigned _sp = 0; while (cond) { __builtin_amdgcn_s_sleep(1); \
    if ((++_sp & 255u) == 0u) { if (xb_ld(&(bar)[XB_TMO])) break; if (_sp > XB_SPIN_CAP) { atomicAdd(&(bar)[XB_TMO], 1u); break; } } } } while (0)

struct XcdBarrier {
    unsigned* bar; unsigned x;
    volatile XLAS unsigned* st;
};

__device__ __forceinline__ XcdBarrier xcd_barrier_post(unsigned* bar, volatile XLAS unsigned* st) {
    XcdBarrier b; b.bar = bar; b.x = xb_xcc_id(); b.st = st;
    if (threadIdx.x == 0) (void)xb_add(&bar[XB_XCNT(b.x)], 1u);
    return b;
}
__device__ __forceinline__ void xcd_barrier_complete(unsigned* bar, unsigned x, unsigned& nloc, unsigned& nx) {
    const unsigned G = gridDim.x * gridDim.y * gridDim.z;
    unsigned sum, cnt, mine, sp = 0u;
    for (;;) {
        sum = 0u; cnt = 0u; mine = 0u;
#pragma unroll
        for (unsigned j = 0; j < 16; ++j) { const unsigned c = xb_ld(&bar[XB_XCNT(j)]); sum += c; cnt += (c > 0u) ? 1u : 0u; mine = (j == x) ? c : mine; }
        if (sum == G) break;
        __builtin_amdgcn_s_sleep(1);
        if ((++sp & 255u) == 0u) { if (xb_ld(&bar[XB_TMO])) break; if (sp > XB_SPIN_CAP) { atomicAdd(&bar[XB_TMO], 1u); break; } }
    }
    nloc = mine > 0u ? mine : 1u; nx = cnt > 0u ? cnt : 1u;
}

__device__ __forceinline__ void xcd_barrier(const XcdBarrier& b) {
    asm volatile("s_waitcnt vmcnt(0)" ::: "memory");
    __syncthreads();
    if (threadIdx.x == 0) {
        unsigned* bar = b.bar;
        __builtin_amdgcn_s_waitcnt(0);
        unsigned nloc = b.st[0], nx = b.st[1];
        if (nloc == 0u) { xcd_barrier_complete(bar, b.x, nloc, nx); b.st[0] = nloc; b.st[1] = nx; }
        const unsigned old = xb_add(&bar[XB_XSUB(b.x)], 1u);
        const unsigned gen = old / nloc;
        if (old + 1u == (gen + 1u) * nloc) {
            __builtin_amdgcn_fence(__ATOMIC_RELEASE, "agent");
            asm volatile("s_waitcnt vmcnt(0)" ::: "memory");
            const unsigned og = xb_add(&bar[XB_TOP], 1u);
            const unsigned tg = og / nx;
            if (og + 1u == (tg + 1u) * nx) xb_add(&bar[XB_TOPGEN], 1u);
            else XB_SPIN(xb_ld(&bar[XB_TOPGEN]) == tg, bar);
            __builtin_amdgcn_fence(__ATOMIC_ACQUIRE, "agent");
            xb_add(&bar[XB_XGEN(b.x)], 1u);
            asm volatile("s_waitcnt vmcnt(0)" ::: "memory");
        } else {
            XB_SPIN(xb_ld(&bar[XB_XGEN(b.x)]) == gen, bar);
            __builtin_amdgcn_fence(__ATOMIC_ACQUIRE, "agent");
            asm volatile("s_waitcnt vmcnt(0)" ::: "memory");
        }
    }
    __syncthreads();
}

constexpr int NWAVES = 8, NTHR = 512;
constexpr int DM = 1024, BATCH = 2, SEQ = 8192, CTXL = 256, NLAT = BATCH * SEQ, NCTX = BATCH * CTXL, NTOK = NLAT + NCTX;
constexpr int DIN = 2320, PN = 2304;
constexpr int PC_QKV = 0, PC_K = 768, PC_V = 896, PC_GV = 1024, PC_GG = 1280, PC_Z = 1536, PC_Q = 1792;
constexpr int KVROWS = CTXL + SEQ;
constexpr int NEXP = 32, DEXP = 512, NTILE_MAX = 164, NSLOT_MAX = NTILE_MAX * 256;
constexpr int NSCAN = 16, NSTEP = 132, GDN_ITEM_BYTES = 49152;
constexpr float EPS = 1e-6f;
constexpr float ATT_C2 = 0.125f * 1.4426950408889634f;
constexpr int ATT_NT = 132, ATT_SPLIT_MAIN = 96, ATT_SPLIT_PART = 12;

constexpr size_t MiB = 1u << 20, KiB = 1024;
constexpr size_t WS_CTL = 0, CTL_ZERO_BYTES = 32 * KiB;
constexpr size_t WS_MOD = 1 * MiB;
constexpr size_t WS_ROPE = 1 * MiB + 256 * KiB;
constexpr size_t WS_WGT = 1 * MiB + 320 * KiB;
constexpr size_t WS_WET = 1 * MiB + 512 * KiB;
constexpr size_t WS_GL = 1 * MiB + 768 * KiB;
constexpr size_t WS_WABT = 1 * MiB + 896 * KiB;
constexpr size_t WS_AB = 2 * MiB;
constexpr size_t WS_EID = 4 * MiB;
constexpr size_t WS_WTS = 4 * MiB + 256 * KiB;
constexpr size_t WS_SLOT = 4 * MiB + 512 * KiB;
constexpr size_t WS_STOK = 4 * MiB + 768 * KiB;
constexpr size_t WS_XCTX = 5 * MiB;
constexpr size_t WS_WIN = 8 * MiB;
constexpr size_t WS_WOUT = 17 * MiB;
constexpr size_t WS_WPW = 21 * MiB;
constexpr size_t WS_Q = 22 * MiB;
constexpr size_t WS_K = 39 * MiB, WS_V = 44 * MiB;
constexpr size_t WS_CF = 49 * MiB;
constexpr size_t WS_H = 58 * MiB;
constexpr size_t WS_OG = 92 * MiB;
constexpr size_t WS_P = 134 * MiB;
constexpr size_t WS_PARTO = 209 * MiB;
constexpr size_t WS_PARTL = 315 * MiB;
constexpr size_t WS_GDN = 216 * MiB;
constexpr size_t WS_WGU = 316 * MiB;
constexpr size_t WS_WD = 444 * MiB;
constexpr size_t WS_END = 508 * MiB;
constexpr int CW_CNT = 64;
constexpr int CW_CUR = 192;
constexpr int CW_NT = 320;
constexpr int CW_TE = 384;
constexpr int CW_CQ = 352;
constexpr int CW_BAR = 4096;

constexpr int RING_BYTES = 131072, MISC_OFF = RING_BYTES + 320, LDS_BYTES = 147456;

#define LAS __attribute__((address_space(3)))
typedef unsigned short bf16;
typedef unsigned v4u __attribute__((ext_vector_type(4)));
typedef unsigned v2u __attribute__((ext_vector_type(2)));
typedef float f32x4 __attribute__((ext_vector_type(4)));
typedef float f32x2 __attribute__((ext_vector_type(2)));
typedef short bf16x8 __attribute__((ext_vector_type(8)));
#define LDS_WAIT() asm volatile("s_waitcnt lgkmcnt(0)" ::: "memory")

__device__ __forceinline__ unsigned pk2(float lo, float hi) { return pg8::cvt_pk_bf16(lo, hi); }
__device__ __forceinline__ float bflo(unsigned u) { return __uint_as_float(u << 16); }
__device__ __forceinline__ float bfhi(unsigned u) { return __uint_as_float(u & 0xffff0000u); }
__device__ __forceinline__ f32x4 ld_bf4(const bf16* p) { const v2u w = *(const v2u*)p; return (f32x4){bflo(w.x), bfhi(w.x), bflo(w.y), bfhi(w.y)}; }
__device__ __forceinline__ void st_bf4(bf16* p, f32x4 v) { v2u w; w.x = pk2(v[0], v[1]); w.y = pk2(v[2], v[3]); *(v2u*)p = w; }
template <int CTRL> __device__ __forceinline__ float dpp_f(float v) { return __int_as_float(__builtin_amdgcn_mov_dpp(__float_as_int(v), CTRL, 0xF, 0xF, true)); }
__device__ __forceinline__ float grp16_sum(float v) { v += dpp_f<0xB1>(v); v += dpp_f<0x4E>(v); v += dpp_f<0x141>(v); v += dpp_f<0x140>(v); return v; }
__device__ __forceinline__ float wave_sum(float v) {
    v = grp16_sum(v);
    const int iv = __float_as_int(v);
    return (__int_as_float(__builtin_amdgcn_readlane(iv, 0)) + __int_as_float(__builtin_amdgcn_readlane(iv, 16))) + (__int_as_float(__builtin_amdgcn_readlane(iv, 32)) + __int_as_float(__builtin_amdgcn_readlane(iv, 48)));
}
__device__ __forceinline__ float fsigmoid(float x) { return __builtin_amdgcn_rcpf(1.0f + __builtin_amdgcn_exp2f(-1.4426950408889634f * x)); }
__device__ __forceinline__ float sigmoid_f(float x) { return 1.0f / (1.0f + expf(-x)); }
__device__ __forceinline__ float silu_acc(float x) { return x / (1.0f + expf(-x)); }
__device__ __forceinline__ float softplus_f(float x) { return x > 20.f ? x : log1pf(expf(x)); }
__device__ __forceinline__ float dot4(f32x4 a, f32x4 b) { return (a[0] * b[0] + a[1] * b[1]) + (a[2] * b[2] + a[3] * b[3]); }

struct Frame {
    LAS unsigned char* lds; unsigned char* lds_g;
    int tid, lane, wave, G, vcu, gw, NGW;
    float* out; unsigned char* ws;
};
struct Args { const float* in[30]; float* out; unsigned char* ws; int ph_lo, ph_hi; };
__device__ __forceinline__ void relane(Frame& F) { F.tid = opaque_tid(); F.lane = F.tid & 63; }
template <class T> __device__ __forceinline__ T* wsp(const Frame& F, size_t off) { return (T*)(F.ws + off); }
__device__ __forceinline__ int msel_of(int r) { return r < NLAT ? (r >> 13) : 2; }

__device__ __forceinline__ void tt_load(float (&w)[32], const float* Wt, int ldw, int lane) {
#pragma unroll
    for (int j = 0; j < 8; ++j) { const f32x4 x = __builtin_nontemporal_load((const f32x4*)(Wt + (size_t)(8 * j + (lane >> 3)) * ldw + (lane & 7) * 4)); w[4 * j] = x[0]; w[4 * j + 1] = x[1]; w[4 * j + 2] = x[2]; w[4 * j + 3] = x[3]; }
}
__device__ __forceinline__ void tt_store(const float (&w)[32], bf16* WTt, int ldwt, LAS float* scr, int lane) {
#pragma unroll
    for (int j = 0; j < 8; ++j)
#pragma unroll
        for (int e = 0; e < 4; ++e) scr[(8 * j + (lane >> 3)) * 33 + (lane & 7) * 4 + e] = w[4 * j + e];
    LDS_WAIT(); asm volatile("" ::: "memory");
    const int c = lane & 7;
#pragma unroll
    for (int j = 0; j < 4; ++j) { const int n = (lane >> 3) + 8 * j; const LAS float* s = scr + (8 * c) * 33 + n;
        v4u o; o.x = pk2(s[0 * 33], s[1 * 33]); o.y = pk2(s[2 * 33], s[3 * 33]); o.z = pk2(s[4 * 33], s[5 * 33]); o.w = pk2(s[6 * 33], s[7 * 33]);
        __builtin_nontemporal_store(o, (v4u*)(WTt + (size_t)n * ldwt + 8 * c)); }
    LDS_WAIT(); asm volatile("" ::: "memory");
}
__device__ __forceinline__ void transpose_tile(const float* Wt, int ldw, bf16* WTt, int ldwt, LAS float* scr, int lane) { float w[32]; tt_load(w, Wt, ldw, lane); tt_store(w, WTt, ldwt, scr, lane); }
__device__ __forceinline__ void sincos_d(double x, double& s, double& c) {
    const double TWO_PI_HI = 6.283185307179586232, TWO_PI_LO = 2.449293598294706414e-16;
    const double n = rint(x * 0.15915494309189534561);
    double r = fma(-n, TWO_PI_HI, x); r = fma(-n, TWO_PI_LO, r);
    const double r2 = r * r; double ss = 1.0, cc = 1.0;
#pragma unroll
    for (int k = 15; k >= 1; --k) { ss = 1.0 - ss * r2 * (1.0 / (double)((2 * k) * (2 * k + 1))); cc = 1.0 - cc * r2 * (1.0 / (double)((2 * k - 1) * (2 * k))); }
    s = r * ss; c = cc;
}
__device__ __forceinline__ void p0_prologue(Frame& F, const Args& A) {
    relane(F);
    LAS float* Lf = (LAS float*)F.lds;
    if (blockIdx.x < 192) {
        const int bt = blockIdx.x, l = bt / 96, cgp = bt % 96;
        LAS float* sc = Lf; LAS float* red = Lf + 3072;
        { float cv[6];
#pragma unroll
          for (int m = 0; m < 6; ++m) { const int idx = F.tid + NTHR * m, v = idx >> 10, k = idx & 1023; cv[m] = v < 2 ? A.in[1][v * 1024 + k] : A.in[3][k]; }
#pragma unroll
          for (int m = 0; m < 6; ++m) sc[F.tid + NTHR * m] = silu_acc(cv[m]); }
        __syncthreads();
        const float* mw = A.in[4] + (size_t)l * 1024 * 6144 + 64 * cgp + F.lane;
        float a0 = 0.f, a1 = 0.f, a2 = 0.f;
#pragma unroll 64
        for (int kk = 0; kk < 128; ++kk) { const int k = F.wave * 128 + kk; const float w = __builtin_nontemporal_load(mw + (size_t)k * 6144); a0 += sc[k] * w; a1 += sc[1024 + k] * w; a2 += sc[2048 + k] * w; }
        red[(F.wave * 3 + 0) * 64 + F.lane] = a0; red[(F.wave * 3 + 1) * 64 + F.lane] = a1; red[(F.wave * 3 + 2) * 64 + F.lane] = a2;
        __syncthreads();
        if (F.tid < 192) { const int v = F.tid >> 6, cc = F.tid & 63; float s = A.in[5][l * 6144 + 64 * cgp + cc];
#pragma unroll
            for (int w = 0; w < 8; ++w) s += red[(w * 3 + v) * 64 + cc];
            wsp<float>(F, WS_MOD)[(l * 3 + v) * 6144 + 64 * cgp + cc] = s; }
        __syncthreads();
    }
    {
        const int gt = blockIdx.x * NTHR + F.tid;
        if (gt < 2048) {
            const double INV[16] = {1.0, 5.6234132519034907e-01, 3.1622776601683794e-01, 1.7782794100389229e-01, 1.0e-01, 5.6234132519034911e-02, 3.1622776601683791e-02, 1.7782794100389229e-02,
                                    1.0e-02, 5.6234132519034910e-03, 3.1622776601683794e-03, 1.7782794100389228e-03, 1.0e-03, 5.6234132519034910e-04, 3.1622776601683794e-04, 1.7782794100389227e-04};
            const int pos = gt >> 4, f = gt & 15; double iv = INV[0];
#pragma unroll
            for (int q = 1; q < 16; ++q) iv = (f == q) ? INV[q] : iv;
            const float ang = (float)pos * (float)iv; double s, c; sincos_d((double)ang, s, c);
            float* rt = wsp<float>(F, WS_ROPE); rt[gt * 2] = (float)c; rt[gt * 2 + 1] = (float)s;
        }
        if (gt < 32768) { const int l = gt >> 14, c = (gt >> 10) & 15, k = gt & 1023; wsp<float>(F, WS_WABT)[gt] = A.in[8][((size_t)l * 1024 + k) * DIN + 768 + c]; }
        if (gt < 65536) { const int l = gt >> 15, e = (gt >> 10) & 31, k = gt & 1023; wsp<float>(F, WS_WET)[gt] = A.in[24][((size_t)l * 1024 + k) * 32 + e]; }
        else if (gt < 65536 + 8192) { const int i2 = gt - 65536, l = i2 >> 12, g = (i2 >> 10) & 3, k = i2 & 1023; wsp<float>(F, WS_WGT)[i2] = A.in[22][((size_t)l * 1024 + k) * 4 + g]; }
    }
    LAS float* scr = Lf + F.wave * 2112;
    constexpr int NI_IN = 2 * 16 * 72, NI_OUT = 2 * 16 * 32, NI_PW = 2 * 4 * 8;
    constexpr int NITEMS = NI_IN + NI_OUT + NI_PW;
    bf16* WIN = wsp<bf16>(F, WS_WIN); bf16* WOUT = wsp<bf16>(F, WS_WOUT); bf16* WPW = wsp<bf16>(F, WS_WPW);
    for (int it = F.gw; it < NITEMS; it += F.NGW) {
        int r = it; const float* src; bf16* dst; int ldw, ldwt;
        if (r < NI_IN) { const int l = r / 1152, q = r % 1152, kb = q / 72, nb = q % 72; const int sc = nb < 24 ? 32 * nb : 784 + 32 * (nb - 24), dr = nb < 24 ? 32 * nb : 768 + 32 * (nb - 24);
            src = A.in[8] + ((size_t)l * 1024 + 64 * kb) * DIN + sc; ldw = DIN; dst = WIN + ((size_t)l * PN + dr) * 1024 + 64 * kb; ldwt = 1024; }
        else if ((r -= NI_IN) < NI_OUT) { const int l = r / 512, q = r % 512, kb = q / 32, nb = q % 32;
            src = A.in[21] + ((size_t)l * 1024 + 64 * kb) * 1024 + 32 * nb; ldw = 1024; dst = WOUT + ((size_t)l * 1024 + 32 * nb) * 1024 + 64 * kb; ldwt = 1024; }
        else { r -= NI_OUT; const int l = r / 32, q = r % 32, kb = q / 8, nb = q % 8;
            src = A.in[13] + ((size_t)l * 256 + 64 * kb) * 256 + 32 * nb; ldw = 256; dst = WPW + ((size_t)l * 256 + 32 * nb) * 256 + 64 * kb; ldwt = 256; }
        transpose_tile(src, ldw, dst, ldwt, scr, F.lane);
    }
}
constexpr int CONV_ITEMS = 32 * 512 + 32 * 256, CONV_CHUNKS = CONV_ITEMS / 32;
__device__ __forceinline__ void convert_pull(Frame& F, const Args& A, int budget, int qlo, int qhi) {
    relane(F);
    LAS float* scr = (LAS float*)F.lds + F.wave * 2112;
    LAS int* box = (LAS int*)(F.lds + RING_BYTES + 8192);
    bf16* WGU = wsp<bf16>(F, WS_WGU); bf16* WD = wsp<bf16>(F, WS_WD); int* ctl = wsp<int>(F, WS_CTL);
    constexpr int NI_GU = 32 * 512;
    for (int kq = 0; kq < budget; ++kq) {
        if (F.tid == 0) { int c = -1, lw = qlo;
            for (; lw <= qhi; ++lw) { c = atomicAdd(ctl + CW_CQ + lw, 1); if (c < CONV_CHUNKS) break; c = -1; }
            box[0] = c; box[1] = lw; }
        __syncthreads();
        const int c = box[0], layer = box[1];
        if (c < 0) break;
#define EXP_ITEM(it_, src, dst, ldw, ldwt) do { int r = (it_); \
        if (r < NI_GU) { const int le = layer * 32 + r / 512, q = r % 512, which = q / 256, q2 = q % 256, kb = q2 / 16, nb = q2 % 16, n0 = 32 * nb, dr = 256 * (n0 >> 7) + (n0 & 127) + 128 * which; \
            src = (which ? A.in[27] : A.in[26]) + ((size_t)le * 1024 + 64 * kb) * 512 + n0; ldw = 512; dst = WGU + ((size_t)le * 1024 + dr) * 1024 + 64 * kb; ldwt = 1024; } \
        else { r -= NI_GU; const int le = layer * 32 + r / 256, q = r % 256, kb = q / 32, nb = q % 32; \
            src = A.in[28] + ((size_t)le * 512 + 64 * kb) * 1024 + 32 * nb; ldw = 1024; dst = WD + ((size_t)le * 1024 + 32 * nb) * 512 + 64 * kb; ldwt = 512; } } while (0)
        const int it0 = c * 32 + F.wave * 4;
        float wc[32], wn[32]; const float* src; bf16* dst; int ldw, ldwt;
        EXP_ITEM(it0, src, dst, ldw, ldwt); tt_load(wc, src, ldw, F.lane);
#pragma unroll 1
        for (int m = 0; m < 4; ++m) {
            const float* src2 = src; bf16* dst2 = dst; int ldw2 = ldw, ldwt2 = ldwt;
            if (m < 3) { EXP_ITEM(it0 + m + 1, src2, dst2, ldw2, ldwt2); tt_load(wn, src2, ldw2, F.lane); }
            tt_store(wc, dst, ldwt, scr, F.lane);
            if (m < 3) {
#pragma unroll
                for (int i = 0; i < 32; ++i) wc[i] = wn[i];
                dst = dst2; ldwt = ldwt2; }
        }
#undef EXP_ITEM
        __syncthreads();
    }
    __syncthreads();
}
__device__ __forceinline__ int my_units(int n, int G, int c) { return c < n ? (n - c + G - 1) / G : 0; }
__device__ __forceinline__ int max_units(int n, int G) { return (n + G - 1) / G; }

#ifndef MK_DRY_AB
#define MK_DRY_AB 1
#endif
#define ROW_RANGE(N_) const int RPW_ = ((N_) + F.NGW - 1) / F.NGW; const int rbeg_ = F.gw * RPW_, rend_ = (rbeg_ + RPW_ < (N_)) ? rbeg_ + RPW_ : (N_);
#define ROW_BATCH_LOOP for (int rb_ = rbeg_; rb_ < rend_; rb_ += 3) { int row[3]; bool valid[3]; _Pragma("unroll") for (int u = 0; u < 3; ++u) { valid[u] = rb_ + u < rend_; row[u] = valid[u] ? rb_ + u : rend_ - 1; }
#define ROW_BATCH_BEGIN(N_) ROW_RANGE(N_) ROW_BATCH_LOOP
#define ROW_BATCH_END }

__device__ __forceinline__ void phase_norm1(Frame& F, const Args& A, int layer, bool dry = false) {
    relane(F);
    LAS float* WabT = (LAS float*)F.lds;
    { const float* wsrc = wsp<float>(F, WS_WABT) + layer * 16384; f32x4 t[8];
#pragma unroll
      for (int m = 0; m < 8; ++m) t[m] = *(const f32x4*)(wsrc + 4 * (F.tid + NTHR * m));
#pragma unroll
      for (int m = 0; m < 8; ++m) *(LAS f32x4*)(WabT + 4 * (F.tid + NTHR * m)) = t[m]; }
    __syncthreads();
    const float* mod = wsp<float>(F, WS_MOD) + layer * 3 * 6144;
    const float* g1n = A.in[6] + layer * 1024;
    bf16* H = wsp<bf16>(F, WS_H); float* AB = wsp<float>(F, WS_AB);
    const float* modp = wsp<float>(F, WS_MOD);
    const int* SLOT = wsp<int>(F, WS_SLOT); const float* WTS = wsp<float>(F, WS_WTS); const bf16* Y = wsp<bf16>(F, WS_GDN);
    f32x4 gn4[4], sc4[4], sh4[4], g24[4]; int msc = -1;
#pragma unroll
    for (int j = 0; j < 4; ++j) gn4[j] = *(const f32x4*)(g1n + 4 * F.lane + 256 * j);
    ROW_RANGE(NTOK)
    int sl_all = 0; float wt_all = 0.f;
    if (layer == 1 && rbeg_ * 2 + F.lane < rend_ * 2) { sl_all = SLOT[rbeg_ * 2 + F.lane]; wt_all = WTS[rbeg_ * 2 + F.lane]; }
    ROW_BATCH_LOOP
        bf16* xr[3]; f32x4 v[3][4];
#pragma unroll
        for (int u = 0; u < 3; ++u) { const int r = row[u];
            if (layer == 0) { const float* xf = r < NLAT ? A.in[0] + (size_t)r * 1024 : A.in[2] + (size_t)(r - NLAT) * 1024; xr[u] = nullptr;
#pragma unroll
                for (int j = 0; j < 4; ++j) v[u][j] = __builtin_nontemporal_load((const f32x4*)(xf + 4 * F.lane + 256 * j)); }
            else { xr[u] = r < NLAT ? (bf16*)F.out + (size_t)r * 1024 : wsp<bf16>(F, WS_XCTX) + (size_t)(r - NLAT) * 1024;
#pragma unroll
                for (int j = 0; j < 4; ++j) v[u][j] = ld_bf4(xr[u] + 4 * F.lane + 256 * j); } }
        if (layer == 1) {
            v2u y0[3][4], y1[3][4]; float w0[3], w1[3];
#pragma unroll
            for (int u = 0; u < 3; ++u) { const int r = row[u]; const int li_ = (r - rbeg_) * 2; const int s0 = __builtin_amdgcn_readlane(sl_all, li_), s1 = __builtin_amdgcn_readlane(sl_all, li_ + 1);
                w0[u] = __int_as_float(__builtin_amdgcn_readlane(__float_as_int(wt_all), li_)); w1[u] = __int_as_float(__builtin_amdgcn_readlane(__float_as_int(wt_all), li_ + 1));
#pragma unroll
                for (int j = 0; j < 4; ++j) { const int k = 4 * F.lane + 256 * j; y0[u][j] = *(const v2u*)(Y + (size_t)s0 * 1024 + k); y1[u][j] = *(const v2u*)(Y + (size_t)s1 * 1024 + k); } }
#pragma unroll
            for (int u = 0; u < 3; ++u) { const float* g2 = modp + msel_of(row[u]) * 6144 + 5120;
#pragma unroll
                for (int j = 0; j < 4; ++j) g24[j] = *(const f32x4*)(g2 + 4 * F.lane + 256 * j);
#pragma unroll
                for (int j = 0; j < 4; ++j) { const int k = 4 * F.lane + 256 * j;
                    const f32x4 a0 = {bflo(y0[u][j].x), bfhi(y0[u][j].x), bflo(y0[u][j].y), bfhi(y0[u][j].y)}, a1 = {bflo(y1[u][j].x), bfhi(y1[u][j].x), bflo(y1[u][j].y), bfhi(y1[u][j].y)};
                    v[u][j] = v[u][j] + g24[j] * (a0 * w0[u] + a1 * w1[u]); if (valid[u] && !dry) st_bf4(xr[u] + k, v[u][j]); } }
        }
        f32x4 hv[3][4];
#pragma unroll
        for (int u = 0; u < 3; ++u) { const int r = row[u], ms = msel_of(r);
            float ss = 0.f;
#pragma unroll
            for (int j = 0; j < 4; ++j) ss += dot4(v[u][j], v[u][j]);
            const float rstd = rsqrtf(wave_sum(ss) * (1.0f / 1024.0f) + EPS);
            if (ms != msc) { msc = ms;
#pragma unroll
                for (int j = 0; j < 4; ++j) { sc4[j] = *(const f32x4*)(mod + ms * 6144 + 1024 + 4 * F.lane + 256 * j); sh4[j] = *(const f32x4*)(mod + ms * 6144 + 4 * F.lane + 256 * j); } }
#pragma unroll
            for (int j = 0; j < 4; ++j) { const int k = 4 * F.lane + 256 * j;
                hv[u][j] = v[u][j] * rstd * gn4[j] * (sc4[j] + 1.0f) + sh4[j]; if (!dry) st_bf4(H + (size_t)r * 1024 + k, hv[u][j]); } }
        if (!dry || MK_DRY_AB) {
            float m0 = 0.f, m1 = 0.f, m2 = 0.f;
#pragma unroll 2
            for (int c = 0; c < 16; ++c) { float a0 = 0.f, a1 = 0.f, a2 = 0.f;
#pragma unroll
                for (int j = 0; j < 4; ++j) { const f32x4 w = *(const LAS f32x4*)(WabT + c * 1024 + 4 * F.lane + 256 * j); a0 += dot4(hv[0][j], w); a1 += dot4(hv[1][j], w); a2 += dot4(hv[2][j], w); }
                a0 = wave_sum(a0); a1 = wave_sum(a1); a2 = wave_sum(a2);
                m0 = (F.lane == c) ? a0 : m0; m1 = (F.lane == c) ? a1 : m1; m2 = (F.lane == c) ? a2 : m2; }
            if (F.lane < 16 && !dry) { AB[(size_t)row[0] * 16 + F.lane] = m0; if (valid[1]) AB[(size_t)row[1] * 16 + F.lane] = m1; if (valid[2]) AB[(size_t)row[2] * 16 + F.lane] = m2; }
            if (dry) { asm volatile("" :: "v"(m0 + m1 + m2)); }
        }
    ROW_BATCH_END
}

__device__ __forceinline__ void phase_attn_prep(Frame& F, const Args& A, int layer) {
    relane(F);
    const bf16* P = wsp<bf16>(F, WS_P); bf16* Q = wsp<bf16>(F, WS_Q); bf16* K = wsp<bf16>(F, WS_K); bf16* V = wsp<bf16>(F, WS_V);
    const float* rope = wsp<float>(F, WS_ROPE);
    const int hl = F.lane >> 4, li = F.lane & 15, d0 = 4 * li;
    const f32x4 qg = *(const f32x4*)(A.in[19] + layer * 64 + d0), kg = *(const f32x4*)(A.in[20] + layer * 64 + d0);
    const int axis = li >> 3, half = (li >> 2) & 1, f0 = 4 * (li & 3);
    const int kvh = hl & 1; const bool isv = hl >= 2;
    ROW_BATCH_BEGIN(NTOK)
        v2u xq[3][2], xkv[3];
#pragma unroll
        for (int u = 0; u < 3; ++u) { const bf16* pr = P + (size_t)row[u] * PN;
            xq[u][0] = *(const v2u*)(pr + PC_Q + hl * 64 + d0); xq[u][1] = *(const v2u*)(pr + PC_Q + (4 + hl) * 64 + d0); xkv[u] = *(const v2u*)(pr + (isv ? PC_V : PC_K) + kvh * 64 + d0); }
#pragma unroll
        for (int u = 0; u < 3; ++u) { const int r = row[u];
            const bool lat = r < NLAT; const int t = lat ? (r & (SEQ - 1)) : ((r - NLAT) & (CTXL - 1)); const int b = lat ? (r >> 13) : ((r - NLAT) >> 8);
            f32x4 cs = {1.f, 1.f, 1.f, 1.f}, sn = {0.f, 0.f, 0.f, 0.f};
            if (lat) { const int pos = axis ? (t & 63) : (t >> 6); const float* rp = rope + (pos * 16 + f0) * 2;
                const f32x4 r0 = *(const f32x4*)rp, r1 = *(const f32x4*)(rp + 4); cs = (f32x4){r0[0], r0[2], r1[0], r1[2]}; sn = (f32x4){r0[1], r0[3], r1[1], r1[3]}; }
            if (lat || layer == 0) {
#pragma unroll
                for (int it = 0; it < 2; ++it) {
                    const int head = it * 4 + hl;
                    f32x4 x = {bflo(xq[u][it].x), bfhi(xq[u][it].x), bflo(xq[u][it].y), bfhi(xq[u][it].y)};
                    const float rstd = rsqrtf(grp16_sum(dot4(x, x)) * (1.0f / 64.0f) + EPS);
                    x = x * rstd * qg;
                    f32x4 xp; xp[0] = __shfl_xor(x[0], 4); xp[1] = __shfl_xor(x[1], 4); xp[2] = __shfl_xor(x[2], 4); xp[3] = __shfl_xor(x[3], 4);
                    const f32x4 o = half ? (x * cs + xp * sn) : (x * cs - xp * sn);
                    st_bf4(Q + (size_t)r * 512 + head * 64 + d0, o * ATT_C2);
                }
            }
            {
                const f32x4 x = {bflo(xkv[u].x), bfhi(xkv[u].x), bflo(xkv[u].y), bfhi(xkv[u].y)};
                const float rstd = rsqrtf(grp16_sum(dot4(x, x)) * (1.0f / 64.0f) + EPS);
                const f32x4 xk = x * rstd * kg;
                f32x4 xp; xp[0] = __shfl_xor(xk[0], 4); xp[1] = __shfl_xor(xk[1], 4); xp[2] = __shfl_xor(xk[2], 4); xp[3] = __shfl_xor(xk[3], 4);
                const f32x4 ok = half ? (xk * cs + xp * sn) : (xk * cs - xp * sn);
                const size_t krow = (size_t)b * KVROWS + (lat ? CTXL + t : t);
                st_bf4((isv ? V : K) + krow * 128 + kvh * 64 + d0, isv ? x : ok);
            } }
    ROW_BATCH_END
}

__device__ __forceinline__ void phase_conformer(Frame& F, const Args& A, int layer) {
    relane(F);
    LAS float* Gl = (LAS float*)F.lds;
    const bf16* P = wsp<bf16>(F, WS_P); bf16* CF = wsp<bf16>(F, WS_CF);
    const int ntile = layer == 0 ? 264 : 256;
    const int c = F.tid & 255, hf = F.tid >> 8;
    float wv[31];
#pragma unroll
    for (int j = 0; j < 31; ++j) wv[j] = A.in[9][((size_t)layer * 31 + j) * 256 + c];
    const float cb = A.in[10][layer * 256 + c];
    const f32x4 lg = *(const f32x4*)(A.in[11] + layer * 256 + 4 * F.lane), lb = *(const f32x4*)(A.in[12] + layer * 256 + 4 * F.lane);
    const int cskip = F.G > 64 ? 32 : 0;
    for (int tile = (int)blockIdx.x - cskip; tile < ntile; tile += F.G - cskip) {
        if (tile < 0) break;
        int sbase, slen, t0;
        if (tile < 256) { sbase = (tile >> 7) * SEQ; slen = SEQ; t0 = (tile & 127) * 64; } else { const int cc = tile - 256; sbase = NLAT + (cc >> 2) * CTXL; slen = CTXL; t0 = (cc & 3) * 64; }
        {
            v2u gv[12], gg[12];
#pragma unroll
            for (int m = 0; m < 12; ++m) { const int idx = F.tid + NTHR * m, i = idx >> 6, c4 = (idx & 63) * 4, t = t0 - 15 + i; gv[m] = (v2u){0u, 0u}; gg[m] = (v2u){0u, 0u};
                if (i < 94 && t >= 0 && t < slen) { const bf16* pr = P + (size_t)(sbase + t) * PN; gv[m] = *(const v2u*)(pr + PC_GV + c4); gg[m] = *(const v2u*)(pr + PC_GG + c4); } }
#pragma unroll
            for (int m = 0; m < 12; ++m) { const int idx = F.tid + NTHR * m, i = idx >> 6, c4 = (idx & 63) * 4;
                const f32x4 a = {bflo(gv[m].x), bfhi(gv[m].x), bflo(gv[m].y), bfhi(gv[m].y)}, g = {bflo(gg[m].x), bfhi(gg[m].x), bflo(gg[m].y), bfhi(gg[m].y)};
                if (i < 94) *(LAS f32x4*)(Gl + i * 256 + c4) = (f32x4){a[0] * fsigmoid(g[0]), a[1] * fsigmoid(g[1]), a[2] * fsigmoid(g[2]), a[3] * fsigmoid(g[3])}; }
        }
        __syncthreads();
        float o[32];
#pragma unroll
        for (int tt = 0; tt < 32; ++tt) o[tt] = cb;
#pragma unroll
        for (int tb = 0; tb < 4; ++tb) {
            float xw[38];
#pragma unroll
            for (int ii = 0; ii < 38; ++ii) xw[ii] = Gl[(hf * 32 + tb * 8 + ii) * 256 + c];
#pragma unroll
            for (int t8 = 0; t8 < 8; ++t8)
#pragma unroll
                for (int j = 0; j < 31; ++j) o[tb * 8 + t8] += xw[t8 + j] * wv[j];
        }
        __syncthreads();
#pragma unroll
        for (int tt = 0; tt < 32; ++tt) Gl[(hf * 32 + tt) * 256 + c] = o[tt];
        __syncthreads();
#pragma unroll
        for (int q = 0; q < 8; ++q) { const int tok = F.wave * 8 + q; const f32x4 x = *(const LAS f32x4*)(Gl + tok * 256 + 4 * F.lane);
            const float mean = wave_sum((x[0] + x[1]) + (x[2] + x[3])) * (1.0f / 256.0f); const f32x4 d = x - mean;
            const float rstd = rsqrtf(wave_sum(dot4(d, d)) * (1.0f / 256.0f) + EPS);
            f32x4 y = d * rstd * lg + lb; y = (f32x4){pg8::silu_f(y[0]), pg8::silu_f(y[1]), pg8::silu_f(y[2]), pg8::silu_f(y[3])};
            st_bf4(CF + (size_t)(sbase + t0 + tok) * 256 + 4 * F.lane, y); }
        __syncthreads();
    }
}

__device__ __forceinline__ float quad_bcast(float v, int q) { switch (q) { case 0: return dpp_f<0x00>(v); case 1: return dpp_f<0x55>(v); case 2: return dpp_f<0xAA>(v); default: return dpp_f<0xFF>(v); } }
#ifndef MK_GDN_REP
#define MK_GDN_REP -1
#endif
#define GREP(k) ((MK_GDN_REP == (k)) ? 2 : 1)
__device__ __forceinline__ float fexp(float x) { return __builtin_amdgcn_exp2f(x * 1.4426950408889634f); }
#define MFMA16P(a, b, c) __builtin_amdgcn_mfma_f32_16x16x32_bf16(a, b, c, 0, 0, 0)
__device__ __forceinline__ void phase_gdn_prep(Frame& F, const Args& A, int layer) {
    relane(F);
    LAS unsigned char* LB = F.lds;
    LAS float* feat = (LAS float*)LB;
    LAS float* KKm = (LAS float*)(LB + 49920);
    LAS float* QKm = (LAS float*)(LB + 66560);
    LAS float* Am = (LAS float*)(LB + 83200);
    LAS float* sm = (LAS float*)(LB + 115968);
    LAS unsigned char* VT = LB + 118016;
    LAS unsigned char* KT = LB + 133120;
    LAS float* raw = (LAS float*)(LB + 66560);
    LAS float* Tm = KKm;
    LAS unsigned char* Kb = LB + 83200; LAS unsigned char* Qb = LB + 92416;
    LAS unsigned char* TU = LB;
    const bf16* P = wsp<bf16>(F, WS_P); const float* AB = wsp<float>(F, WS_AB);
    unsigned char* GD = F.ws + WS_GDN; float* GLp = wsp<float>(F, WS_GL);
    const float* cw = A.in[15] + (size_t)layer * 5 * 768;
    const int lane = F.lane, wave = F.wave, l15 = lane & 15, g4 = lane >> 4;
    v2u pre[7]; float pa = 0.f, pb = 0.f;
#define GDN_ITEM_GEOM(item_) const int sc = (item_) >> 2, h = (item_) & 3; int b, n, sbase, slen, isctx; \
        if (sc < 256) { b = sc >> 7; n = sc & 127; sbase = b * SEQ; slen = SEQ; isctx = 0; } else { const int cc = sc - 256; b = cc >> 2; n = cc & 3; sbase = NLAT + b * CTXL; slen = CTXL; isctx = 1; } \
        const int t0 = 64 * n;
#define GDN_PREFETCH(item_) do { GDN_ITEM_GEOM(item_) (void)isctx; \
        _Pragma("unroll") for (int m = 0; m < 7; ++m) { const int idx = F.tid + NTHR * m; const int s = idx / (68 * 16), rem = idx % (68 * 16), i = rem >> 4, c4 = (rem & 15) * 4, t = t0 - 2 + i; \
            pre[m] = (v2u){0u, 0u}; if (idx < 3 * 68 * 16 && t >= 0 && t < slen) pre[m] = *(const v2u*)(P + (size_t)(sbase + t) * PN + s * 256 + h * 64 + c4); } \
        if (F.tid < 128) { const int d = F.tid >> 6, i = F.tid & 63, ti = d ? 63 - i : i; const size_t row = (size_t)sbase + t0 + ti; pa = AB[row * 16 + d * 4 + h]; pb = AB[row * 16 + 8 + d * 4 + h]; } } while (0)
    if ((int)blockIdx.x < 264 * 4) GDN_PREFETCH((int)blockIdx.x);
    for (int item = blockIdx.x; item < 264 * 4; item += F.G) {
        GDN_ITEM_GEOM(item) (void)slen;
        float cwr[3][5];
#pragma unroll
        for (int s = 0; s < 3; ++s)
#pragma unroll
            for (int j = 0; j < 5; ++j) cwr[s][j] = cw[j * 768 + s * 256 + h * 64 + (F.tid & 63)];
#pragma unroll
        for (int m = 0; m < 7; ++m) { const int idx = F.tid + NTHR * m; const int s = idx / (68 * 16), rem = idx % (68 * 16), i = rem >> 4, c4 = (rem & 15) * 4;
            if (idx < 3 * 68 * 16) *(LAS f32x4*)(raw + (s * 68 + i) * 64 + c4) = (f32x4){bflo(pre[m].x), bfhi(pre[m].x), bflo(pre[m].y), bfhi(pre[m].y)}; }
        const float ga = pa, gb2 = pb;
        __syncthreads();
        if (item + F.G < 264 * 4) GDN_PREFETCH(item + F.G);
        for (int rp_ = 0; rp_ < GREP(0); ++rp_) {
        { const int c = F.tid & 63, ib = F.tid >> 6;
#pragma unroll
            for (int s = 0; s < 3; ++s) { float xw[12];
#pragma unroll
                for (int ii = 0; ii < 12; ++ii) xw[ii] = raw[(s * 68 + 8 * ib + ii) * 64 + c];
#pragma unroll
                for (int t8 = 0; t8 < 8; ++t8) { float acc = 0.f;
#pragma unroll
                    for (int j = 0; j < 5; ++j) acc += xw[t8 + j] * cwr[s][j];
                    feat[(s * 64 + 8 * ib + t8) * 65 + c] = pg8::silu_f(acc); } } }
        __syncthreads();
        }
        for (int rp_ = 0; rp_ < GREP(1); ++rp_) {
#pragma unroll 4
        for (int q = 0; q < 16; ++q) { const int rid = wave * 16 + q, s = rid >> 6, i = rid & 63; const float x = feat[(s * 64 + i) * 65 + lane];
            const float scl = rsqrtf(wave_sum(x * x) + EPS) * (s == 0 ? 0.125f : 1.0f); feat[(s * 64 + i) * 65 + lane] = x * scl; }
        if (F.tid < 128) { const int d = F.tid >> 6, i = F.tid & 63;
            const float xg = ga + A.in[17][layer * 8 + d * 4 + h];
            float gsum = -fexp(A.in[16][layer * 8 + d * 4 + h]) * (xg > 20.f ? xg : __logf(1.0f + fexp(xg)));
#pragma unroll
            for (int o = 1; o < 64; o <<= 1) { const float up = __shfl_up(gsum, o); if (i >= o) gsum += up; }
            sm[d * 64 + i] = gsum; sm[128 + d * 64 + i] = fsigmoid(gb2); }
        __syncthreads();
        }
        for (int rp_ = 0; rp_ < GREP(2); ++rp_) {
        { const int t = F.tid >> 3, c8 = (F.tid & 7) * 8;
            float x[8];
#pragma unroll
            for (int e = 0; e < 8; ++e) x[e] = feat[(64 + t) * 65 + c8 + e];
            v4u o; o.x = pk2(x[0], x[1]); o.y = pk2(x[2], x[3]); o.z = pk2(x[4], x[5]); o.w = pk2(x[6], x[7]); *(LAS v4u*)(Kb + t * 144 + c8 * 2) = o;
#pragma unroll
            for (int e = 0; e < 8; ++e) x[e] = feat[t * 65 + c8 + e];
            o.x = pk2(x[0], x[1]); o.y = pk2(x[2], x[3]); o.z = pk2(x[4], x[5]); o.w = pk2(x[6], x[7]); *(LAS v4u*)(Qb + t * 144 + c8 * 2) = o;
            const int c = F.tid & 63, t8 = (F.tid >> 6) * 8;
#pragma unroll
            for (int e = 0; e < 8; ++e) x[e] = feat[(64 + t8 + e) * 65 + c];
            o.x = pk2(x[0], x[1]); o.y = pk2(x[2], x[3]); o.z = pk2(x[4], x[5]); o.w = pk2(x[6], x[7]); *(LAS v4u*)(KT + c * 144 + t8 * 2) = o;
#pragma unroll
            for (int e = 0; e < 8; ++e) x[e] = feat[(128 + t8 + e) * 65 + c];
            o.x = pk2(x[0], x[1]); o.y = pk2(x[2], x[3]); o.z = pk2(x[4], x[5]); o.w = pk2(x[6], x[7]); *(LAS v4u*)(VT + c * 144 + t8 * 2) = o; }
        __syncthreads();
        }
        for (int rp_ = 0; rp_ < GREP(3); ++rp_) {
        { const int m = wave >> 2, a = wave & 3; const LAS unsigned char* src = m ? Qb : Kb; LAS float* dst = m ? QKm : KKm;
            const bf16x8 fa0 = *(const LAS bf16x8*)(src + (16 * a + l15) * 144 + 16 * g4), fa1 = *(const LAS bf16x8*)(src + (16 * a + l15) * 144 + 64 + 16 * g4);
#pragma unroll
            for (int bq = 0; bq < 4; ++bq) { const bf16x8 fb0 = *(const LAS bf16x8*)(Kb + (16 * bq + l15) * 144 + 16 * g4), fb1 = *(const LAS bf16x8*)(Kb + (16 * bq + l15) * 144 + 64 + 16 * g4);
                f32x4 acc = MFMA16P(fa0, fb0, ((f32x4){0.f, 0.f, 0.f, 0.f})); acc = MFMA16P(fa1, fb1, acc);
#pragma unroll
                for (int r = 0; r < 4; ++r) dst[(16 * a + 4 * g4 + r) * 65 + 16 * bq + l15] = acc[r]; } }
        __syncthreads();
        }
        for (int rp_ = 0; rp_ < GREP(4); ++rp_) {
#pragma unroll
        for (int d = 0; d < 2; ++d) { const int i = lane, ti = d ? 63 - i : i; const float gi = sm[d * 64 + i], bi_ = sm[128 + d * 64 + i];
#pragma unroll
            for (int k = 0; k < 8; ++k) { const int j = wave + 8 * k, tj = d ? 63 - j : j;
                Am[d * 4096 + j * 64 + i] = (j < i) ? bi_ * KKm[ti * 65 + tj] * fexp(gi - sm[d * 64 + j]) : 0.f; } }
        if (F.tid < 128) sm[256 + F.tid] = sm[128 + F.tid] * fexp(sm[F.tid]);
        __syncthreads();
        }
        for (int rp_ = 0; rp_ < GREP(5); ++rp_) {
        const int ch = F.tid, frg = ch >> 6, itl = frg >> 1, sst = frg & 1, rowx = 16 * itl + l15, kA = 32 * sst + 4 * g4;
#pragma unroll 1
        for (int d = 0; d < 2; ++d) {
            const int step = isctx ? (d ? 3 - n : n) : 4 + (d ? 127 - n : n); const size_t itemid = (size_t)((b * 2 + d) * 4 + h) * NSTEP + step;
            unsigned char* gb = GD + itemid * GDN_ITEM_BYTES;
            const LAS float* gam = sm + d * 64; const float glast = gam[63], grow = gam[rowx], erow = fexp(grow);
            float vq[8], vk[8], vp[8];
#pragma unroll
            for (int j = 0; j < 8; ++j) { const int k = kA + (j & 3) + ((j >> 2) << 4);
                const int trow = d ? 63 - rowx : rowx, tk = d ? 63 - k : k; const float gk = gam[k];
                vq[j] = feat[trow * 65 + k] * erow;
                vk[j] = feat[(64 + tk) * 65 + rowx] * fexp(glast - gk);
                vp[j] = (k <= rowx) ? QKm[trow * 65 + tk] * fexp(grow - gk) : 0.f; }
            v4u o;
            o.x = pk2(vk[0], vk[1]); o.y = pk2(vk[2], vk[3]); o.z = pk2(vk[4], vk[5]); o.w = pk2(vk[6], vk[7]); *(v4u*)(gb + 8192 + ch * 16) = o;
            o.x = pk2(vq[0], vq[1]); o.y = pk2(vq[2], vq[3]); o.z = pk2(vq[4], vq[5]); o.w = pk2(vq[6], vq[7]); *(v4u*)(gb + 16384 + ch * 16) = o;
            o.x = pk2(vp[0], vp[1]); o.y = pk2(vp[2], vp[3]); o.z = pk2(vp[4], vp[5]); o.w = pk2(vp[6], vp[7]); *(v4u*)(gb + 24576 + ch * 16) = o;
            if (F.tid == 0) GLp[itemid] = fexp(glast);
        }
        __syncthreads();
        }
        for (int rp_ = 0; rp_ < GREP(6); ++rp_) {
        { LAS unsigned char* Ab = LB; LAS unsigned char* TTb = LB + 18432; LAS unsigned char* Dfr = LB + 36864;
#pragma unroll
            for (int d = 0; d < 2; ++d)
#pragma unroll
                for (int k = 0; k < 8; ++k) { const int j = wave + 8 * k; *(LAS unsigned short*)(Ab + d * 9216 + lane * 144 + j * 2) = (unsigned short)(pk2(Am[d * 4096 + j * 64 + lane], 0.f) & 0xffffu); }
            for (int idx = F.tid; idx < 2 * 64 * 4; idx += NTHR) { const int d = idx >> 8, col = (idx >> 2) & 63, rb = idx & 3;
                if (rb != (col >> 4)) { *(LAS v4u*)(TTb + d * 9216 + col * 144 + rb * 32) = (v4u){0u, 0u, 0u, 0u}; *(LAS v4u*)(TTb + d * 9216 + col * 144 + rb * 32 + 16) = (v4u){0u, 0u, 0u, 0u}; } }
            { const int d = F.tid >> 8, b = (F.tid >> 6) & 3, cc = (F.tid >> 2) & 15, q = F.tid & 3; const LAS float* At = Am + d * 4096;
                float tb[4];
#pragma unroll
                for (int e = 0; e < 4; ++e) tb[e] = (4 * q + e == cc) ? 1.0f : 0.0f;
#pragma unroll
                for (int rp = 0; rp < 15; ++rp) { const float val = quad_bcast(tb[rp & 3], rp >> 2); const f32x4 a = *(const LAS f32x4*)(At + (16 * b + rp) * 64 + 16 * b + 4 * q);
#pragma unroll
                    for (int e = 0; e < 4; ++e) { const float upd = tb[e] - a[e] * val; tb[e] = (4 * q + e > rp) ? upd : tb[e]; } }
                LAS float* Td = Tm + d * 4160;
#pragma unroll
                for (int e = 0; e < 4; ++e) { const int r = 4 * q + e; Td[(16 * b + r) * 65 + 16 * b + cc] = tb[e];
                    LAS unsigned char* fr = Dfr + (size_t)(((d * 4 + b) * 64 + 16 * (cc >> 2) + r) * 16);
                    *(LAS unsigned short*)(fr + (cc & 3) * 2) = (unsigned short)(pk2(tb[e], 0.f) & 0xffffu);
                    if ((cc & 3) == 0) *(LAS v2u*)(fr + 8) = (v2u){0u, 0u}; }
                v2u o; o.x = pk2(tb[0], tb[1]); o.y = pk2(tb[2], tb[3]);
                *(LAS v2u*)(TTb + d * 9216 + (16 * b + cc) * 144 + (16 * b + 4 * q) * 2) = o; }
            { const int d = wave >> 2, cb = wave & 3; LAS float* Td = Tm + d * 4160;
#pragma unroll
                for (int bi = 0; bi < 3; ++bi) if (bi < cb) {
#pragma unroll
                    for (int r = 0; r < 4; ++r) Td[(16 * bi + 4 * g4 + r) * 65 + 16 * cb + l15] = 0.f; } }
            __syncthreads();
#pragma unroll
            for (int bi = 1; bi < 4; ++bi) {
                const int d = wave >> 2, cb = wave & 3;
                if (cb < bi) {
                    const LAS unsigned char* ap = Ab + d * 9216 + (16 * bi + l15) * 144 + 16 * g4; const LAS unsigned char* tp = TTb + d * 9216 + (16 * cb + l15) * 144 + 16 * g4;
                    f32x4 x = MFMA16P(*(const LAS bf16x8*)ap, *(const LAS bf16x8*)tp, ((f32x4){0.f, 0.f, 0.f, 0.f}));
                    if (bi == 3) x = MFMA16P(*(const LAS bf16x8*)(ap + 64), *(const LAS bf16x8*)(tp + 64), x);
                    v4u yb; yb.x = pk2(-x[0], -x[1]); yb.y = pk2(-x[2], -x[3]); yb.z = 0u; yb.w = 0u;
                    const bf16x8 df = *(const LAS bf16x8*)(Dfr + (size_t)(((d * 4 + bi) * 64 + lane) * 16));
                    const f32x4 tt = MFMA16P(df, __builtin_bit_cast(bf16x8, yb), ((f32x4){0.f, 0.f, 0.f, 0.f}));
                    LAS float* Td = Tm + d * 4160;
#pragma unroll
                    for (int r = 0; r < 4; ++r) Td[(16 * bi + 4 * g4 + r) * 65 + 16 * cb + l15] = tt[r];
                    v2u tw; tw.x = pk2(tt[0], tt[1]); tw.y = pk2(tt[2], tt[3]);
                    *(LAS v2u*)(TTb + d * 9216 + (16 * cb + l15) * 144 + (16 * bi + 4 * g4) * 2) = tw;
                }
                __syncthreads();
            }
        }
        }
        for (int rp_ = 0; rp_ < GREP(7); ++rp_) {
#pragma unroll
        for (int m = 0; m < 2; ++m) { const int q = F.tid + NTHR * m, d = q >> 9, i = (q >> 3) & 63, c8 = (q & 7) * 8; const LAS float* Td = Tm + d * 4160 + i * 65;
            float xu[8], xw[8];
#pragma unroll
            for (int e = 0; e < 8; ++e) { const int ip = d ? 63 - (c8 + e) : c8 + e; const float t = Td[ip]; xu[e] = t * sm[128 + d * 64 + ip]; xw[e] = t * sm[256 + d * 64 + ip]; }
            v4u o; o.x = pk2(xu[0], xu[1]); o.y = pk2(xu[2], xu[3]); o.z = pk2(xu[4], xu[5]); o.w = pk2(xu[6], xu[7]); *(LAS v4u*)(TU + d * 9216 + i * 144 + c8 * 2) = o;
            o.x = pk2(xw[0], xw[1]); o.y = pk2(xw[2], xw[3]); o.z = pk2(xw[4], xw[5]); o.w = pk2(xw[6], xw[7]); *(LAS v4u*)(TU + 18432 + d * 9216 + i * 144 + c8 * 2) = o; }
        __syncthreads();
        }
        for (int rp_ = 0; rp_ < GREP(8); ++rp_) {
        { const int d = wave >> 2, it = wave & 3;
            const int step = isctx ? (d ? 3 - n : n) : 4 + (d ? 127 - n : n); const size_t itemid = (size_t)((b * 2 + d) * 4 + h) * NSTEP + step;
            unsigned char* gb = GD + itemid * GDN_ITEM_BYTES;
            const LAS unsigned char* tu = TU + d * 9216 + (16 * it + l15) * 144 + 16 * g4; const LAS unsigned char* tw = TU + 18432 + d * 9216 + (16 * it + l15) * 144 + 16 * g4;
            const bf16x8 ta0 = *(const LAS bf16x8*)tu, ta1 = *(const LAS bf16x8*)(tu + 64), tw0 = *(const LAS bf16x8*)tw, tw1 = *(const LAS bf16x8*)(tw + 64);
#pragma unroll
            for (int sl = 0; sl < 4; ++sl) { const LAS unsigned char* vp = VT + (16 * sl + l15) * 144 + 16 * g4;
                f32x4 acc = MFMA16P(ta0, *(const LAS bf16x8*)vp, ((f32x4){0.f, 0.f, 0.f, 0.f})); acc = MFMA16P(ta1, *(const LAS bf16x8*)(vp + 64), acc);
                *(f32x4*)(gb + 32768 + (size_t)((it * 4 + sl) * 64 + lane) * 16) = acc; }
#pragma unroll
            for (int sp = 0; sp < 2; ++sp) { const LAS unsigned char* k0 = KT + (16 * (2 * sp) + l15) * 144 + 16 * g4; const LAS unsigned char* k1 = KT + (16 * (2 * sp + 1) + l15) * 144 + 16 * g4;
                f32x4 c0 = MFMA16P(*(const LAS bf16x8*)k0, tw0, ((f32x4){0.f, 0.f, 0.f, 0.f})); c0 = MFMA16P(*(const LAS bf16x8*)(k0 + 64), tw1, c0);
                f32x4 c1 = MFMA16P(*(const LAS bf16x8*)k1, tw0, ((f32x4){0.f, 0.f, 0.f, 0.f})); c1 = MFMA16P(*(const LAS bf16x8*)(k1 + 64), tw1, c1);
                v4u o; o.x = pk2(-c0[0], -c0[1]); o.y = pk2(-c0[2], -c0[3]); o.z = pk2(-c1[0], -c1[1]); o.w = pk2(-c1[2], -c1[3]);
                *(v4u*)(gb + (size_t)((it * 2 + sp) * 64 + lane) * 16) = o; } }
        __syncthreads();
        }
    }
}

#undef GDN_PREFETCH
#undef GDN_ITEM_GEOM
__device__ __forceinline__ bf16x8 pack_tiles(f32x4 t0, f32x4 t1) { v4u o; o.x = pk2(t0[0], t0[1]); o.y = pk2(t0[2], t0[3]); o.z = pk2(t1[0], t1[1]); o.w = pk2(t1[2], t1[3]); return __builtin_bit_cast(bf16x8, o); }
#define MFMA16(a, b, c) __builtin_amdgcn_mfma_f32_16x16x32_bf16(a, b, c, 0, 0, 0)
constexpr int SCAN_SLOT = 20480, SCAN_NSLOT = 6, SCAN_AHEAD = 5, NSCANBLK = NSCAN * 4;
__device__ __forceinline__ void phase_gdn_scan(Frame& F, const Args& A, int layer) {
    relane(F);
    const int xq_ = (int)blockIdx.x >> 3, bd = ((int)blockIdx.x & 7) + 8 * (xq_ >> 2), sl = xq_ & 3, lane = F.lane, wave = F.wave;
    const unsigned char* gbase = F.ws + WS_GDN + (size_t)bd * NSTEP * GDN_ITEM_BYTES;
    unsigned char* svb = F.ws + WS_OG + (size_t)bd * NSTEP * 16384;
    LAS unsigned char* ring = F.lds;
    LAS float* glL = (LAS float*)(F.lds + RING_BYTES + 1024);
    for (int i = F.tid; i < NSTEP; i += NTHR) glL[i] = wsp<float>(F, WS_GL)[bd * NSTEP + i];
    const bool loader = wave >= 1; const int lw = wave - 1;
#define SCAN_ISSUE(stp) do { LAS unsigned char* sb_ = ring + ((stp) % SCAN_NSLOT) * SCAN_SLOT; const unsigned char* gb_ = gbase + (size_t)(stp) * GDN_ITEM_BYTES + lane * 16; \
        _Pragma("unroll") for (int q_ = 0; q_ < 3; ++q_) { const int p0_ = lw * 3 + q_, p_ = p0_ < 20 ? p0_ : 19;   \
            __builtin_amdgcn_global_load_lds((const unsigned*)(gb_ + (p_ < 16 ? p_ * 1024 : 32768 + ((p_ - 16) * 4 + sl) * 1024)), (LAS unsigned*)(sb_ + p_ * 1024), 16, 0, 0); } } while (0)
    if (loader) { SCAN_ISSUE(0); SCAN_ISSUE(1); SCAN_ISSUE(2); SCAN_ISSUE(3); SCAN_ISSUE(4); }
    f32x4 S[4];
#pragma unroll
    for (int j = 0; j < 4; ++j) S[j] = (f32x4){0.f, 0.f, 0.f, 0.f};
    bf16x8 wfA[4][2], kfA[4][2], wfB[4][2], kfB[4][2]; f32x4 vnA[4], vnB[4]; float glA = 0.f, glB = 0.f;
    asm volatile("s_waitcnt lgkmcnt(0)" ::: "memory");
#define SCAN_SYNC(n_) do { if ((n_) < NSTEP) { \
        if (loader) { const int rem = NSTEP - 1 - (n_); \
            if (rem >= 4) asm volatile("s_waitcnt vmcnt(12)" ::: "memory"); else if (rem == 3) asm volatile("s_waitcnt vmcnt(9)" ::: "memory"); else if (rem == 2) asm volatile("s_waitcnt vmcnt(6)" ::: "memory"); \
            else if (rem == 1) asm volatile("s_waitcnt vmcnt(3)" ::: "memory"); else asm volatile("s_waitcnt vmcnt(0)" ::: "memory"); } \
        asm volatile("s_waitcnt lgkmcnt(0)" ::: "memory"); __builtin_amdgcn_s_barrier(); asm volatile("" ::: "memory"); \
        if (loader) { if ((n_) + SCAN_AHEAD < NSTEP) SCAN_ISSUE((n_) + SCAN_AHEAD); } } } while (0)
#define SCAN_READ(n_, WF, KF, VN, GL) do { if ((n_) < NSTEP) { const LAS unsigned char* slot = ring + ((n_) % SCAN_NSLOT) * SCAN_SLOT + lane * 16; \
        _Pragma("unroll") for (int i = 0; i < 4; ++i) { WF[i][0] = *(const LAS bf16x8*)(slot + (i * 2) * 1024); WF[i][1] = *(const LAS bf16x8*)(slot + (i * 2 + 1) * 1024); VN[i] = *(const LAS f32x4*)(slot + 16384 + i * 1024); } \
        _Pragma("unroll") for (int j = 0; j < 4; ++j) { KF[j][0] = *(const LAS bf16x8*)(slot + 8192 + (j * 2) * 1024); KF[j][1] = *(const LAS bf16x8*)(slot + 8192 + (j * 2 + 1) * 1024); } \
        GL = glL[(n_)]; } } while (0)
#define SCAN_COMP(m_, WF, KF, VN, GL) do { \
        const bf16x8 bs0 = pack_tiles(S[0], S[1]), bs1 = pack_tiles(S[2], S[3]); \
        _Pragma("unroll") for (int i = 0; i < 4; ++i) VN[i] = MFMA16(WF[i][0], bs0, VN[i]); \
        _Pragma("unroll") for (int i = 0; i < 4; ++i) VN[i] = MFMA16(WF[i][1], bs1, VN[i]); \
        _Pragma("unroll") for (int j = 0; j < 4; ++j) S[j] = S[j] * GL; \
        const bf16x8 bv0 = pack_tiles(VN[0], VN[1]), bv1 = pack_tiles(VN[2], VN[3]); \
        _Pragma("unroll") for (int j = 0; j < 4; ++j) S[j] = MFMA16(KF[j][0], bv0, S[j]); \
        _Pragma("unroll") for (int j = 0; j < 4; ++j) S[j] = MFMA16(KF[j][1], bv1, S[j]); \
        if (!((m_) < 4 && layer == 1)) { unsigned char* sv = svb + ((size_t)(m_) * 4 + sl) * 4096 + lane * 16; \
            *(bf16x8*)(sv) = bs0; *(bf16x8*)(sv + 1024) = bs1; *(bf16x8*)(sv + 2048) = bv0; *(bf16x8*)(sv + 3072) = bv1; } } while (0)
    SCAN_SYNC(0); if (wave == 0) SCAN_READ(0, wfA, kfA, vnA, glA);
#pragma unroll 1
    for (int n = 1; n <= NSTEP; n += 2) {
        SCAN_SYNC(n);
        if (wave == 0) { SCAN_READ(n, wfB, kfB, vnB, glB); SCAN_COMP(n - 1, wfA, kfA, vnA, glA); }
        SCAN_SYNC(n + 1);
        if (wave == 0) { SCAN_READ(n + 1, wfA, kfA, vnA, glA); SCAN_COMP(n, wfB, kfB, vnB, glB); }
    }
#undef SCAN_SYNC
#undef SCAN_READ
#undef SCAN_COMP
#undef SCAN_ISSUE
    asm volatile("s_waitcnt vmcnt(0) lgkmcnt(0)" ::: "memory");
    __builtin_amdgcn_s_barrier();
    asm volatile("" ::: "memory");
}

__device__ __forceinline__ void phase_gdn_out(Frame& F, const Args& A, int layer) {
    relane(F);
    const int nitems = (layer == 0 ? 264 : 256) * 4;
    LAS float* oL = (LAS float*)F.lds;
    const bf16* P = wsp<bf16>(F, WS_P); bf16* MIX = wsp<bf16>(F, WS_H);
    const unsigned char* GD = F.ws + WS_GDN; const unsigned char* SV = F.ws + WS_OG;
    const int lane = F.lane, d = F.wave >> 2, sl = F.wave & 3;
    for (int item = blockIdx.x; item < nitems; item += F.G) {
        const int sc = item >> 2, h = item & 3;
        int b, n, sbase, isctx;
        if (sc < 256) { b = sc >> 7; n = sc & 127; sbase = b * SEQ; isctx = 0; } else { const int cc = sc - 256; b = cc >> 2; n = cc & 3; sbase = NLAT + b * CTXL; isctx = 1; }
        const int step = isctx ? (d ? 3 - n : n) : 4 + (d ? 127 - n : n); const size_t itemid = (size_t)((b * 2 + d) * 4 + h) * NSTEP + step;
        const unsigned char* gb = GD + itemid * GDN_ITEM_BYTES; const unsigned char* sv = SV + (itemid * 4 + sl) * 4096 + lane * 16;
        bf16x8 qg[4][2], pp[4][2];
#pragma unroll
        for (int i = 0; i < 4; ++i)
#pragma unroll
            for (int s = 0; s < 2; ++s) { qg[i][s] = *(const bf16x8*)(gb + 16384 + ((i * 2 + s) * 64 + lane) * 16); pp[i][s] = *(const bf16x8*)(gb + 24576 + ((i * 2 + s) * 64 + lane) * 16); }
        const bf16x8 bs0 = *(const bf16x8*)(sv), bs1 = *(const bf16x8*)(sv + 1024), bv0 = *(const bf16x8*)(sv + 2048), bv1 = *(const bf16x8*)(sv + 3072);
        const v4u zw = *(const v4u*)(P + ((size_t)sbase + 64 * n + (F.tid >> 3)) * PN + PC_Z + h * 64 + (F.tid & 7) * 8);
#pragma unroll
        for (int i = 0; i < 4; ++i) { f32x4 o = MFMA16(qg[i][0], bs0, ((f32x4){0.f, 0.f, 0.f, 0.f})); o = MFMA16(qg[i][1], bs1, o); o = MFMA16(pp[i][0], bv0, o); o = MFMA16(pp[i][1], bv1, o);
#pragma unroll
            for (int r = 0; r < 4; ++r) { const int c = 16 * i + 4 * (lane >> 4) + r, tr = d ? 63 - c : c; oL[(d * 64 + tr) * 68 + sl * 16 + (lane & 15)] = o[r]; } }
        __syncthreads();
        { const int tok = F.tid >> 3, d8 = (F.tid & 7) * 8; const size_t row = (size_t)sbase + 64 * n + tok;
            const f32x4 a0 = *(const LAS f32x4*)(oL + tok * 68 + d8) + *(const LAS f32x4*)(oL + (64 + tok) * 68 + d8), a1 = *(const LAS f32x4*)(oL + tok * 68 + d8 + 4) + *(const LAS f32x4*)(oL + (64 + tok) * 68 + d8 + 4);
            float ss = dot4(a0, a0) + dot4(a1, a1); ss += __shfl_xor(ss, 1); ss += __shfl_xor(ss, 2); ss += __shfl_xor(ss, 4);
            const float rstd = rsqrtf(ss * (1.0f / 64.0f) + EPS);
            const f32x4 g0 = *(const f32x4*)(A.in[18] + layer * 64 + d8), g1 = *(const f32x4*)(A.in[18] + layer * 64 + d8 + 4);
            const f32x4 z0 = {bflo(zw.x), bfhi(zw.x), bflo(zw.y), bfhi(zw.y)}, z1 = {bflo(zw.z), bfhi(zw.z), bflo(zw.w), bfhi(zw.w)};
            const f32x4 y0 = a0 * rstd * g0 * (f32x4){silu_acc(z0[0]), silu_acc(z0[1]), silu_acc(z0[2]), silu_acc(z0[3])};
            const f32x4 y1 = a1 * rstd * g1 * (f32x4){silu_acc(z1[0]), silu_acc(z1[1]), silu_acc(z1[2]), silu_acc(z1[3])};
            v4u o; o.x = pk2(y0[0], y0[1]); o.y = pk2(y0[2], y0[3]); o.z = pk2(y1[0], y1[1]); o.w = pk2(y1[2], y1[3]);
            *(v4u*)(MIX + row * 1024 + 256 + h * 64 + d8) = o; }
        __syncthreads();
    }
}

__device__ __forceinline__ void phase_attn_merge(Frame& F) {
    relane(F);
    if (F.G != 256) return;
    bf16* MIX = wsp<bf16>(F, WS_H); const bf16* PO = wsp<bf16>(F, WS_PARTO); const float* PL = wsp<float>(F, WS_PARTL);
    for (int q4 = blockIdx.x; q4 < NSCANBLK * 4; q4 += F.G) {
        const int su = q4 >> 2;
        const int vs = (su % 8) * (F.G / 8) + su / 8, U = vs + F.G;
        const int x = (U & 255) >> 5, j = U & 31, i = U >> 8, pair = x >> 1, b = pair >> 1, kvh = pair & 1, head = kvh * 4 + (x & 1) * 2 + i;
        const size_t qrow = (size_t)b * SEQ + (size_t)j * 256;
        const int r = (q4 & 3) * 64 + (F.tid >> 3), d8 = (F.tid & 7) * 8;
        float L[4], w[4]; float lm = -INFINITY;
        bf16* mp = MIX + (qrow + r) * 1024 + 512 + head * 64 + d8;
        f32x4 pv[4][2];
        pv[0][0] = ld_bf4(mp); pv[0][1] = ld_bf4(mp + 4);
#pragma unroll
        for (int p = 0; p < 3; ++p) { const bf16* pp = PO + (((size_t)su * 3 + p) * 256 + r) * 64 + d8; pv[1 + p][0] = ld_bf4(pp); pv[1 + p][1] = ld_bf4(pp + 4); }
#pragma unroll
        for (int p = 0; p < 4; ++p) { L[p] = PL[((size_t)su * 4 + p) * 256 + r]; lm = fmaxf(lm, L[p]); }
        float ws = 0.f;
#pragma unroll
        for (int p = 0; p < 4; ++p) { w[p] = __builtin_amdgcn_exp2f(L[p] - lm); ws += w[p]; }
        const float inv = 1.0f / ws;
        f32x4 a0 = pv[0][0] * (w[0] * inv), a1 = pv[0][1] * (w[0] * inv);
#pragma unroll
        for (int p = 1; p < 4; ++p) { a0 = a0 + pv[p][0] * (w[p] * inv); a1 = a1 + pv[p][1] * (w[p] * inv); }
        st_bf4(mp, a0); st_bf4(mp + 4, a1);
    }
}

__device__ __forceinline__ void phase_route(Frame& F, const Args& A, int layer, bool dry = false) {
    relane(F);
    const int nrows = layer == 0 ? NTOK : NLAT;
    LAS int* hist = (LAS int*)(F.lds + RING_BYTES + 4096);
    if (F.tid < 32) hist[F.tid] = 0;
    const float* mod = wsp<float>(F, WS_MOD) + layer * 3 * 6144; const float* g2n = A.in[7] + layer * 1024;
    const float* WGT = wsp<float>(F, WS_WGT) + layer * 4096; const float* WETg = wsp<float>(F, WS_WET) + layer * 32768;
    LAS float* WET = (LAS float*)F.lds;
    { const unsigned lds0 = (unsigned)(uintptr_t)F.lds_g;
#pragma unroll
        for (int q = 0; q < 16; ++q) { const int piece = F.wave * 16 + q; attn_body::glds16(WETg + piece * 256 + F.lane * 4, (unsigned)__builtin_amdgcn_readfirstlane(lds0 + piece * 1024)); } }
    f32x4 wg[4][4], gn4[4], sc4[4], sh4[4]; int msc = -1;
#pragma unroll
    for (int gi = 0; gi < 4; ++gi)
#pragma unroll
        for (int j = 0; j < 4; ++j) wg[gi][j] = *(const f32x4*)(WGT + gi * 1024 + 4 * F.lane + 256 * j);
#pragma unroll
    for (int j = 0; j < 4; ++j) gn4[j] = *(const f32x4*)(g2n + 4 * F.lane + 256 * j);
    asm volatile("s_waitcnt vmcnt(0)" ::: "memory");
    __syncthreads();
    const float* brg = A.in[23] + layer * 4; const float* bre = A.in[25] + layer * 32;
    bf16* H2 = wsp<bf16>(F, WS_H); int* EID = wsp<int>(F, WS_EID); float* WTS = wsp<float>(F, WS_WTS);
    ROW_BATCH_BEGIN(nrows)
        f32x4 vv[3][4];
#pragma unroll
        for (int u = 0; u < 3; ++u) { const int r = row[u]; const bf16* xr = r < NLAT ? (layer == 0 ? (const bf16*)F.out : wsp<bf16>(F, WS_P)) + (size_t)r * 1024 : wsp<bf16>(F, WS_XCTX) + (size_t)(r - NLAT) * 1024;
#pragma unroll
            for (int j = 0; j < 4; ++j) vv[u][j] = ld_bf4(xr + 4 * F.lane + 256 * j); }
#pragma unroll
        for (int u = 0; u < 3; ++u) { const int r = row[u], ms = msel_of(r);
        f32x4 v[4]; float ss = 0.f;
#pragma unroll
        for (int j = 0; j < 4; ++j) { v[j] = vv[u][j]; ss += dot4(v[j], v[j]); }
        const float rstd = rsqrtf(wave_sum(ss) * (1.0f / 1024.0f) + EPS);
        if (ms != msc) { msc = ms;
#pragma unroll
            for (int j = 0; j < 4; ++j) { sc4[j] = *(const f32x4*)(mod + ms * 6144 + 4096 + 4 * F.lane + 256 * j); sh4[j] = *(const f32x4*)(mod + ms * 6144 + 3072 + 4 * F.lane + 256 * j); } }
#pragma unroll
        for (int j = 0; j < 4; ++j) { const int k = 4 * F.lane + 256 * j;
            v[j] = v[j] * rstd * gn4[j] * (sc4[j] + 1.0f) + sh4[j];
            if (!dry) st_bf4(H2 + (size_t)r * 1024 + k, v[j]); }
        float lg[4];
#pragma unroll
        for (int gi = 0; gi < 4; ++gi) { float a = 0.f;
#pragma unroll
            for (int j = 0; j < 4; ++j) a += dot4(v[j], wg[gi][j]);
            lg[gi] = wave_sum(a) + brg[gi]; }
        int grp = 0; float lmax = lg[0];
#pragma unroll
        for (int gi = 1; gi < 4; ++gi) if (lg[gi] > lmax) { lmax = lg[gi]; grp = gi; }
        float den = 0.f;
#pragma unroll
        for (int gi = 0; gi < 4; ++gi) den += expf(lg[gi] - lmax);
        const float pg_sel = 1.0f / den;
        grp = __builtin_amdgcn_readfirstlane(grp);
        float le[8];
#pragma unroll
        for (int e = 0; e < 8; ++e) { float a = 0.f;
#pragma unroll
            for (int j = 0; j < 4; ++j) a += dot4(v[j], *(const LAS f32x4*)(WET + (grp * 8 + e) * 1024 + 4 * F.lane + 256 * j));
            le[e] = wave_sum(a) + bre[grp * 8 + e]; }
        int i1 = 0; float l1 = le[0];
#pragma unroll
        for (int e = 1; e < 8; ++e) if (le[e] > l1) { l1 = le[e]; i1 = e; }
        int i2 = -1; float l2 = -INFINITY;
#pragma unroll
        for (int e = 0; e < 8; ++e) if (e != i1 && le[e] > l2) { l2 = le[e]; i2 = e; }
        const float p2 = expf(l2 - l1), inv = 1.0f / (1.0f + p2);
        if (F.lane == 0 && valid[u] && !dry) { const int e0 = grp * 8 + i1, e1 = grp * 8 + i2; EID[r * 2] = e0; EID[r * 2 + 1] = e1; WTS[r * 2] = pg_sel * inv; WTS[r * 2 + 1] = pg_sel * p2 * inv;
            __hip_atomic_fetch_add(&hist[e0], 1, __ATOMIC_RELAXED, __HIP_MEMORY_SCOPE_WORKGROUP); __hip_atomic_fetch_add(&hist[e1], 1, __ATOMIC_RELAXED, __HIP_MEMORY_SCOPE_WORKGROUP); }
        }
    ROW_BATCH_END
    __syncthreads();
    if (F.tid < 32 && hist[F.tid] != 0) atomicAdd(wsp<int>(F, WS_CTL) + CW_CNT + layer * 32 + F.tid, hist[F.tid]);
}

__device__ __forceinline__ void phase_slots(Frame& F, const Args& A, int layer) {
    relane(F);
    const int nrows = layer == 0 ? NTOK : NLAT;
    LAS int* li = (LAS int*)F.lds;
    int* ctl = wsp<int>(F, WS_CTL);
    if (F.tid < 32) { li[F.tid] = 0; li[32 + F.tid] = 0; }
    if (F.tid < 64) {
        const int e = F.tid & 31; const int c = __hip_atomic_load(ctl + CW_CNT + layer * 32 + e, __ATOMIC_RELAXED, __HIP_MEMORY_SCOPE_AGENT); const int nt = (c + 255) >> 8; int incl = nt;
#pragma unroll
        for (int o = 1; o < 32; o <<= 1) { const int t = __shfl_up(incl, o, 32); if (e >= o) incl += t; }
        const int excl = incl - nt;
        if (F.tid < 32) { li[64 + e] = excl * 256; li[128 + e] = c;
            if (blockIdx.x == 0) { for (int t = 0; t < nt; ++t) ctl[CW_TE + layer * 256 + excl + t] = e; if (e == 31) ctl[CW_NT + layer] = incl; } } }
    __syncthreads();
    const int* EID = wsp<int>(F, WS_EID); int* SLOT = wsp<int>(F, WS_SLOT);
    { const int RPW = (nrows + F.NGW - 1) / F.NGW, r0 = F.gw * RPW, r1 = (r0 + RPW < nrows) ? r0 + RPW : nrows;
      for (int i = r0 * 2 + F.lane; i < r1 * 2; i += 64) __hip_atomic_fetch_add(&li[EID[i]], 1, __ATOMIC_RELAXED, __HIP_MEMORY_SCOPE_WORKGROUP); }
    __syncthreads();
    if (F.tid < 32) li[96 + F.tid] = li[F.tid] ? atomicAdd(ctl + CW_CUR + layer * 32 + F.tid, li[F.tid]) : 0;
    __syncthreads();
    int* STOK = wsp<int>(F, WS_STOK);
    if (blockIdx.x == 0) {
        for (int e = 0; e < 32; ++e) { const int c = li[128 + e]; const int base = li[64 + e], pad = ((c + 255) & ~255);
            for (int s = c + F.tid; s < pad; s += NTHR) STOK[base + s] = 0; } }
    { const int RPW = (nrows + F.NGW - 1) / F.NGW, r0 = F.gw * RPW, r1 = (r0 + RPW < nrows) ? r0 + RPW : nrows;
      for (int i = r0 * 2 + F.lane; i < r1 * 2; i += 64) { const int e = EID[i]; const int slot = li[64 + e] + li[96 + e] + __hip_atomic_fetch_add(&li[32 + e], 1, __ATOMIC_RELAXED, __HIP_MEMORY_SCOPE_WORKGROUP);
          SLOT[i] = slot; STOK[slot] = i >> 1; } }
}

__device__ __forceinline__ void phase_final(Frame& F, const Args& A, bool dry = false) {
    relane(F);
    const float* mod = wsp<float>(F, WS_MOD) + 3 * 6144; const float* gf = A.in[29];
    const int* SLOT = wsp<int>(F, WS_SLOT); const float* WTS = wsp<float>(F, WS_WTS); const bf16* Y = wsp<bf16>(F, WS_GDN);
    f32x4 gf4[4], g24[4]; int msc = -1;
#pragma unroll
    for (int j = 0; j < 4; ++j) gf4[j] = *(const f32x4*)(gf + 4 * F.lane + 256 * j);
    ROW_RANGE(NLAT)
    int sl_all = 0; float wt_all = 0.f;
    if (rbeg_ * 2 + F.lane < rend_ * 2) { sl_all = SLOT[rbeg_ * 2 + F.lane]; wt_all = WTS[rbeg_ * 2 + F.lane]; }
    ROW_BATCH_LOOP
        f32x4 v[3][4]; v2u y0[3][4], y1[3][4]; float w0[3], w1[3];
#pragma unroll
        for (int u = 0; u < 3; ++u) { const int r = row[u]; const bf16* xr = wsp<bf16>(F, WS_P) + (size_t)r * 1024; const int li_ = (r - rbeg_) * 2; const int s0 = __builtin_amdgcn_readlane(sl_all, li_), s1 = __builtin_amdgcn_readlane(sl_all, li_ + 1);
            w0[u] = __int_as_float(__builtin_amdgcn_readlane(__float_as_int(wt_all), li_)); w1[u] = __int_as_float(__builtin_amdgcn_readlane(__float_as_int(wt_all), li_ + 1));
#pragma unroll
            for (int j = 0; j < 4; ++j) { const int k = 4 * F.lane + 256 * j; v[u][j] = ld_bf4(xr + k); y0[u][j] = *(const v2u*)(Y + (size_t)s0 * 1024 + k); y1[u][j] = *(const v2u*)(Y + (size_t)s1 * 1024 + k); } }
#pragma unroll
        for (int u = 0; u < 3; ++u) { const int r = row[u], ms = r >> 13; float* xr = F.out + (size_t)r * 1024; float ss = 0.f;
            if (ms != msc) { msc = ms;
#pragma unroll
                for (int j = 0; j < 4; ++j) g24[j] = *(const f32x4*)(mod + ms * 6144 + 5120 + 4 * F.lane + 256 * j); }
#pragma unroll
            for (int j = 0; j < 4; ++j) { const int k = 4 * F.lane + 256 * j;
                const f32x4 a0 = {bflo(y0[u][j].x), bfhi(y0[u][j].x), bflo(y0[u][j].y), bfhi(y0[u][j].y)}, a1 = {bflo(y1[u][j].x), bfhi(y1[u][j].x), bflo(y1[u][j].y), bfhi(y1[u][j].y)};
                v[u][j] = v[u][j] + g24[j] * (a0 * w0[u] + a1 * w1[u]); ss += dot4(v[u][j], v[u][j]); }
            const float rstd = rsqrtf(wave_sum(ss) * (1.0f / 1024.0f) + EPS);
            if (valid[u] && !dry) {
#pragma unroll
                for (int j = 0; j < 4; ++j) { const int k = 4 * F.lane + 256 * j; *(f32x4*)(xr + k) = v[u][j] * rstd * gf4[j]; } } }
    ROW_BATCH_END
}

#ifndef MK_MULTI
#define MK_MULTI 0
#endif
#ifndef MK_ONLY
#define MK_ONLY -1
#endif
#define EN(c) (MK_ONLY < 0 || MK_ONLY == (c))
#ifndef MK_EXTRA_BARRIERS
#define MK_EXTRA_BARRIERS 0
#endif
#ifndef MK_ATT_DV
#define MK_ATT_DV 0
#endif
#ifndef MK_FORCE_NOMAX
#define MK_FORCE_NOMAX 0
#endif
#ifndef MK_REP_MASK
#define MK_REP_MASK 0
#endif
#define REPS(c) (((MK_REP_MASK >> (c)) & 1) ? 2 : 1)
constexpr int N_PHASES = 22;

__device__ __forceinline__ void phase_mixers(Frame& F, const Args& A, int layer) {
    if (EN(6) && blockIdx.x < NSCANBLK) for (int rep = 0; rep < REPS(6); ++rep) phase_gdn_scan(F, A, layer);
    if (EN(7)) {
        const int M = layer == 0 ? NTOK : NLAT;
        pg8::Gemm g{wsp<bf16>(F, WS_CF), wsp<bf16>(F, WS_WPW) + (size_t)layer * 65536, M, 256, 256, nullptr};
        pg8::StaticOrder S; S.init(M, 256, F.G, (int)blockIdx.x - NSCANBLK);
        pg8::EpiBf16<true> E{wsp<bf16>(F, WS_H), 1024, A.in[14] + layer * 256};
        pg8::gemm_phase<pg8::EpiBf16<true>, pg8::StaticOrder, true, true>(F.lds, g, S, E);
        __syncthreads();
    }
    if (EN(8)) for (int rep = 0; rep < REPS(8); ++rep) {
        using abf = attn_body::bf16;
        const abf* Q = (const abf*)wsp<bf16>(F, WS_Q); const abf* K = (const abf*)wsp<bf16>(F, WS_K); const abf* V = (const abf*)wsp<bf16>(F, WS_V); abf* MIX = (abf*)wsp<bf16>(F, WS_H);
        const bool split_ok = (F.G == 256);
        const float* gqp = A.in[19] + layer * 64; const float* gkp = A.in[20] + layer * 64;
#define ATTN_CALL(OPITCH, ...) do { float M0; { const int l6 = opaque_tid() & 63; float gq = fabsf(gqp[l6]), gk = fabsf(gkp[l6]); \
            _Pragma("unroll") for (int o = 1; o < 64; o <<= 1) { gq = fmaxf(gq, __shfl_xor(gq, o)); gk = fmaxf(gk, __shfl_xor(gk, o)); } \
            M0 = 8.0f * 1.4426950408889634f * gq * gk; } \
        if (MK_FORCE_NOMAX || __builtin_amdgcn_readfirstlane((int)(M0 < 56.0f))) { if (MK_ATT_DV && rep + 1 < REPS(8)) attn_body::attn_unit<8, OPITCH, true, MK_ATT_DV>(__VA_ARGS__, M0); else attn_body::attn_unit<8, OPITCH, true>(__VA_ARGS__, M0); } else attn_body::attn_unit<8, OPITCH, false>(__VA_ARGS__, 0.f); } while (0)
        bf16* PO = wsp<bf16>(F, WS_PARTO); float* PL = wsp<float>(F, WS_PARTL);
        for (int U = F.vcu; U < 512; U += F.G) {
            const int x = (U & 255) >> 5, j = U & 31, i = U >> 8, pair = x >> 1, b = pair >> 1, kvh = pair & 1, head = kvh * 4 + (x & 1) * 2 + i;
            const size_t qrow = (size_t)b * SEQ + (size_t)j * 256;
            const bool split = split_ok && i == 1 && (int)blockIdx.x < NSCANBLK;
            ATTN_CALL(1024, Q + qrow * 512 + head * 64, K + (size_t)b * KVROWS * 128 + kvh * 64, V + (size_t)b * KVROWS * 128 + kvh * 64, MIX + qrow * 1024 + 512 + head * 64,
                                          split ? ATT_SPLIT_MAIN : ATT_NT, (char*)F.lds_g, split ? PL + ((size_t)blockIdx.x * 4) * 256 : nullptr);
        }
        if (split_ok && (int)blockIdx.x >= NSCANBLK) {
            const int hb = (int)blockIdx.x - NSCANBLK, su = hb / 3, part = hb % 3;
            const int vs = (su % 8) * (F.G / 8) + su / 8, U = vs + F.G;
            const int x = (U & 255) >> 5, j = U & 31, i = U >> 8, pair = x >> 1, b = pair >> 1, kvh = pair & 1, head = kvh * 4 + (x & 1) * 2 + i;
            const size_t qrow = (size_t)b * SEQ + (size_t)j * 256; const size_t koff = (size_t)b * KVROWS * 128 + (size_t)(ATT_SPLIT_MAIN + ATT_SPLIT_PART * part) * 64 * 128 + kvh * 64;
            ATTN_CALL(64, Q + qrow * 512 + head * 64, K + koff, V + koff, (abf*)(PO + ((size_t)su * 3 + part) * 256 * 64), ATT_SPLIT_PART, (char*)F.lds_g, PL + ((size_t)su * 4 + 1 + part) * 256);
        }
        if (layer == 0) {
            for (int U = F.vcu; U < 16; U += F.G) {
                const int b = U >> 3, head = U & 7, kvh = head >> 2; const size_t qrow = (size_t)NLAT + (size_t)b * CTXL;
                ATTN_CALL(1024, Q + qrow * 512 + head * 64, K + (size_t)b * KVROWS * 128 + kvh * 64, V + (size_t)b * KVROWS * 128 + kvh * 64, MIX + qrow * 1024 + 512 + head * 64, 4, (char*)F.lds_g, nullptr);
            }
        }
    }
}

__device__ __forceinline__ void run_layer(Frame& F, const Args& A, const XcdBarrier& bar, const int layer, const int lo, const int hi) {
#define RUN(p) (lo <= (p) && (p) < hi)
#define SEAM(p) do { if (RUN(p) && RUN((p) + 1)) { xcd_barrier(bar); } } while (0)
        const int pb = 1 + 10 * layer;
        if (EN(1) && RUN(pb + 0)) for (int rep = 0; rep < REPS(1); ++rep) { phase_norm1(F, A, layer, rep + 1 < REPS(1)); __syncthreads(); }
        SEAM(pb + 0);
        if (EN(2) && RUN(pb + 1)) for (int rep = 0; rep < REPS(2); ++rep) {
            pg8::Gemm g{wsp<bf16>(F, WS_H), wsp<bf16>(F, WS_WIN) + (size_t)layer * PN * 1024, NTOK, PN, 1024, nullptr};
            pg8::StaticOrder S; S.init(NTOK, PN, F.G, (int)blockIdx.x);
            pg8::EpiBf16<false> E{wsp<bf16>(F, WS_P), PN, nullptr};
            pg8::gemm_phase<pg8::EpiBf16<false>, pg8::StaticOrder, true, true>(F.lds, g, S, E);
            { const int nu = (NTOK / 256) * (PN / 256); const int idle = max_units(nu, F.G) - my_units(nu, F.G, (int)blockIdx.x); if (idle > 0) convert_pull(F, A, 2 * idle, 0, 1); }
        }
        SEAM(pb + 1);
        if (RUN(pb + 2)) { if (EN(3)) for (int rep = 0; rep < REPS(3); ++rep) phase_attn_prep(F, A, layer); if (EN(4)) for (int rep = 0; rep < REPS(4); ++rep) phase_conformer(F, A, layer); __syncthreads(); if (EN(5)) for (int rep = 0; rep < REPS(5); ++rep) phase_gdn_prep(F, A, layer); }
        SEAM(pb + 2);
        if (RUN(pb + 3)) phase_mixers(F, A, layer);
        SEAM(pb + 3);
        if (EN(9) && RUN(pb + 4)) { phase_attn_merge(F); for (int rep = 0; rep < REPS(9); ++rep) phase_gdn_out(F, A, layer); }
        SEAM(pb + 4);
        if (EN(10) && RUN(pb + 5)) for (int rep = 0; rep < (layer == 0 ? REPS(10) : 1); ++rep) {
            const int M = layer == 0 ? NTOK : NLAT;
            pg8::Gemm g{wsp<bf16>(F, WS_H), wsp<bf16>(F, WS_WOUT) + (size_t)layer * 1024 * 1024, M, 1024, 1024, nullptr};
            pg8::StaticOrder S; S.init(M, 1024, F.G, (int)blockIdx.x);
            bf16* xb0 = (bf16*)F.out; bf16* xcb = wsp<bf16>(F, WS_XCTX); bf16* xb1 = wsp<bf16>(F, WS_P);
            if (layer == 0) { pg8::EpiResid<true> E{A.in[0], A.in[2], xb0, xcb, wsp<float>(F, WS_MOD) + 2048};
                pg8::gemm_phase<pg8::EpiResid<true>, pg8::StaticOrder, true, true>(F.lds, g, S, E); }
            else { pg8::EpiResid<false> E{xb0, xcb, xb1, xcb, wsp<float>(F, WS_MOD) + 3 * 6144 + 2048};
                pg8::gemm_phase<pg8::EpiResid<false>, pg8::StaticOrder, true, true>(F.lds, g, S, E); }
            { const int nu = (M / 256) * 4; const int idle = max_units(nu, F.G) - my_units(nu, F.G, (int)blockIdx.x); if (idle > 0) convert_pull(F, A, 3 * idle, 0, 1); }
        }
        SEAM(pb + 5);
        if (EN(11) && RUN(pb + 6)) for (int rep = 0; rep < REPS(11); ++rep) { phase_route(F, A, layer, rep + 1 < REPS(11)); __syncthreads(); }
        SEAM(pb + 6);
        if (EN(12) && RUN(pb + 7)) { phase_slots(F, A, layer); __syncthreads(); convert_pull(F, A, CONV_CHUNKS, layer, layer); }
        SEAM(pb + 7);
        if (EN(13) && RUN(pb + 8)) for (int rep = 0; rep < REPS(13); ++rep) {
            const int* ctl = wsp<int>(F, WS_CTL);
            const int nt = __builtin_amdgcn_readfirstlane(__hip_atomic_load(ctl + CW_NT + layer, __ATOMIC_RELAXED, __HIP_MEMORY_SCOPE_AGENT));
            pg8::Gemm g{wsp<bf16>(F, WS_H), wsp<bf16>(F, WS_WGU) + (size_t)layer * 32 * 1024 * 1024, NSLOT_MAX, 32 * 1024, 1024, wsp<int>(F, WS_STOK)};
            pg8::MoeOrder S{ctl + CW_TE + layer * 256, nt, F.G, F.vcu};
            pg8::EpiSwiGLU E{wsp<bf16>(F, WS_OG), 512};
            pg8::gemm_phase<pg8::EpiSwiGLU, pg8::MoeOrder, true, true, true>(F.lds, g, S, E);
            { const int idle = max_units(nt * 4, F.G) - my_units(nt * 4, F.G, F.vcu); if (idle > 0) convert_pull(F, A, 2 * idle, 0, 1); }
        }
        SEAM(pb + 8);
        if (EN(14) && RUN(pb + 9)) for (int rep = 0; rep < REPS(14); ++rep) {
            const int* ctl = wsp<int>(F, WS_CTL);
            const int nt = __builtin_amdgcn_readfirstlane(__hip_atomic_load(ctl + CW_NT + layer, __ATOMIC_RELAXED, __HIP_MEMORY_SCOPE_AGENT));
            pg8::Gemm g{wsp<bf16>(F, WS_OG), wsp<bf16>(F, WS_WD) + (size_t)layer * 32 * 1024 * 512, NSLOT_MAX, 32 * 1024, 512, nullptr};
            pg8::MoeOrder S{ctl + CW_TE + layer * 256, nt, F.G, F.vcu};
            pg8::EpiBf16<false> E{wsp<bf16>(F, WS_GDN), 1024, nullptr};
            pg8::gemm_phase<pg8::EpiBf16<false>, pg8::MoeOrder, true, true>(F.lds, g, S, E);
            { const int idle = max_units(nt * 4, F.G) - my_units(nt * 4, F.G, F.vcu); if (idle > 0) convert_pull(F, A, idle, 0, 1); }
        }
        SEAM(pb + 9);
#undef RUN
#undef SEAM
}

__global__ void __launch_bounds__(NTHR, 2) mk_fwd(const Args A) {
    extern __shared__ __attribute__((aligned(16))) unsigned char lds[];
    Frame F;
    F.lds = (LAS unsigned char*)lds; F.lds_g = lds;
    F.tid = threadIdx.x; F.lane = F.tid & 63; F.wave = __builtin_amdgcn_readfirstlane(F.tid >> 6);
    F.G = gridDim.x; { const int bx = blockIdx.x; F.vcu = (F.G % 8 == 0) ? (bx % 8) * (F.G / 8) + bx / 8 : bx; }
    F.gw = blockIdx.x * NWAVES + F.wave; F.NGW = F.G * NWAVES;
    F.out = A.out; F.ws = A.ws;
    const int lo = A.ph_lo, hi = A.ph_hi;
    for (int u = F.tid; u < (LDS_BYTES - RING_BYTES) / 4; u += NTHR) ((LAS unsigned*)(F.lds + RING_BYTES))[u] = 0u;
    __syncthreads();
    XcdBarrier bar = xcd_barrier_post((unsigned*)(F.ws + WS_CTL) + CW_BAR, (volatile XLAS unsigned*)(F.lds + MISC_OFF + 32));
#define RUN(p) (lo <= (p) && (p) < hi)
#define SEAM(p) do { if (RUN(p) && RUN((p) + 1)) { xcd_barrier(bar); } } while (0)
    if (hi > N_PHASES + 1) cg::this_grid().sync();

    if (EN(0) && RUN(0)) for (int rep = 0; rep < REPS(0); ++rep) { p0_prologue(F, A); __syncthreads(); }
    SEAM(0);
    run_layer(F, A, bar, 0, lo, hi);
    run_layer(F, A, bar, 1, lo, hi);
    for (int xb_ = 0; xb_ < MK_EXTRA_BARRIERS; ++xb_) xcd_barrier(bar);
    if (EN(15) && RUN(21)) for (int rep = 0; rep < REPS(15); ++rep) phase_final(F, A, rep + 1 < REPS(15));
#undef RUN
#undef SEAM
}

extern "C" void kernel_launch(void* const* d_in, const int* in_sizes, int n_in, void* d_out, int out_size, void* d_ws, size_t ws_size, hipStream_t stream) {
    static int grid = 0;
    if (grid == 0) {
        if (n_in != 30 || out_size != NLAT * DM || ws_size < WS_END) { fprintf(stderr, "kernel_launch: unexpected shapes: n_in %d out %d ws %zu (need %zu)\n", n_in, out_size, ws_size, (size_t)WS_END); grid = -1; return; }
        int dev = 0, cus = 0, per_cu = 0;
        hipGetDevice(&dev); hipDeviceGetAttribute(&cus, hipDeviceAttributeMultiprocessorCount, dev);
        if (hipFuncSetAttribute((const void*)mk_fwd, hipFuncAttributeMaxDynamicSharedMemorySize, LDS_BYTES) != hipSuccess) { fprintf(stderr, "kernel_launch: hipFuncSetAttribute failed\n"); grid = -1; return; }
        if (hipOccupancyMaxActiveBlocksPerMultiprocessor(&per_cu, (const void*)mk_fwd, NTHR, LDS_BYTES) != hipSuccess || per_cu < 1) { fprintf(stderr, "kernel_launch: occupancy query says %d blocks per CU\n", per_cu); (void)hipGetLastError(); per_cu = 1; }
        grid = cus;
        fprintf(stderr, "kernel_launch: %d CUs, occupancy %d per CU, grid %d\n", cus, per_cu, grid);
    }
    if (grid < 0) return;
    hipMemsetAsync((char*)d_ws + WS_CTL, 0, CTL_ZERO_BYTES, stream);
    Args a{};
    for (int i = 0; i < 30; ++i) a.in[i] = (const float*)d_in[i];
    a.out = (float*)d_out; a.ws = (unsigned char*)d_ws;
#if MK_MULTI
    for (int p = 0; p < N_PHASES; ++p) { a.ph_lo = p; a.ph_hi = p + 1; hipLaunchKernelGGL(mk_fwd, dim3(grid), dim3(NTHR), LDS_BYTES, stream, a); }
#else
    a.ph_lo = 0; a.ph_hi = N_PHASES;
    void* kargs[] = {&a};
    hipError_t e = hipLaunchCooperativeKernel((const void*)mk_fwd, dim3(grid), dim3(NTHR), kargs, LDS_BYTES, stream);
    if (e != hipSuccess) fprintf(stderr, "kernel_launch: cooperative launch failed: %s (grid %d)\n", hipGetErrorString(e), grid);
#endif
}
```

```cpp
#include <hip/hip_runtime.h>
#include <hip/hip_bf16.h>
#include <hip/hip_cooperative_groups.h>
#include <cstdio>
#include <cstdint>
#include <cmath>
namespace cg = cooperative_groups;
__device__ __forceinline__ int opaque_tid() { int t = threadIdx.x; asm volatile("" : "+v"(t)); return t; }

namespace pg8 {
#define PG8_LAS __attribute__((address_space(3)))
typedef unsigned short bf16_t;
typedef short bf16x8 __attribute__((ext_vector_type(8)));
typedef float f32x4 __attribute__((ext_vector_type(4)));
typedef unsigned u32x4 __attribute__((ext_vector_type(4)));
constexpr int BM = 256, BK = 64, HALF = 128, HTB = HALF * BK * 2  , STAGE_BYTES = 8 * HTB, NXCD = 8, WGM = 8;

__host__ __device__ __forceinline__ int lds_byte(int r, int c) { const int st = (r >> 4) * 2 + (c >> 5), rr = r & 15, cc = c & 31, ob = rr * 64 + cc * 2; return st * 1024 + (ob ^ (((ob >> 9) & 1) << 5)); }
__host__ __device__ __forceinline__ void stage_rc(int b, int& R, int& C) { const int st = b / 1024, sb = b % 1024, swz = sb ^ (((sb >> 9) & 1) << 5); R = (st >> 1) * 16 + swz / 64; C = (st & 1) * 32 + (swz % 64) / 2; }
__host__ __device__ __forceinline__ int perm32(int rho) { const int n = rho >> 4, i = rho & 15; return 8 * (i >> 2) + 4 * n + (i & 3); }

struct Unit { int pm, pn, pc; };
struct Gemm { const bf16_t* A; const bf16_t* Bt; int M, N, K; const int* gather; };

struct StaticOrder {
    int nM, nN, nwg, G, c;
    __host__ __device__ void init(int M, int N, int G_, int c_) { nM = M / BM; nN = N / BM; nwg = nM * nN; G = G_; c = c_; }
    __host__ __device__ bool next(int i, Unit& u) const {
        if (c < 0) return false;
        const long L = (long)i * G + c; if (L >= nwg) return false;
        int wgid = (int)L; { const int q = nwg / NXCD, r = nwg % NXCD, xcd = wgid % NXCD, off = wgid / NXCD; wgid = (xcd < r ? xcd * (q + 1) : r * (q + 1) + (xcd - r) * q) + off; }
        const int nig = WGM * nN, gid = wgid / nig, fm = gid * WGM, gsz = (nM - fm) < WGM ? (nM - fm) : WGM;
        u.pm = fm + ((wgid % nig) % gsz); u.pn = (wgid % nig) / gsz; u.pc = u.pn; return true;
    }
    __device__ __forceinline__ void a_ready(const Unit&) const {}
    __device__ __forceinline__ void done(const Unit&) const {}
};
struct MoeOrder {
    const int* tile_expert; int ntiles, G, c;
    __device__ __forceinline__ bool next(int i, Unit& u) const {
        const long L = (long)i * G + c; if (L >= (long)ntiles * 4) return false;
        const int t = (int)(L >> 2), j = (int)(L & 3);
        const int e = __builtin_amdgcn_readfirstlane(__hip_atomic_load(tile_expert + t, __ATOMIC_RELAXED, __HIP_MEMORY_SCOPE_AGENT));
        u.pm = t; u.pn = e * 4 + j; u.pc = j; return true;
    }
    __device__ __forceinline__ void a_ready(const Unit&) const {}
    __device__ __forceinline__ void done(const Unit&) const {}
};

typedef float f32x2_t __attribute__((ext_vector_type(2))); typedef __bf16 bf16x2_t __attribute__((ext_vector_type(2)));
__device__ __forceinline__ unsigned cvt_pk_bf16(float lo, float hi) { f32x2_t v = {lo, hi}; bf16x2_t b = __builtin_convertvector(v, bf16x2_t); return __builtin_bit_cast(unsigned, b); }

template <bool BIAS> struct EpiBf16 {
    static constexpr bool PERM = true, AFTER_DRAIN = false;
    bf16_t* O; int ldc; const float* bias;
    __device__ __forceinline__ void init(f32x4 (&acc)[2][2][4][2], const Unit& u, int wr, int wc, int fr, int fq) const {
        const int col0 = u.pc * BM + wc * 32 + 8 * fq;
#pragma unroll
        for (int bj = 0; bj < 2; ++bj)
#pragma unroll
            for (int n = 0; n < 2; ++n) { const f32x4 b = BIAS ? *(const f32x4*)(bias + col0 + bj * HALF + 4 * n) : (f32x4){0.f, 0.f, 0.f, 0.f};
#pragma unroll
                for (int ai = 0; ai < 2; ++ai)
#pragma unroll
                    for (int m = 0; m < 4; ++m) acc[ai][bj][m][n] = b; }
    }
    __device__ __forceinline__ void operator()(const f32x4 (&acc)[2][2][4][2], const Unit& u, int wr, int wc, int fr, int fq) const {
        const int row0 = u.pm * BM + wr * 64 + fr; const int col0 = u.pc * BM + wc * 32 + 8 * fq;
#pragma unroll
        for (int ai = 0; ai < 2; ++ai)
#pragma unroll
            for (int m = 0; m < 4; ++m) { bf16_t* rowp = O + (size_t)(row0 + ai * HALF + m * 16) * ldc + col0;
#pragma unroll
                for (int bj = 0; bj < 2; ++bj) { const f32x4 v0 = acc[ai][bj][m][0], v1 = acc[ai][bj][m][1];
                    u32x4 w; w.x = cvt_pk_bf16(v0[0], v0[1]); w.y = cvt_pk_bf16(v0[2], v0[3]); w.z = cvt_pk_bf16(v1[0], v1[1]); w.w = cvt_pk_bf16(v1[2], v1[3]);
                    *(u32x4*)(rowp + bj * HALF) = w; } }
    }
};
__device__ __forceinline__ float silu_f(float x) { return x * __builtin_amdgcn_rcpf(1.0f + __builtin_amdgcn_exp2f(-1.4426950408889634f * x)); }
struct EpiSwiGLU {
    static constexpr bool PERM = true, AFTER_DRAIN = false;
    bf16_t* O; int ldc;
    __device__ __forceinline__ void init(f32x4 (&acc)[2][2][4][2], const Unit&, int, int, int, int) const {
#pragma unroll
        for (int a = 0; a < 2; ++a)
#pragma unroll
            for (int b = 0; b < 2; ++b)
#pragma unroll
                for (int m = 0; m < 4; ++m)
#pragma unroll
                    for (int n = 0; n < 2; ++n) acc[a][b][m][n] = (f32x4){0.f, 0.f, 0.f, 0.f};
    }
    __device__ __forceinline__ void operator()(const f32x4 (&acc)[2][2][4][2], const Unit& u, int wr, int wc, int fr, int fq) const {
        const int row0 = u.pm * BM + wr * 64 + fr; const int col0 = u.pc * HALF + wc * 32 + 8 * fq;
#pragma unroll
        for (int ai = 0; ai < 2; ++ai)
#pragma unroll
            for (int m = 0; m < 4; ++m) { bf16_t* rowp = O + (size_t)(row0 + ai * HALF + m * 16) * ldc + col0;
                const f32x4 g0 = acc[ai][0][m][0], g1 = acc[ai][0][m][1], u0 = acc[ai][1][m][0], u1 = acc[ai][1][m][1];
                u32x4 w; w.x = cvt_pk_bf16(silu_f(g0[0]) * u0[0], silu_f(g0[1]) * u0[1]); w.y = cvt_pk_bf16(silu_f(g0[2]) * u0[2], silu_f(g0[3]) * u0[3]);
                w.z = cvt_pk_bf16(silu_f(g1[0]) * u1[0], silu_f(g1[1]) * u1[1]); w.w = cvt_pk_bf16(silu_f(g1[2]) * u1[2], silu_f(g1[3]) * u1[3]);
                *(u32x4*)rowp = w; }
    }
};
struct EpiInProj {
    static constexpr bool PERM = true, AFTER_DRAIN = false;
    bf16_t* O; int ldc; float* AB;
    __device__ __forceinline__ void init(f32x4 (&acc)[2][2][4][2], const Unit&, int, int, int, int) const {
#pragma unroll
        for (int a = 0; a < 2; ++a)
#pragma unroll
            for (int b = 0; b < 2; ++b)
#pragma unroll
                for (int m = 0; m < 4; ++m)
#pragma unroll
                    for (int n = 0; n < 2; ++n) acc[a][b][m][n] = (f32x4){0.f, 0.f, 0.f, 0.f};
    }
    __device__ __forceinline__ void operator()(const f32x4 (&acc)[2][2][4][2], const Unit& u, int wr, int wc, int fr, int fq) const {
        const int row0 = u.pm * BM + wr * 64 + fr;
        if (u.pc == 9) {
            if (wc == 0 && fq < 2) {
#pragma unroll
                for (int ai = 0; ai < 2; ++ai)
#pragma unroll
                    for (int m = 0; m < 4; ++m) { float* rowp = AB + (size_t)(row0 + ai * HALF + m * 16) * 16 + 8 * fq;
                        *(f32x4*)rowp = acc[ai][0][m][0]; *(f32x4*)(rowp + 4) = acc[ai][0][m][1]; } }
            return; }
        const int col0 = u.pc * BM + wc * 32 + 8 * fq;
#pragma unroll
        for (int ai = 0; ai < 2; ++ai)
#pragma unroll
            for (int m = 0; m < 4; ++m) { bf16_t* rowp = O + (size_t)(row0 + ai * HALF + m * 16) * ldc + col0;
#pragma unroll
                for (int bj = 0; bj < 2; ++bj) { const f32x4 v0 = acc[ai][bj][m][0], v1 = acc[ai][bj][m][1];
                    u32x4 w; w.x = cvt_pk_bf16(v0[0], v0[1]); w.y = cvt_pk_bf16(v0[2], v0[3]); w.z = cvt_pk_bf16(v1[0], v1[1]); w.w = cvt_pk_bf16(v1[2], v1[3]);
                    *(u32x4*)(rowp + bj * HALF) = w; } }
    }
};
template <bool BASE_F32> struct EpiResid {
    static constexpr bool PERM = true, AFTER_DRAIN = false;
    __device__ __forceinline__ void init(f32x4 (&acc)[2][2][4][2], const Unit&, int, int, int, int) const {
#pragma unroll
        for (int a = 0; a < 2; ++a)
#pragma unroll
            for (int b = 0; b < 2; ++b)
#pragma unroll
                for (int m = 0; m < 4; ++m)
#pragma unroll
                    for (int n = 0; n < 2; ++n) acc[a][b][m][n] = (f32x4){0.f, 0.f, 0.f, 0.f};
    }
    const void* base_l; const void* base_c; bf16_t* out_l; bf16_t* out_c; const float* gate;
    __device__ __forceinline__ void operator()(const f32x4 (&acc)[2][2][4][2], const Unit& u, int wr, int wc, int fr, int fq) const {
        const bool isc = u.pm >= 64; const int msel = isc ? 2 : (u.pm >> 5);
        const void* base = isc ? base_c : base_l; bf16_t* out = isc ? out_c : out_l; const int rbase = isc ? (u.pm - 64) * BM : u.pm * BM;
        const float* gp = gate + msel * 6144;
        const int col0 = u.pc * BM + wc * 32 + 8 * fq;
        f32x4 gv[2][2];
#pragma unroll
        for (int bj = 0; bj < 2; ++bj)
#pragma unroll
            for (int n = 0; n < 2; ++n) gv[bj][n] = *(const f32x4*)(gp + col0 + bj * HALF + 4 * n);
#pragma unroll
        for (int ai = 0; ai < 2; ++ai)
#pragma unroll
            for (int m = 0; m < 4; ++m) { const size_t off = (size_t)(rbase + ai * HALF + wr * 64 + m * 16 + fr) * 1024 + col0;
#pragma unroll
                for (int bj = 0; bj < 2; ++bj) { f32x4 b0, b1;
                    if constexpr (BASE_F32) { b0 = __builtin_nontemporal_load((const f32x4*)((const float*)base + off + bj * HALF)); b1 = __builtin_nontemporal_load((const f32x4*)((const float*)base + off + bj * HALF + 4)); }
                    else { const u32x4 w = *(const u32x4*)((const bf16_t*)base + off + bj * HALF);
                        b0 = (f32x4){__uint_as_float(w.x << 16), __uint_as_float(w.x & 0xffff0000u), __uint_as_float(w.y << 16), __uint_as_float(w.y & 0xffff0000u)};
                        b1 = (f32x4){__uint_as_float(w.z << 16), __uint_as_float(w.z & 0xffff0000u), __uint_as_float(w.w << 16), __uint_as_float(w.w & 0xffff0000u)}; }
                    const f32x4 v0 = b0 + gv[bj][0] * acc[ai][bj][m][0], v1 = b1 + gv[bj][1] * acc[ai][bj][m][1];
                    u32x4 o; o.x = cvt_pk_bf16(v0[0], v0[1]); o.y = cvt_pk_bf16(v0[2], v0[3]); o.z = cvt_pk_bf16(v1[0], v1[1]); o.w = cvt_pk_bf16(v1[2], v1[3]);
                    *(u32x4*)(out + off + bj * HALF) = o; } }
    }
};

template <class Epi, class Sched, bool ALIGN_EPI = false, bool SP2 = false, bool GATHER = false>
__device__ __forceinline__ void gemm_phase(PG8_LAS unsigned char* lds, const Gemm g, const Sched& S, const Epi& E) {
    const int tid = opaque_tid(), wid = __builtin_amdgcn_readfirstlane(tid >> 6), lane = tid & 63, wr = wid >> 2, wc = wid & 3, fr = lane & 15, fq = lane >> 4;
    const int K = g.K, nt = K / BK;
    unsigned voffA[2], voffB[2]; int Rr[2], Cc[2];
#pragma unroll
    for (int i = 0; i < 2; ++i) { int R, C; stage_rc(tid * 16 + i * 8192, R, C); const int Rb = Epi::PERM ? ((R & ~31) + perm32(R & 31)) : R; Rr[i] = R; Cc[i] = C;
        voffA[i] = (unsigned)(R * K + C) * 2u; voffB[i] = (unsigned)(Rb * K + C) * 2u; }
    const size_t kstep = (size_t)(BK * 2);
    const size_t hstep = (size_t)HALF * K * 2;
    const size_t tstep = 2 * hstep;
    const unsigned ldsw = (unsigned)wid * 1024u;
    const int aoff = lds_byte(wr * 64 + fr, fq * 8), boff = lds_byte(wc * 32 + fr, fq * 8);
#define PG8_SA(b, h) (((b) * 2 + (h)) * HTB)
#define PG8_SB(b, h) ((4 + (b) * 2 + (h)) * HTB)
#define PG8_STAGE(bufoff, gbase, voff) do { _Pragma("unroll") for (int _i = 0; _i < 2; ++_i) \
        __builtin_amdgcn_global_load_lds((const unsigned*)((const char*)(gbase) + (voff)[_i]), (PG8_LAS unsigned*)(lds + (bufoff) + ldsw + _i * 8192), 16, 0, 0); } while (0)
#define PG8_LDA(dst, b, h) do { _Pragma("unroll") for (int m = 0; m < 4; ++m) _Pragma("unroll") for (int k = 0; k < 2; ++k) dst[m][k] = *(const PG8_LAS bf16x8*)(lds + PG8_SA(b, h) + aoff + m * 2048 + k * 1024); } while (0)
#define PG8_LDB(dst, b, h) do { _Pragma("unroll") for (int n = 0; n < 2; ++n) _Pragma("unroll") for (int k = 0; k < 2; ++k) dst[n][k] = *(const PG8_LAS bf16x8*)(lds + PG8_SB(b, h) + boff + n * 2048 + k * 1024); } while (0)
#define PG8_MMA(ai, bj, At, Bt) do { __builtin_amdgcn_s_setprio(1); _Pragma("unroll") for (int m = 0; m < 4; ++m) _Pragma("unroll") for (int n = 0; n < 2; ++n) _Pragma("unroll") for (int k = 0; k < 2; ++k) \
        acc[ai][bj][m][n] = __builtin_amdgcn_mfma_f32_16x16x32_bf16(Bt[n][k], At[m][k], acc[ai][bj][m][n], 0, 0, 0); __builtin_amdgcn_s_setprio(0); } while (0)
#define PG8_WAIT_V(n) asm volatile("s_waitcnt vmcnt(" #n ")" ::: "memory")
#define PG8_WAIT_L(n) asm volatile("s_waitcnt lgkmcnt(" #n ")" ::: "memory")
#define PG8_BAR __builtin_amdgcn_s_barrier()
#define PG8_SCHED __builtin_amdgcn_sched_barrier(0)
    Unit cur, nxt; int ui = 0;
    if (!S.next(0, cur)) return;
    f32x4 acc[2][2][4][2];
    E.init(acc, cur, wr, wc, fr, fq);
    bf16x8 At[4][2], B0[2][2], B1[2][2];
    const char* cA = GATHER ? (const char*)g.A : (const char*)g.A + (size_t)cur.pm * tstep; const char* cB = (const char*)g.Bt + (size_t)cur.pn * tstep;
    unsigned cv0[2], cv1[2], nv0[2], nv1[2];
#pragma unroll
    for (int i = 0; i < 2; ++i) {
        if constexpr (GATHER) { cv0[i] = (unsigned)(g.gather[cur.pm * BM + Rr[i]] * K + Cc[i]) * 2u; cv1[i] = (unsigned)(g.gather[cur.pm * BM + HALF + Rr[i]] * K + Cc[i]) * 2u; }
        else { cv0[i] = voffA[i]; cv1[i] = voffA[i] + (unsigned)hstep; }
        nv0[i] = cv0[i]; nv1[i] = cv1[i]; }
    S.a_ready(cur);
    if constexpr (SP2) {
        PG8_STAGE(PG8_SB(0, 0), cB, voffB); PG8_STAGE(PG8_SB(0, 1), cB + hstep, voffB); PG8_STAGE(PG8_SA(0, 0), cA, cv0); PG8_STAGE(PG8_SA(0, 1), cA, cv1);
        if (wr == 1) PG8_BAR;
        PG8_WAIT_V(2); PG8_BAR;
        PG8_STAGE(PG8_SB(1, 0), cB + kstep, voffB); PG8_STAGE(PG8_SA(1, 0), cA + kstep, cv0); PG8_STAGE(PG8_SB(1, 1), cB + hstep + kstep, voffB);
        PG8_WAIT_V(6); PG8_BAR;
    } else {
        PG8_STAGE(PG8_SB(0, 0), cB, voffB); PG8_STAGE(PG8_SA(0, 0), cA, cv0); PG8_STAGE(PG8_SB(0, 1), cB + hstep, voffB); PG8_STAGE(PG8_SA(0, 1), cA, cv1);
        if (wr == 1) PG8_BAR;
        PG8_WAIT_V(4); PG8_BAR;
        PG8_STAGE(PG8_SB(1, 0), cB + kstep, voffB); PG8_STAGE(PG8_SA(1, 0), cA + kstep, cv0); PG8_STAGE(PG8_SB(1, 1), cB + hstep + kstep, voffB);
        PG8_WAIT_V(6); PG8_BAR;
    }
    for (;;) {
        const bool has_next = S.next(ui + 1, nxt);
        const char* nA = (has_next && !GATHER) ? (const char*)g.A + (size_t)nxt.pm * tstep : cA; const char* nB = has_next ? (const char*)g.Bt + (size_t)nxt.pn * tstep : cB;
        if constexpr (GATHER) { if (has_next) {
#pragma unroll
            for (int i = 0; i < 2; ++i) { nv0[i] = (unsigned)(g.gather[nxt.pm * BM + Rr[i]] * K + Cc[i]) * 2u; nv1[i] = (unsigned)(g.gather[nxt.pm * BM + HALF + Rr[i]] * K + Cc[i]) * 2u; } } }
        for (int t = 0; t < nt; t += 2) {
            const bool last = (t == nt - 2);
            const char* a1 = cA + (size_t)(t + 1) * kstep;
            const char* a2 = last ? nA : cA + (size_t)(t + 2) * kstep; const char* b2 = last ? nB : cB + (size_t)(t + 2) * kstep;
            const char* a3 = a2 + kstep; const char* b3 = b2 + kstep;
            unsigned sv0[2], sv1[2];
#pragma unroll
            for (int i = 0; i < 2; ++i) { sv0[i] = last ? nv0[i] : cv0[i]; sv1[i] = last ? nv1[i] : cv1[i]; }
            if (last && has_next) S.a_ready(nxt);
            if constexpr (SP2) {
            PG8_LDB(B0, 0, 0); PG8_LDB(B1, 0, 1); PG8_SCHED; PG8_LDA(At, 0, 0); PG8_STAGE(PG8_SA(1, 1), a1, cv1);
            PG8_WAIT_V(8); PG8_WAIT_L(0); PG8_BAR; PG8_MMA(0, 0, At, B0); PG8_MMA(0, 1, At, B1); PG8_BAR; PG8_SCHED;
            PG8_LDA(At, 0, 1); PG8_STAGE(PG8_SB(0, 0), b2, voffB); PG8_STAGE(PG8_SB(0, 1), b2 + hstep, voffB); PG8_STAGE(PG8_SA(0, 0), a2, sv0);
            PG8_WAIT_V(8); PG8_WAIT_L(0); PG8_BAR; PG8_MMA(1, 0, At, B0); PG8_MMA(1, 1, At, B1); PG8_BAR; PG8_SCHED;
            PG8_LDB(B0, 1, 0); PG8_LDB(B1, 1, 1); PG8_SCHED; PG8_LDA(At, 1, 0); PG8_STAGE(PG8_SA(0, 1), a2, sv1);
            PG8_WAIT_V(8); PG8_WAIT_L(0); PG8_BAR; PG8_MMA(0, 0, At, B0); PG8_MMA(0, 1, At, B1); PG8_BAR; PG8_SCHED;
            PG8_LDA(At, 1, 1); PG8_STAGE(PG8_SB(1, 0), b3, voffB); PG8_STAGE(PG8_SB(1, 1), b3 + hstep, voffB); PG8_STAGE(PG8_SA(1, 0), a3, sv0);
            PG8_WAIT_V(8); PG8_WAIT_L(0); PG8_BAR; PG8_MMA(1, 0, At, B0); PG8_MMA(1, 1, At, B1); PG8_BAR; PG8_SCHED;
            } else {
            PG8_LDB(B0, 0, 0); PG8_SCHED; PG8_LDA(At, 0, 0); PG8_STAGE(PG8_SA(1, 1), a1, cv1);
            PG8_WAIT_L(8); PG8_BAR; PG8_WAIT_L(0); PG8_MMA(0, 0, At, B0); PG8_BAR; PG8_SCHED;
            PG8_LDB(B1, 0, 1); PG8_STAGE(PG8_SB(0, 0), b2, voffB);
            PG8_BAR; PG8_WAIT_L(0); PG8_MMA(0, 1, At, B1); PG8_BAR;
            PG8_LDA(At, 0, 1); PG8_STAGE(PG8_SA(0, 0), a2, sv0);
            PG8_BAR; PG8_WAIT_L(0); PG8_MMA(1, 0, At, B0); PG8_BAR; PG8_SCHED;
            PG8_STAGE(PG8_SB(0, 1), b2 + hstep, voffB);
            PG8_WAIT_V(6); PG8_BAR; PG8_MMA(1, 1, At, B1); PG8_BAR;
            PG8_LDB(B0, 1, 0); PG8_SCHED; PG8_LDA(At, 1, 0); PG8_STAGE(PG8_SA(0, 1), a2, sv1);
            PG8_WAIT_L(8); PG8_BAR; PG8_WAIT_L(0); PG8_MMA(0, 0, At, B0); PG8_BAR; PG8_SCHED;
            PG8_LDB(B1, 1, 1); PG8_STAGE(PG8_SB(1, 0), b3, voffB);
            PG8_BAR; PG8_WAIT_L(0); PG8_MMA(0, 1, At, B1); PG8_BAR;
            PG8_LDA(At, 1, 1); PG8_STAGE(PG8_SA(1, 0), a3, sv0);
            PG8_BAR; PG8_WAIT_L(0); PG8_MMA(1, 0, At, B0); PG8_BAR; PG8_SCHED;
            PG8_STAGE(PG8_SB(1, 1), b3 + hstep, voffB);
            PG8_WAIT_V(6); PG8_BAR; PG8_MMA(1, 1, At, B1); PG8_BAR;
            }
        }
        if constexpr (ALIGN_EPI) { if (wr == 0) PG8_BAR; }
        if constexpr (!Epi::AFTER_DRAIN) { E(acc, cur, wr, wc, fr, fq); S.done(cur); }
        if (!has_next) break;
        E.init(acc, nxt, wr, wc, fr, fq);
        cur = nxt; cA = nA; cB = nB; ++ui;
#pragma unroll
        for (int i = 0; i < 2; ++i) { cv0[i] = nv0[i]; cv1[i] = nv1[i]; }
        if constexpr (ALIGN_EPI) { if (wr == 1) PG8_BAR; }
    }
    PG8_WAIT_V(0);
    if constexpr (!ALIGN_EPI) { if (wr == 0) PG8_BAR; }
    PG8_BAR;
    if constexpr (Epi::AFTER_DRAIN) { E.fused(acc, cur, wr, wc, fr, fq, lds, wid, lane); S.done(cur); }
#undef PG8_SA
#undef PG8_SB
#undef PG8_STAGE
#undef PG8_LDA
#undef PG8_LDB
#undef PG8_MMA
#undef PG8_WAIT_V
#undef PG8_WAIT_L
#undef PG8_BAR
#undef PG8_SCHED
}
}
namespace attn_body {
using bf16=__hip_bfloat16;
using bf16x8=__attribute__((ext_vector_type(8)))short;
using s16x4=__attribute__((ext_vector_type(4)))short;
using f32x16=__attribute__((ext_vector_type(16)))float;
using u32x4=__attribute__((ext_vector_type(4)))unsigned;
constexpr int D=64,QP=512,KP=128;
constexpr int NW=8,QBLK=32,QB=QBLK*NW,KVBLK=64;
constexpr int ATTN_UNIT_ROWS=QB;
__device__ __forceinline__ int crow(int r,int hi){return (r&3)+8*(r>>2)+4*hi;}
#define SBAR() __builtin_amdgcn_sched_barrier(0)
__device__ __forceinline__ void cmask(f32x16&p0,f32x16&p1,int jb,int qrel,int hi){
  const float NEG=-INFINITY; int kb=64*jb+4*hi;
  #pragma unroll
  for(int r=0;r<16;++r){int kv=kb+(r&3)+8*(r>>2); if(kv>qrel)p0[r]=NEG; if(kv+32>qrel)p1[r]=NEG;}
}

constexpr int NSLOT=3, SLOTB=8192;
constexpr int LDS_K=0, LDS_V=NSLOT*SLOTB, LDS_WS=2*NSLOT*SLOTB, LDS_OST=LDS_WS+NW*64*4, LDS_BYTES=LDS_OST+NW*4096;
constexpr float C2=0.125f*1.4426950408889634f;
__device__ __forceinline__ void glds16(const void*gsrc,unsigned lds_dst){unsigned keep;
  asm volatile("s_mov_b32 %0, m0\n\ts_mov_b32 m0, %2\n\ts_nop 0\n\tglobal_load_lds_dwordx4 %1, off\n\ts_mov_b32 m0, %0":"=&s"(keep):"v"(gsrc),"s"(lds_dst):"memory");}
__device__ __forceinline__ float max3f(float a,float b,float c){float r;asm("v_max3_f32 %0, %1, %2, %3":"=v"(r):"v"(a),"v"(b),"v"(c));return r;}
__device__ __forceinline__ float max2f(float a,float b){float r;asm("v_max_f32_e32 %0, %1, %2":"=v"(r):"v"(a),"v"(b));return r;}
__device__ __forceinline__ float fadd_s(float a,float b){float r;asm("v_add_f32_e32 %0, %1, %2":"=v"(r):"v"(a),"v"(b));return r;}
__device__ __forceinline__ float fsub_s(float a,float b){float r;asm("v_sub_f32_e32 %0, %1, %2":"=v"(r):"v"(a),"v"(b));return r;}
typedef float f32x2_t __attribute__((ext_vector_type(2))); typedef __bf16 bf16x2_t __attribute__((ext_vector_type(2)));
__device__ __forceinline__ unsigned cvtpk_s(float lo,float hi){f32x2_t v={lo,hi};bf16x2_t b=__builtin_convertvector(v,bf16x2_t);return __builtin_bit_cast(unsigned,b);}
#define WAIT_BAR(N) asm volatile("s_waitcnt vmcnt(" #N ") lgkmcnt(0)\n\ts_barrier":::"memory")

__device__ __forceinline__ void qkt(f32x16&p0,f32x16&p1,const char*Kslot,const bf16x8*qr,const f32x16&negm,int r32,int hi){
  const char*kb=Kslot+hi*1024+r32*16;
  #pragma unroll
  for(int d0=0;d0<4;++d0){
    const bf16x8 b0=*reinterpret_cast<const bf16x8*>(kb+d0*2048);
    const bf16x8 b1=*reinterpret_cast<const bf16x8*>(kb+d0*2048+512);
    if(d0==0){p0=__builtin_amdgcn_mfma_f32_32x32x16_bf16(b0,qr[0],negm,0,0,0);p1=__builtin_amdgcn_mfma_f32_32x32x16_bf16(b1,qr[0],negm,0,0,0);}
    else{p0=__builtin_amdgcn_mfma_f32_32x32x16_bf16(b0,qr[d0],p0,0,0,0);p1=__builtin_amdgcn_mfma_f32_32x32x16_bf16(b1,qr[d0],p1,0,0,0);}}
}
typedef __attribute__((address_space(3))) const char* lds_cptr;
typedef short v4i16_t __attribute__((ext_vector_type(4)));
__device__ __forceinline__ void kload8(bf16x8*kf,lds_cptr kp){
  kf[0]=*(const __attribute__((address_space(3))) bf16x8*)(kp);      kf[1]=*(const __attribute__((address_space(3))) bf16x8*)(kp+512);
  kf[2]=*(const __attribute__((address_space(3))) bf16x8*)(kp+2048); kf[3]=*(const __attribute__((address_space(3))) bf16x8*)(kp+2560);
  kf[4]=*(const __attribute__((address_space(3))) bf16x8*)(kp+4096); kf[5]=*(const __attribute__((address_space(3))) bf16x8*)(kp+4608);
  kf[6]=*(const __attribute__((address_space(3))) bf16x8*)(kp+6144); kf[7]=*(const __attribute__((address_space(3))) bf16x8*)(kp+6656);
}
__device__ __forceinline__ void kload2(bf16x8*kf,lds_cptr kp,int j){ kf[2*j]=*(const __attribute__((address_space(3))) bf16x8*)(kp+j*2048); kf[2*j+1]=*(const __attribute__((address_space(3))) bf16x8*)(kp+j*2048+512); }
__device__ __forceinline__ s16x4 vtr(lds_cptr p){ return __builtin_bit_cast(s16x4,__builtin_amdgcn_ds_read_tr16_b64_v4i16((__attribute__((address_space(3))) v4i16_t*)p)); }
__device__ __forceinline__ float rowmax(const f32x16&p0,const f32x16&p1){
  float a=max3f(p0[0],p0[1],p1[0]),b=max3f(p0[2],p0[3],p1[1]);a=max3f(a,p1[2],p1[3]);
  #pragma unroll
  for(int r=4;r<16;r+=4){a=max3f(a,p0[r],p0[r+1]);b=max3f(b,p0[r+2],p0[r+3]);a=max3f(a,p1[r],p1[r+1]);b=max3f(b,p1[r+2],p1[r+3]);}
  const float m=max2f(a,b);
  auto rr=__builtin_amdgcn_permlane32_swap(__float_as_uint(m),__float_as_uint(m),false,false);
  return max2f(__uint_as_float(rr[0]),__uint_as_float(rr[1]));
}
__device__ __forceinline__ void pv(f32x16*o,int vb,bf16x8 pa0,bf16x8 pa1,bf16x8 pa2,bf16x8 pa3){
  #pragma unroll
  for(int d0=0;d0<2;++d0){s16x4 lo[4],hi[4];
    #pragma unroll
    for(int ks=0;ks<4;++ks){
      asm volatile("ds_read_b64_tr_b16 %0,%1 offset:%c2":"=&v"(lo[ks]):"v"(vb),"i"(d0*4096+ks*1024):"memory");
      asm volatile("ds_read_b64_tr_b16 %0,%1 offset:%c2":"=&v"(hi[ks]):"v"(vb),"i"(d0*4096+ks*1024+512):"memory");}
    asm volatile("s_waitcnt lgkmcnt(0)":::"memory");SBAR();
    #define PK(k) (bf16x8){lo[k][0],lo[k][1],lo[k][2],lo[k][3],hi[k][0],hi[k][1],hi[k][2],hi[k][3]}
    o[d0]=__builtin_amdgcn_mfma_f32_32x32x16_bf16(pa0,PK(0),o[d0],0,0,0);
    o[d0]=__builtin_amdgcn_mfma_f32_32x32x16_bf16(pa1,PK(1),o[d0],0,0,0);
    o[d0]=__builtin_amdgcn_mfma_f32_32x32x16_bf16(pa2,PK(2),o[d0],0,0,0);
    o[d0]=__builtin_amdgcn_mfma_f32_32x32x16_bf16(pa3,PK(3),o[d0],0,0,0);
    #undef PK
  }
}

#ifndef ATTN_STORE16
#define ATTN_STORE16(p,v) (*(u32x4*)(p)=(v))
#endif
template<int THRL,int OP,bool NOMAX,int DV=0> __device__ __forceinline__ void attn_unit(const bf16*Qu,const bf16*Kh,const bf16*Vh,bf16*Ou,const int NT,char*shm,float*lse_out,const float M0){
  const int tid=opaque_tid(),lane=tid&63,r32=lane&31,hi=lane>>5; const int wid=__builtin_amdgcn_readfirstlane(tid>>6);
  const bf16*Qw=Qu+(long)(wid*QBLK)*QP;
  const unsigned lds0=(unsigned)(uintptr_t)shm;
  float*wsf=(float*)(shm+LDS_WS)+wid*64;
  const bf16*ksrc=Kh+(long)lane*KP+wid*8;
  const bf16*vsrc=Vh+(long)(16*(wid&3)+(lane>>2))*KP+(wid>>2)*32+(lane&3)*8;
  const unsigned kdst=lds0+LDS_K+wid*1024, vdst=lds0+LDS_V+wid*1024;
  #define DMA_K(t,slot) glds16(ksrc+(long)(t)*KVBLK*KP,(unsigned)__builtin_amdgcn_readfirstlane(kdst+(slot)))
  #define DMA_V(t,slot) glds16(vsrc+(long)(t)*KVBLK*KP,(unsigned)__builtin_amdgcn_readfirstlane(vdst+(slot)))
  const int vb0=(int)(lds0+LDS_V)+((lane>>4)&1)*32+(lane&3)*8+(4*hi+((lane&15)>>2))*64;
  const char*Kbase=shm+LDS_K; bf16x8 kf[8];
  const lds_cptr shm3=(lds_cptr)shm; const lds_cptr kp0=shm3+LDS_K+hi*1024+r32*16; const lds_cptr vp0=shm3+LDS_V+((lane>>4)&1)*32+(lane&3)*8+(4*hi+((lane&15)>>2))*64;
  DMA_K(0,0);DMA_V(0,0);DMA_K(1,SLOTB);
  bf16x8 qr[4];
  #pragma unroll
  for(int d0=0;d0<4;++d0)qr[d0]=*reinterpret_cast<const bf16x8*>(&Qw[(long)r32*QP+d0*16+hi*8]);
  float mhat=NOMAX?M0:0.f,l_reg=0.f;f32x16 o[2];o[0]=f32x16{};o[1]=f32x16{};f32x16 negm=f32x16{};
  if(NOMAX){_Pragma("unroll") for(int r=0;r<16;++r)negm[r]=-M0;} asm volatile("":"+v"(negm));
  #define CMASK(P0,P1,t) do{}while(0)
  bool resc=false;
  #define START(P0,P1) do{ resc=false; \
    if(!NOMAX){ const float rm=rowmax(P0,P1); const float dl=rm; mhat=fadd_s(mhat,dl); \
      _Pragma("unroll") for(int r=0;r<16;++r){P0[r]=fsub_s(P0[r],dl);P1[r]=fsub_s(P1[r],dl);} \
      _Pragma("unroll") for(int r=0;r<16;++r)negm[r]=-mhat; asm volatile("":"+v"(negm)); } \
    _Pragma("unroll") for(int r=0;r<16;++r)P0[r]=__builtin_amdgcn_exp2f(P0[r]); }while(0)
  #define RESC() do{ if(!NOMAX&&resc){ asm volatile("s_waitcnt lgkmcnt(0)":::"memory"); \
      _Pragma("unroll") for(int d_=0;d_<2;++d_) _Pragma("unroll") for(int r=0;r<16;++r)o[d_][r]*=wsf[crow(r,hi)]; } }while(0)
  f32x16 pA0,pA1,pB0,pB1;
  int sl_prev=0,sl_cur=0,sl_next=SLOTB;
  #define ROT() do{sl_prev=sl_cur;sl_cur=sl_next;sl_next=(sl_next==(NSLOT-1)*SLOTB)?0:sl_next+SLOTB;}while(0)
  DMA_K(2,2*SLOTB);
  WAIT_BAR(3);
  qkt(pA0,pA1,Kbase,qr,negm,r32,hi);asm volatile("s_nop 15\n\ts_nop 7":"+v"(pA0),"+v"(pA1));CMASK(pA0,pA1,0);
  START(pA0,pA1);
  _Pragma("unroll") for(int r=0;r<16;++r)pA1[r]=__builtin_amdgcn_exp2f(pA1[r]);
  WAIT_BAR(0);
  DMA_K(3,0);DMA_V(1,SLOTB);
  ROT();
  kload8(kf,kp0+sl_cur);
  WAIT_BAR(2);
  s16x4 vlo[8],vhi[8]; u32x4 pw0,pw1,pw2,pw3;
  if(DV==5||DV==6){_Pragma("unroll") for(int i=0;i<8;++i){vlo[i]=(s16x4){kf[i][0],kf[i][1],kf[i][2],kf[i][3]};vhi[i]=(s16x4){kf[i][4],kf[i][5],kf[i][6],kf[i][7]};asm volatile("":"+v"(vlo[i]),"+v"(vhi[i]));}}
  #define PKW(P,B) cvtpk_s(P[B],P[B+1])
  #define PAF(k) __builtin_bit_cast(bf16x8,pw##k)
  #define VFR(i) (bf16x8){vlo[i][0],vlo[i][1],vlo[i][2],vlo[i][3],vhi[i][0],vhi[i][1],vhi[i][2],vhi[i][3]}
  #define PIN(x) asm volatile("":"+v"(x))
  #define MX3(a,b,c) __builtin_fmaxf(__builtin_fmaxf((a),(b)),(c))
  #define GAPA(MF,A0,A1,A2,A3,W0,W1,PW) do{ MF; if(DV!=2){sacc+=A0; sacc+=A1; sacc+=A2; sacc+=A3;} PIN(sacc); if(DV!=4){W0; W1;} PIN(PW); SBAR(); }while(0)
  #define EX(v) (DV==1?(v)*0.5f:__builtin_amdgcn_exp2f(v))
  #define GAPB(MF,X,B) do{ if(DV!=9){MF;} X[B]=EX(X[B]); X[B+1]=EX(X[B+1]); X[B+2]=EX(X[B+2]); X[B+3]=EX(X[B+3]); PIN(X); SBAR(); }while(0)
  #define VRD(i) do{ if(DV==5||DV==6)break; vlo[i]=vtr(vp_+(((i)>>2)*4096+((i)&3)*1024)); vhi[i]=vtr(vp_+(((i)>>2)*4096+((i)&3)*1024+512)); }while(0)
  #define KRD(G,j) do{ if((G)&&DV!=5&&DV!=8){ kload2(kf,kp0+sl_next,j); SBAR(); } }while(0)
  #define STEP(C0,C1,P0,P1,t,GK,GV,GL) do{ SBAR(); \
    const lds_cptr vp_=vp0+sl_prev; \
    VRD(0); SBAR(); float sacc=(P0[0]+P0[1]); \
    GAPA(C0=__builtin_amdgcn_mfma_f32_32x32x16_bf16(kf[0],qr[0],negm,0,0,0), P0[2],P0[3],P0[4],P0[5],     pw0[0]=PKW(P0,0), pw0[1]=PKW(P0,2), pw0); \
    VRD(4); SBAR(); GAPA(C1=__builtin_amdgcn_mfma_f32_32x32x16_bf16(kf[1],qr[0],negm,0,0,0), P0[6],P0[7],P0[8],P0[9],     pw0[2]=PKW(P0,4), pw0[3]=PKW(P0,6), pw0); \
    VRD(1); SBAR(); GAPA(C0=__builtin_amdgcn_mfma_f32_32x32x16_bf16(kf[2],qr[1],C0,0,0,0),   P0[10],P0[11],P0[12],P0[13], pw1[0]=PKW(P0,8), pw1[1]=PKW(P0,10), pw1); \
    VRD(5); SBAR(); GAPA(C1=__builtin_amdgcn_mfma_f32_32x32x16_bf16(kf[3],qr[1],C1,0,0,0),   P0[14],P0[15],P1[0],P1[1],   pw1[2]=PKW(P0,12),pw1[3]=PKW(P0,14), pw1); \
    VRD(2); SBAR(); GAPA(C0=__builtin_amdgcn_mfma_f32_32x32x16_bf16(kf[4],qr[2],C0,0,0,0),   P1[2],P1[3],P1[4],P1[5],     pw2[0]=PKW(P1,0), pw2[1]=PKW(P1,2), pw2); \
    VRD(6); SBAR(); GAPA(C1=__builtin_amdgcn_mfma_f32_32x32x16_bf16(kf[5],qr[2],C1,0,0,0),   P1[6],P1[7],P1[8],P1[9],     pw2[2]=PKW(P1,4), pw2[3]=PKW(P1,6), pw2); \
    VRD(3); SBAR(); GAPA(C0=__builtin_amdgcn_mfma_f32_32x32x16_bf16(kf[6],qr[3],C0,0,0,0),   P1[10],P1[11],P1[12],P1[13], pw3[0]=PKW(P1,8), pw3[1]=PKW(P1,10), pw3); \
    VRD(7); SBAR(); GAPA(C1=__builtin_amdgcn_mfma_f32_32x32x16_bf16(kf[7],qr[3],C1,0,0,0),   P1[14],P1[15],0.f,0.f,       pw3[2]=PKW(P1,12),pw3[3]=PKW(P1,14), pw3); \
    l_reg+=sacc; \
    if((GK)&&DV!=7){DMA_K((t)+3,sl_cur);} if((GV)&&DV!=7){DMA_V((t)+1,sl_next);} \
    CMASK(C0,C1,t); \
    if(!NOMAX){ float a=MX3(C0[0],C0[1],C1[0]),b=MX3(C0[2],C0[3],C1[1]); a=MX3(a,C1[2],C1[3]); \
      _Pragma("unroll") for(int r=4;r<16;r+=4){a=MX3(a,C0[r],C0[r+1]);b=MX3(b,C0[r+2],C0[r+3]);a=MX3(a,C1[r],C1[r+1]);b=MX3(b,C1[r+2],C1[r+3]);} \
      float rm=__builtin_fmaxf(a,b); { auto rr=__builtin_amdgcn_permlane32_swap(__float_as_uint(rm),__float_as_uint(rm),false,false); rm=__builtin_fmaxf(__uint_as_float(rr[0]),__uint_as_float(rr[1])); } \
      resc=false; \
      if(__builtin_expect(__any(rm>(float)THRL),0)){ const float dl=__builtin_fmaxf(rm,0.f); mhat+=dl; \
        _Pragma("unroll") for(int r=0;r<16;++r){C0[r]-=dl;C1[r]-=dl;} \
        _Pragma("unroll") for(int r=0;r<16;++r)negm[r]=-mhat; asm volatile("":"+v"(negm)); \
        const float f=__builtin_amdgcn_exp2f(-dl); l_reg*=f; if(hi==0)wsf[r32]=f; resc=true; } } \
    SBAR(); \
    GAPB(o[0]=__builtin_amdgcn_mfma_f32_32x32x16_bf16(PAF(0),VFR(0),o[0],0,0,0), C0,0); \
    GAPB(o[1]=__builtin_amdgcn_mfma_f32_32x32x16_bf16(PAF(0),VFR(4),o[1],0,0,0), C0,4); \
    KRD(GL,0); GAPB(o[0]=__builtin_amdgcn_mfma_f32_32x32x16_bf16(PAF(1),VFR(1),o[0],0,0,0), C0,8); \
    KRD(GL,1); GAPB(o[1]=__builtin_amdgcn_mfma_f32_32x32x16_bf16(PAF(1),VFR(5),o[1],0,0,0), C0,12); \
    KRD(GL,2); GAPB(o[0]=__builtin_amdgcn_mfma_f32_32x32x16_bf16(PAF(2),VFR(2),o[0],0,0,0), C1,0); \
    KRD(GL,3); GAPB(o[1]=__builtin_amdgcn_mfma_f32_32x32x16_bf16(PAF(2),VFR(6),o[1],0,0,0), C1,4); \
    GAPB(o[0]=__builtin_amdgcn_mfma_f32_32x32x16_bf16(PAF(3),VFR(3),o[0],0,0,0), C1,8); \
    GAPB(o[1]=__builtin_amdgcn_mfma_f32_32x32x16_bf16(PAF(3),VFR(7),o[1],0,0,0), C1,12); \
    }while(0)
  int t=1;
  #undef CMASK
  #define CMASK(P0,P1,t) do{}while(0)
  for(;t+5<NT;t+=2){
    STEP(pB0,pB1,pA0,pA1,t,true,true,true);     if(DV==3){asm volatile("s_waitcnt vmcnt(2) lgkmcnt(0)":::"memory");}else{WAIT_BAR(2);} RESC(); ROT();
    STEP(pA0,pA1,pB0,pB1,t+1,true,true,true);   if(DV==3){asm volatile("s_waitcnt vmcnt(2) lgkmcnt(0)":::"memory");}else{WAIT_BAR(2);} RESC(); ROT();
  }
  #undef CMASK
  #define CMASK(P0,P1,t) do{}while(0)
  #define ENDW(tt) do{ if((tt)+3<NT){WAIT_BAR(2);} else if((tt)+2<NT){WAIT_BAR(1);} else {WAIT_BAR(0);} }while(0)
  for(;t+1<NT;t+=2){
    STEP(pB0,pB1,pA0,pA1,t,(t+3<NT),(t+1<NT),(t+1<NT));       ENDW(t);   RESC(); ROT();
    STEP(pA0,pA1,pB0,pB1,t+1,(t+4<NT),(t+2<NT),(t+2<NT));     ENDW(t+1); RESC(); ROT();
  }
  STEP(pB0,pB1,pA0,pA1,NT-1,false,false,false); RESC();
  { float sacc=pB0[0]+pB0[1]; _Pragma("unroll") for(int r=2;r<16;++r)sacc+=pB0[r]; _Pragma("unroll") for(int r=0;r<16;++r)sacc+=pB1[r]; l_reg+=sacc;
    pw0=(u32x4){PKW(pB0,0),PKW(pB0,2),PKW(pB0,4),PKW(pB0,6)};pw1=(u32x4){PKW(pB0,8),PKW(pB0,10),PKW(pB0,12),PKW(pB0,14)};pw2=(u32x4){PKW(pB1,0),PKW(pB1,2),PKW(pB1,4),PKW(pB1,6)};pw3=(u32x4){PKW(pB1,8),PKW(pB1,10),PKW(pB1,12),PKW(pB1,14)};
    SBAR(); pv(o,vb0+sl_cur,PAF(0),PAF(1),PAF(2),PAF(3)); }
  #undef PKW
  #undef PAF
  #undef VFR
  #undef PIN
  #undef MX3
  #undef GAPA
  #undef GAPB
  #undef EX
  #undef VRD
  #undef KRD
  #undef STEP
  #undef ENDW
  {auto rr=__builtin_amdgcn_permlane32_swap(__float_as_uint(l_reg),__float_as_uint(l_reg),false,false);l_reg=__uint_as_float(rr[0])+__uint_as_float(rr[1]);}
  if(lse_out!=nullptr&&hi==0)lse_out[wid*QBLK+r32]=mhat+__log2f(l_reg);
  if(hi==0)wsf[32+r32]=l_reg;asm volatile("s_waitcnt lgkmcnt(0)":::"memory");
  float rli[16];
  #pragma unroll
  for(int r=0;r<16;++r)rli[r]=__builtin_amdgcn_rcpf(wsf[32+crow(r,hi)]);
  bf16*Ow=Ou+(long)(wid*QBLK)*OP;
  { bf16*stg=(bf16*)(shm+LDS_OST)+wid*2048;
    #pragma unroll
    for(int r=0;r<16;++r){const int orow=crow(r,hi);
      #pragma unroll
      for(int d0=0;d0<2;++d0)stg[orow*64+d0*32+r32]=__float2bfloat16(o[d0][r]*rli[r]);}
    asm volatile("s_waitcnt lgkmcnt(0)":::"memory");
    #pragma unroll
    for(int i=0;i<4;++i){const int row=i*8+(lane>>3),ch=lane&7; const u32x4 v=*(const u32x4*)(stg+row*64+ch*8); ATTN_STORE16(Ow+(long)row*OP+ch*8,v);} }
  asm volatile("s_waitcnt lgkmcnt(0)\n\ts_barrier":::"memory");
  #undef DMA_K
  #undef DMA_V
  #undef CMASK
  #undef START
  #undef RESC
  #undef ROT
}
constexpr int ATTN_LDS_BYTES=LDS_BYTES;
#undef SBAR
#undef WAIT_BAR
}

#define XLAS __attribute__((address_space(3)))
#define XB_TMO      128
#define XB_XCNT(j)  (256  + 64 * (j))
#define XB_XSUB(j)  (1280 + 64 * (j))
#define XB_XGEN(j)  (2304 + 64 * (j))
#define XB_TOP      3328
#define XB_TOPGEN   3392
#define XCD_BAR_WORDS 3456
#define XB_SPIN_CAP (1u << 18)

__device__ __forceinline__ unsigned xb_ld(unsigned* p)              { return __hip_atomic_load(p, __ATOMIC_RELAXED, __HIP_MEMORY_SCOPE_AGENT); }
__device__ __forceinline__ unsigned xb_add(unsigned* p, unsigned v) { return __hip_atomic_fetch_add(p, v, __ATOMIC_RELAXED, __HIP_MEMORY_SCOPE_AGENT); }
__device__ __forceinline__ unsigned xb_xcc_id() { return (unsigned)__builtin_amdgcn_s_getreg((3 << 11) | 20) & 0xFu; }
#define XB_SPIN(cond, bar) do { unsigned _sp = 0; while (cond) { __builtin_amdgcn_s_sleep(1); \
    if ((++_sp & 255u) == 0u) { if (xb_ld(&(bar)[XB_TMO])) break; if (_sp > XB_SPIN_CAP) { atomicAdd(&(bar)[XB_TMO], 1u); break; } } } } while (0)

struct XcdBarrier {
    unsigned* bar; unsigned x;
    volatile XLAS unsigned* st;
};

__device__ __forceinline__ XcdBarrier xcd_barrier_post(unsigned* bar, volatile XLAS unsigned* st) {
    XcdBarrier b; b.bar = bar; b.x = xb_xcc_id(); b.st = st;
    if (threadIdx.x == 0) (void)xb_add(&bar[XB_XCNT(b.x)], 1u);
    return b;
}
__device__ __forceinline__ void xcd_barrier_complete(unsigned* bar, unsigned x, unsigned& nloc, unsigned& nx) {
    const unsigned G = gridDim.x * gridDim.y * gridDim.z;
    unsigned sum, cnt, mine, sp = 0u;
    for (;;) {
        sum = 0u; cnt = 0u; mine = 0u;
#pragma unroll
        for (unsigned j = 0; j < 16; ++j) { const unsigned c = xb_ld(&bar[XB_XCNT(j)]); sum += c; cnt += (c > 0u) ? 1u : 0u; mine = (j == x) ? c : mine; }
        if (sum == G) break;
        __builtin_amdgcn_s_sleep(1);
        if ((++sp & 255u) == 0u) { if (xb_ld(&bar[XB_TMO])) break; if (sp > XB_SPIN_CAP) { atomicAdd(&bar[XB_TMO], 1u); break; } }
    }
    nloc = mine > 0u ? mine : 1u; nx = cnt > 0u ? cnt : 1u;
}

__device__ __forceinline__ void xcd_barrier(const XcdBarrier& b) {
    asm volatile("s_waitcnt vmcnt(0)" ::: "memory");
    __syncthreads();
    if (threadIdx.x == 0) {
        unsigned* bar = b.bar;
        __builtin_amdgcn_s_waitcnt(0);
        unsigned nloc = b.st[0], nx = b.st[1];
        if (nloc == 0u) { xcd_barrier_complete(bar, b.x, nloc, nx); b.st[0] = nloc; b.st[1] = nx; }
        const unsigned old = xb_add(&bar[XB_XSUB(b.x)], 1u);
        const unsigned gen = old / nloc;
        if (old + 1u == (gen + 1u) * nloc) {
            __builtin_amdgcn_fence(__ATOMIC_RELEASE, "agent");
            asm volatile("s_waitcnt vmcnt(0)" ::: "memory");
            const unsigned og = xb_add(&bar[XB_TOP], 1u);
            const unsigned tg = og / nx;
            if (og + 1u == (tg + 1u) * nx) xb_add(&bar[XB_TOPGEN], 1u);
            else XB_SPIN(xb_ld(&bar[XB_TOPGEN]) == tg, bar);
            __builtin_amdgcn_fence(__ATOMIC_ACQUIRE, "agent");
            xb_add(&bar[XB_XGEN(b.x)], 1u);
            asm volatile("s_waitcnt vmcnt(0)" ::: "memory");
        } else {
            XB_SPIN(xb_ld(&bar[XB_XGEN(b.x)]) == gen, bar);
            __builtin_amdgcn_fence(__ATOMIC_ACQUIRE, "agent");
            asm volatile("s_waitcnt vmcnt(0)" ::: "memory");
        }
    }
    __syncthreads();
}

constexpr int NWAVES = 8, NTHR = 512;
constexpr int DM = 1024, BATCH = 2, SEQ = 8192, CTXL = 256, NLAT = BATCH * SEQ, NCTX = BATCH * CTXL, NTOK = NLAT + NCTX;
constexpr int DIN = 2320, PN = 2304, PNW = 2560;
constexpr int PC_QKV = 0, PC_K = 768, PC_V = 896, PC_GV = 1024, PC_GG = 1280, PC_Z = 1536, PC_Q = 1792;
constexpr int KVROWS = CTXL + SEQ;
constexpr int NEXP = 32, DEXP = 512, NTILE_MAX = 164, NSLOT_MAX = NTILE_MAX * 256;
constexpr int NSCAN = 16, NSTEP = 132, GDN_ITEM_BYTES = 49152;
constexpr float EPS = 1e-6f;
constexpr float ATT_C2 = 0.125f * 1.4426950408889634f;
constexpr int ATT_NT = 132, ATT_SPLIT_MAIN = 96, ATT_SPLIT_PART = 12;

constexpr size_t MiB = 1u << 20, KiB = 1024;
constexpr size_t WS_CTL = 0, CTL_ZERO_BYTES = 32 * KiB;
constexpr size_t WS_MOD = 1 * MiB;
constexpr size_t WS_ROPE = 1 * MiB + 256 * KiB;
constexpr size_t WS_WGT = 1 * MiB + 320 * KiB;
constexpr size_t WS_WET = 1 * MiB + 512 * KiB;
constexpr size_t WS_GL = 1 * MiB + 768 * KiB;
constexpr size_t WS_WABT = 1 * MiB + 896 * KiB;
constexpr size_t WS_AB = 2 * MiB;
constexpr size_t WS_EID = 4 * MiB;
constexpr size_t WS_WTS = 4 * MiB + 256 * KiB;
constexpr size_t WS_SLOT = 4 * MiB + 512 * KiB;
constexpr size_t WS_STOK = 4 * MiB + 768 * KiB;
constexpr size_t WS_XCTX = 5 * MiB;
constexpr size_t WS_WIN = 6 * MiB;
constexpr size_t WS_WOUT = 17 * MiB;
constexpr size_t WS_WPW = 21 * MiB;
constexpr size_t WS_Q = 22 * MiB;
constexpr size_t WS_K = 39 * MiB, WS_V = 44 * MiB;
constexpr size_t WS_CF = 49 * MiB;
constexpr size_t WS_H = 58 * MiB;
constexpr size_t WS_OG = 92 * MiB;
constexpr size_t WS_P = 134 * MiB;
constexpr size_t WS_PARTO = 209 * MiB;
constexpr size_t WS_PARTL = 315 * MiB;
constexpr size_t WS_GDN = 216 * MiB;
constexpr size_t WS_WGU = 316 * MiB;
constexpr size_t WS_WD = 444 * MiB;
constexpr size_t WS_END = 508 * MiB;
constexpr int CW_CNT = 64;
constexpr int CW_CUR = 192;
constexpr int CW_NT = 320;
constexpr int CW_TE = 384;
constexpr int CW_CQ = 352;
constexpr int CW_BAR = 4096;

constexpr int RING_BYTES = 131072, MISC_OFF = RING_BYTES + 320, LDS_BYTES = 147456;

#define LAS __attribute__((address_space(3)))
typedef unsigned short bf16;
typedef unsigned v4u __attribute__((ext_vector_type(4)));
typedef unsigned v2u __attribute__((ext_vector_type(2)));
typedef float f32x4 __attribute__((ext_vector_type(4)));
typedef float f32x2 __attribute__((ext_vector_type(2)));
typedef short bf16x8 __attribute__((ext_vector_type(8)));
#define LDS_WAIT() asm volatile("s_waitcnt lgkmcnt(0)" ::: "memory")

__device__ __forceinline__ unsigned pk2(float lo, float hi) { return pg8::cvt_pk_bf16(lo, hi); }
__device__ __forceinline__ float bflo(unsigned u) { return __uint_as_float(u << 16); }
__device__ __forceinline__ float bfhi(unsigned u) { return __uint_as_float(u & 0xffff0000u); }
__device__ __forceinline__ f32x4 ld_bf4(const bf16* p) { const v2u w = *(const v2u*)p; return (f32x4){bflo(w.x), bfhi(w.x), bflo(w.y), bfhi(w.y)}; }
__device__ __forceinline__ void st_bf4(bf16* p, f32x4 v) { v2u w; w.x = pk2(v[0], v[1]); w.y = pk2(v[2], v[3]); *(v2u*)p = w; }
template <int CTRL> __device__ __forceinline__ float dpp_f(float v) { return __int_as_float(__builtin_amdgcn_mov_dpp(__float_as_int(v), CTRL, 0xF, 0xF, true)); }
__device__ __forceinline__ float grp16_sum(float v) { v += dpp_f<0xB1>(v); v += dpp_f<0x4E>(v); v += dpp_f<0x141>(v); v += dpp_f<0x140>(v); return v; }
__device__ __forceinline__ float wave_sum(float v) {
    v = grp16_sum(v);
    const int iv = __float_as_int(v);
    return (__int_as_float(__builtin_amdgcn_readlane(iv, 0)) + __int_as_float(__builtin_amdgcn_readlane(iv, 16))) + (__int_as_float(__builtin_amdgcn_readlane(iv, 32)) + __int_as_float(__builtin_amdgcn_readlane(iv, 48)));
}
__device__ __forceinline__ float fsigmoid(float x) { return __builtin_amdgcn_rcpf(1.0f + __builtin_amdgcn_exp2f(-1.4426950408889634f * x)); }
__device__ __forceinline__ float sigmoid_f(float x) { return 1.0f / (1.0f + expf(-x)); }
__device__ __forceinline__ float silu_acc(float x) { return x / (1.0f + expf(-x)); }
__device__ __forceinline__ float softplus_f(float x) { return x > 20.f ? x : log1pf(expf(x)); }
__device__ __forceinline__ float dot4(f32x4 a, f32x4 b) { return (a[0] * b[0] + a[1] * b[1]) + (a[2] * b[2] + a[3] * b[3]); }

struct Frame {
    LAS unsigned char* lds; unsigned char* lds_g;
    int tid, lane, wave, G, vcu, gw, NGW;
    float* out; unsigned char* ws;
};
struct Args { const float* in[30]; float* out; unsigned char* ws; int ph_lo, ph_hi; };
__device__ __forceinline__ void relane(Frame& F) { F.tid = opaque_tid(); F.lane = F.tid & 63; }
template <class T> __device__ __forceinline__ T* wsp(const Frame& F, size_t off) { return (T*)(F.ws + off); }
__device__ __forceinline__ int msel_of(int r) { return r < NLAT ? (r >> 13) : 2; }

__device__ __forceinline__ void tt_load(float (&w)[32], const float* Wt, int ldw, int lane) {
#pragma unroll
    for (int j = 0; j < 8; ++j) { const f32x4 x = __builtin_nontemporal_load((const f32x4*)(Wt + (size_t)(8 * j + (lane >> 3)) * ldw + (lane & 7) * 4)); w[4 * j] = x[0]; w[4 * j + 1] = x[1]; w[4 * j + 2] = x[2]; w[4 * j + 3] = x[3]; }
}
__device__ __forceinline__ void tt_store(const float (&w)[32], bf16* WTt, int ldwt, LAS float* scr, int lane) {
#pragma unroll
    for (int j = 0; j < 8; ++j)
#pragma unroll
        for (int e = 0; e < 4; ++e) scr[(8 * j + (lane >> 3)) * 33 + (lane & 7) * 4 + e] = w[4 * j + e];
    LDS_WAIT(); asm volatile("" ::: "memory");
    const int c = lane & 7;
#pragma unroll
    for (int j = 0; j < 4; ++j) { const int n = (lane >> 3) + 8 * j; const LAS float* s = scr + (8 * c) * 33 + n;
        v4u o; o.x = pk2(s[0 * 33], s[1 * 33]); o.y = pk2(s[2 * 33], s[3 * 33]); o.z = pk2(s[4 * 33], s[5 * 33]); o.w = pk2(s[6 * 33], s[7 * 33]);
        __builtin_nontemporal_store(o, (v4u*)(WTt + (size_t)n * ldwt + 8 * c)); }
    LDS_WAIT(); asm volatile("" ::: "memory");
}
__device__ __forceinline__ void transpose_tile(const float* Wt, int ldw, bf16* WTt, int ldwt, LAS float* scr, int lane) { float w[32]; tt_load(w, Wt, ldw, lane); tt_store(w, WTt, ldwt, scr, lane); }
__device__ __forceinline__ void sincos_d(double x, double& s, double& c) {
    const double TWO_PI_HI = 6.283185307179586232, TWO_PI_LO = 2.449293598294706414e-16;
    const double n = rint(x * 0.15915494309189534561);
    double r = fma(-n, TWO_PI_HI, x); r = fma(-n, TWO_PI_LO, r);
    const double r2 = r * r; double ss = 1.0, cc = 1.0;
#pragma unroll
    for (int k = 15; k >= 1; --k) { ss = 1.0 - ss * r2 * (1.0 / (double)((2 * k) * (2 * k + 1))); cc = 1.0 - cc * r2 * (1.0 / (double)((2 * k - 1) * (2 * k))); }
    s = r * ss; c = cc;
}
__device__ __forceinline__ void p0_prologue(Frame& F, const Args& A) {
    relane(F);
    LAS float* Lf = (LAS float*)F.lds;
    if (blockIdx.x < 192) {
        const int bt = blockIdx.x, l = bt / 96, cgp = bt % 96;
        LAS float* sc = Lf; LAS float* red = Lf + 3072;
        { float cv[6];
#pragma unroll
          for (int m = 0; m < 6; ++m) { const int idx = F.tid + NTHR * m, v = idx >> 10, k = idx & 1023; cv[m] = v < 2 ? A.in[1][v * 1024 + k] : A.in[3][k]; }
#pragma unroll
          for (int m = 0; m < 6; ++m) sc[F.tid + NTHR * m] = silu_acc(cv[m]); }
        __syncthreads();
        const float* mw = A.in[4] + (size_t)l * 1024 * 6144 + 64 * cgp + F.lane;
        float a0 = 0.f, a1 = 0.f, a2 = 0.f;
#pragma unroll 64
        for (int kk = 0; kk < 128; ++kk) { const int k = F.wave * 128 + kk; const float w = __builtin_nontemporal_load(mw + (size_t)k * 6144); a0 += sc[k] * w; a1 += sc[1024 + k] * w; a2 += sc[2048 + k] * w; }
        red[(F.wave * 3 + 0) * 64 + F.lane] = a0; red[(F.wave * 3 + 1) * 64 + F.lane] = a1; red[(F.wave * 3 + 2) * 64 + F.lane] = a2;
        __syncthreads();
        if (F.tid < 192) { const int v = F.tid >> 6, cc = F.tid & 63; float s = A.in[5][l * 6144 + 64 * cgp + cc];
#pragma unroll
            for (int w = 0; w < 8; ++w) s += red[(w * 3 + v) * 64 + cc];
            wsp<float>(F, WS_MOD)[(l * 3 + v) * 6144 + 64 * cgp + cc] = s; }
        __syncthreads();
    }
    {
        const int gt = blockIdx.x * NTHR + F.tid;
        if (gt < 2048) {
            const double INV[16] = {1.0, 5.6234132519034907e-01, 3.1622776601683794e-01, 1.7782794100389229e-01, 1.0e-01, 5.6234132519034911e-02, 3.1622776601683791e-02, 1.7782794100389229e-02,
                                    1.0e-02, 5.6234132519034910e-03, 3.1622776601683794e-03, 1.7782794100389228e-03, 1.0e-03, 5.6234132519034910e-04, 3.1622776601683794e-04, 1.7782794100389227e-04};
            const int pos = gt >> 4, f = gt & 15; double iv = INV[0];
#pragma unroll
            for (int q = 1; q < 16; ++q) iv = (f == q) ? INV[q] : iv;
            const float ang = (float)pos * (float)iv; double s, c; sincos_d((double)ang, s, c);
            float* rt = wsp<float>(F, WS_ROPE); rt[gt * 2] = (float)c; rt[gt * 2 + 1] = (float)s;
        }
        if (gt < 32768) { const int l = gt >> 14, c = (gt >> 10) & 15, k = gt & 1023;
            wsp<bf16>(F, WS_WIN)[((size_t)l * PNW + PN + c) * 1024 + k] = (bf16)(pk2(A.in[8][((size_t)l * 1024 + k) * DIN + 768 + c], 0.f) & 0xffffu); }
        for (int i = gt; i < 2 * 240 * 512; i += F.G * NTHR) { const int l = i / (240 * 512), rem = i % (240 * 512); ((unsigned*)(wsp<bf16>(F, WS_WIN) + ((size_t)l * PNW + PN + 16) * 1024))[rem] = 0u; }
        if (gt < 65536) { const int l = gt >> 15, e = (gt >> 10) & 31, k = gt & 1023; wsp<float>(F, WS_WET)[gt] = A.in[24][((size_t)l * 1024 + k) * 32 + e]; }
        else if (gt < 65536 + 8192) { const int i2 = gt - 65536, l = i2 >> 12, g = (i2 >> 10) & 3, k = i2 & 1023; wsp<float>(F, WS_WGT)[i2] = A.in[22][((size_t)l * 1024 + k) * 4 + g]; }
    }
    LAS float* scr = Lf + F.wave * 2112;
    constexpr int NI_IN = 2 * 16 * 72, NI_OUT = 2 * 16 * 32, NI_PW = 2 * 4 * 8;
    constexpr int NITEMS = NI_IN + NI_OUT + NI_PW;
    bf16* WIN = wsp<bf16>(F, WS_WIN); bf16* WOUT = wsp<bf16>(F, WS_WOUT); bf16* WPW = wsp<bf16>(F, WS_WPW);
    for (int it = F.gw; it < NITEMS; it += F.NGW) {
        int r = it; const float* src; bf16* dst; int ldw, ldwt;
        if (r < NI_IN) { const int l = r / 1152, q = r % 1152, kb = q / 72, nb = q % 72; const int sc = nb < 24 ? 32 * nb : 784 + 32 * (nb - 24), dr = nb < 24 ? 32 * nb : 768 + 32 * (nb - 24);
            src = A.in[8] + ((size_t)l * 1024 + 64 * kb) * DIN + sc; ldw = DIN; dst = WIN + ((size_t)l * PNW + dr) * 1024 + 64 * kb; ldwt = 1024; }
        else if ((r -= NI_IN) < NI_OUT) { const int l = r / 512, q = r % 512, kb = q / 32, nb = q % 32;
            src = A.in[21] + ((size_t)l * 1024 + 64 * kb) * 1024 + 32 * nb; ldw = 1024; dst = WOUT + ((size_t)l * 1024 + 32 * nb) * 1024 + 64 * kb; ldwt = 1024; }
        else { r -= NI_OUT; const int l = r / 32, q = r % 32, kb = q / 8, nb = q % 8;
            src = A.in[13] + ((size_t)l * 256 + 64 * kb) * 256 + 32 * nb; ldw = 256; dst = WPW + ((size_t)l * 256 + 32 * nb) * 256 + 64 * kb; ldwt = 256; }
        transpose_tile(src, ldw, dst, ldwt, scr, F.lane);
    }
}
constexpr int CONV_ITEMS = 32 * 512 + 32 * 256, CONV_CHUNKS = CONV_ITEMS / 32;
__device__ __forceinline__ void convert_pull(Frame& F, const Args& A, int budget, int qlo, int qhi) {
    relane(F);
    LAS float* scr = (LAS float*)F.lds + F.wave * 2112;
    LAS int* box = (LAS int*)(F.lds + RING_BYTES + 8192);
    bf16* WGU = wsp<bf16>(F, WS_WGU); bf16* WD = wsp<bf16>(F, WS_WD); int* ctl = wsp<int>(F, WS_CTL);
    constexpr int NI_GU = 32 * 512;
    for (int kq = 0; kq < budget; ++kq) {
        if (F.tid == 0) { int c = -1, lw = qlo;
            for (; lw <= qhi; ++lw) { c = atomicAdd(ctl + CW_CQ + lw, 1); if (c < CONV_CHUNKS) break; c = -1; }
            box[0] = c; box[1] = lw; }
        __syncthreads();
        const int c = box[0], layer = box[1];
        if (c < 0) break;
#define EXP_ITEM(it_, src, dst, ldw, ldwt) do { int r = (it_); \
        if (r < NI_GU) { const int le = layer * 32 + r / 512, q = r % 512, which = q / 256, q2 = q % 256, kb = q2 / 16, nb = q2 % 16, n0 = 32 * nb, dr = 256 * (n0 >> 7) + (n0 & 127) + 128 * which; \
            src = (which ? A.in[27] : A.in[26]) + ((size_t)le * 1024 + 64 * kb) * 512 + n0; ldw = 512; dst = WGU + ((size_t)le * 1024 + dr) * 1024 + 64 * kb; ldwt = 1024; } \
        else { r -= NI_GU; const int le = layer * 32 + r / 256, q = r % 256, kb = q / 32, nb = q % 32; \
            src = A.in[28] + ((size_t)le * 512 + 64 * kb) * 1024 + 32 * nb; ldw = 1024; dst = WD + ((size_t)le * 1024 + 32 * nb) * 512 + 64 * kb; ldwt = 512; } } while (0)
        const int it0 = c * 32 + F.wave * 4;
        float wc[32], wn[32]; const float* src; bf16* dst; int ldw, ldwt;
        EXP_ITEM(it0, src, dst, ldw, ldwt); tt_load(wc, src, ldw, F.lane);
#pragma unroll 1
        for (int m = 0; m < 4; ++m) {
            const float* src2 = src; bf16* dst2 = dst; int ldw2 = ldw, ldwt2 = ldwt;
            if (m < 3) { EXP_ITEM(it0 + m + 1, src2, dst2, ldw2, ldwt2); tt_load(wn, src2, ldw2, F.lane); }
            tt_store(wc, dst, ldwt, scr, F.lane);
            if (m < 3) {
#pragma unroll
                for (int i = 0; i < 32; ++i) wc[i] = wn[i];
                dst = dst2; ldwt = ldwt2; }
        }
#undef EXP_ITEM
        __syncthreads();
    }
    __syncthreads();
}
__device__ __forceinline__ int my_units(int n, int G, int c) { return c < n ? (n - c + G - 1) / G : 0; }
__device__ __forceinline__ int max_units(int n, int G) { return (n + G - 1) / G; }

#ifndef MK_DRY_AB
#define MK_DRY_AB 1
#endif
#define ROW_RANGE(N_) const int RPW_ = ((N_) + F.NGW - 1) / F.NGW; const int rbeg_ = F.gw * RPW_, rend_ = (rbeg_ + RPW_ < (N_)) ? rbeg_ + RPW_ : (N_);
#define ROW_BATCH_LOOP for (int rb_ = rbeg_; rb_ < rend_; rb_ += 3) { int row[3]; bool valid[3]; _Pragma("unroll") for (int u = 0; u < 3; ++u) { valid[u] = rb_ + u < rend_; row[u] = valid[u] ? rb_ + u : rend_ - 1; }
#define ROW_BATCH_BEGIN(N_) ROW_RANGE(N_) ROW_BATCH_LOOP
#define ROW_BATCH_END }

__device__ __forceinline__ void phase_norm1(Frame& F, const Args& A, int layer, bool dry = false) {
    relane(F);
    const float* mod = wsp<float>(F, WS_MOD) + layer * 3 * 6144;
    const float* g1n = A.in[6] + layer * 1024;
    bf16* H = wsp<bf16>(F, WS_H);
    const float* modp = wsp<float>(F, WS_MOD);
    const int* SLOT = wsp<int>(F, WS_SLOT); const float* WTS = wsp<float>(F, WS_WTS); const bf16* Y = wsp<bf16>(F, WS_GDN);
    f32x4 gn4[4], sc4[4], sh4[4], g24[4]; int msc = -1;
#pragma unroll
    for (int j = 0; j < 4; ++j) gn4[j] = *(const f32x4*)(g1n + 4 * F.lane + 256 * j);
    ROW_RANGE(NTOK)
    int sl_all = 0; float wt_all = 0.f;
    if (layer == 1 && rbeg_ * 2 + F.lane < rend_ * 2) { sl_all = SLOT[rbeg_ * 2 + F.lane]; wt_all = WTS[rbeg_ * 2 + F.lane]; }
    ROW_BATCH_LOOP
        bf16* xr[3]; f32x4 v[3][4];
#pragma unroll
        for (int u = 0; u < 3; ++u) { const int r = row[u];
            if (layer == 0) { const float* xf = r < NLAT ? A.in[0] + (size_t)r * 1024 : A.in[2] + (size_t)(r - NLAT) * 1024; xr[u] = nullptr;
#pragma unroll
                for (int j = 0; j < 4; ++j) v[u][j] = __builtin_nontemporal_load((const f32x4*)(xf + 4 * F.lane + 256 * j)); }
            else { xr[u] = r < NLAT ? (bf16*)F.out + (size_t)r * 1024 : wsp<bf16>(F, WS_XCTX) + (size_t)(r - NLAT) * 1024;
#pragma unroll
                for (int j = 0; j < 4; ++j) v[u][j] = ld_bf4(xr[u] + 4 * F.lane + 256 * j); } }
        if (layer == 1) {
            v2u y0[3][4], y1[3][4]; float w0[3], w1[3];
#pragma unroll
            for (int u = 0; u < 3; ++u) { const int r = row[u]; const int li_ = (r - rbeg_) * 2; const int s0 = __builtin_amdgcn_readlane(sl_all, li_), s1 = __builtin_amdgcn_readlane(sl_all, li_ + 1);
                w0[u] = __int_as_float(__builtin_amdgcn_readlane(__float_as_int(wt_all), li_)); w1[u] = __int_as_float(__builtin_amdgcn_readlane(__float_as_int(wt_all), li_ + 1));
#pragma unroll
                for (int j = 0; j < 4; ++j) { const int k = 4 * F.lane + 256 * j; y0[u][j] = *(const v2u*)(Y + (size_t)s0 * 1024 + k); y1[u][j] = *(const v2u*)(Y + (size_t)s1 * 1024 + k); } }
#pragma unroll
            for (int u = 0; u < 3; ++u) { const float* g2 = modp + msel_of(row[u]) * 6144 + 5120;
#pragma unroll
                for (int j = 0; j < 4; ++j) g24[j] = *(const f32x4*)(g2 + 4 * F.lane + 256 * j);
#pragma unroll
                for (int j = 0; j < 4; ++j) { const int k = 4 * F.lane + 256 * j;
                    const f32x4 a0 = {bflo(y0[u][j].x), bfhi(y0[u][j].x), bflo(y0[u][j].y), bfhi(y0[u][j].y)}, a1 = {bflo(y1[u][j].x), bfhi(y1[u][j].x), bflo(y1[u][j].y), bfhi(y1[u][j].y)};
                    v[u][j] = v[u][j] + g24[j] * (a0 * w0[u] + a1 * w1[u]); if (valid[u] && !dry) st_bf4(xr[u] + k, v[u][j]); } }
        }
        f32x4 hv[3][4];
#pragma unroll
        for (int u = 0; u < 3; ++u) { const int r = row[u], ms = msel_of(r);
            float ss = 0.f;
#pragma unroll
            for (int j = 0; j < 4; ++j) ss += dot4(v[u][j], v[u][j]);
            const float rstd = rsqrtf(wave_sum(ss) * (1.0f / 1024.0f) + EPS);
            if (ms != msc) { msc = ms;
#pragma unroll
                for (int j = 0; j < 4; ++j) { sc4[j] = *(const f32x4*)(mod + ms * 6144 + 1024 + 4 * F.lane + 256 * j); sh4[j] = *(const f32x4*)(mod + ms * 6144 + 4 * F.lane + 256 * j); } }
#pragma unroll
            for (int j = 0; j < 4; ++j) { const int k = 4 * F.lane + 256 * j;
                hv[u][j] = v[u][j] * rstd * gn4[j] * (sc4[j] + 1.0f) + sh4[j]; if (!dry) st_bf4(H + (size_t)r * 1024 + k, hv[u][j]); } }
    ROW_BATCH_END
}

__device__ __forceinline__ void phase_attn_prep(Frame& F, const Args& A, int layer) {
    relane(F);
    const bf16* P = wsp<bf16>(F, WS_P); bf16* Q = wsp<bf16>(F, WS_Q); bf16* K = wsp<bf16>(F, WS_K); bf16* V = wsp<bf16>(F, WS_V);
    const float* rope = wsp<float>(F, WS_ROPE);
    const int hl = F.lane >> 4, li = F.lane & 15, d0 = 4 * li;
    const f32x4 qg = *(const f32x4*)(A.in[19] + layer * 64 + d0), kg = *(const f32x4*)(A.in[20] + layer * 64 + d0);
    const int axis = li >> 3, half = (li >> 2) & 1, f0 = 4 * (li & 3);
    const int kvh = hl & 1; const bool isv = hl >= 2;
    ROW_BATCH_BEGIN(NTOK)
        v2u xq[3][2], xkv[3];
#pragma unroll
        for (int u = 0; u < 3; ++u) { const bf16* pr = P + (size_t)row[u] * PN;
            xq[u][0] = *(const v2u*)(pr + PC_Q + hl * 64 + d0); xq[u][1] = *(const v2u*)(pr + PC_Q + (4 + hl) * 64 + d0); xkv[u] = *(const v2u*)(pr + (isv ? PC_V : PC_K) + kvh * 64 + d0); }
#pragma unroll
        for (int u = 0; u < 3; ++u) { const int r = row[u];
            const bool lat = r < NLAT; const int t = lat ? (r & (SEQ - 1)) : ((r - NLAT) & (CTXL - 1)); const int b = lat ? (r >> 13) : ((r - NLAT) >> 8);
            f32x4 cs = {1.f, 1.f, 1.f, 1.f}, sn = {0.f, 0.f, 0.f, 0.f};
            if (lat) { const int pos = axis ? (t & 63) : (t >> 6); const float* rp = rope + (pos * 16 + f0) * 2;
                const f32x4 r0 = *(const f32x4*)rp, r1 = *(const f32x4*)(rp + 4); cs = (f32x4){r0[0], r0[2], r1[0], r1[2]}; sn = (f32x4){r0[1], r0[3], r1[1], r1[3]}; }
            if (lat || layer == 0) {
#pragma unroll
                for (int it = 0; it < 2; ++it) {
                    const int head = it * 4 + hl;
                    f32x4 x = {bflo(xq[u][it].x), bfhi(xq[u][it].x), bflo(xq[u][it].y), bfhi(xq[u][it].y)};
                    const float rstd = rsqrtf(grp16_sum(dot4(x, x)) * (1.0f / 64.0f) + EPS);
                    x = x * rstd * qg;
                    f32x4 xp; xp[0] = __shfl_xor(x[0], 4); xp[1] = __shfl_xor(x[1], 4); xp[2] = __shfl_xor(x[2], 4); xp[3] = __shfl_xor(x[3], 4);
                    const f32x4 o = half ? (x * cs + xp * sn) : (x * cs - xp * sn);
                    st_bf4(Q + (size_t)r * 512 + head * 64 + d0, o * ATT_C2);
                }
            }
            {
                const f32x4 x = {bflo(xkv[u].x), bfhi(xkv[u].x), bflo(xkv[u].y), bfhi(xkv[u].y)};
                const float rstd = rsqrtf(grp16_sum(dot4(x, x)) * (1.0f / 64.0f) + EPS);
                const f32x4 xk = x * rstd * kg;
                f32x4 xp; xp[0] = __shfl_xor(xk[0], 4); xp[1] = __shfl_xor(xk[1], 4); xp[2] = __shfl_xor(xk[2], 4); xp[3] = __shfl_xor(xk[3], 4);
                const f32x4 ok = half ? (xk * cs + xp * sn) : (xk * cs - xp * sn);
                const size_t krow = (size_t)b * KVROWS + (lat ? CTXL + t : t);
                st_bf4((isv ? V : K) + krow * 128 + kvh * 64 + d0, isv ? x : ok);
            } }
    ROW_BATCH_END
}

__device__ __forceinline__ void phase_conformer(Frame& F, const Args& A, int layer) {
    relane(F);
    LAS float* Gl = (LAS float*)F.lds;
    const bf16* P = wsp<bf16>(F, WS_P); bf16* CF = wsp<bf16>(F, WS_CF);
    const int ntile = layer == 0 ? 264 : 256;
    const int c = F.tid & 255, hf = F.tid >> 8;
    float wv[31];
#pragma unroll
    for (int j = 0; j < 31; ++j) wv[j] = A.in[9][((size_t)layer * 31 + j) * 256 + c];
    const float cb = A.in[10][layer * 256 + c];
    const f32x4 lg = *(const f32x4*)(A.in[11] + layer * 256 + 4 * F.lane), lb = *(const f32x4*)(A.in[12] + layer * 256 + 4 * F.lane);
    const int cskip = F.G > 64 ? 32 : 0;
    for (int tile = (int)blockIdx.x - cskip; tile < ntile; tile += F.G - cskip) {
        if (tile < 0) break;
        int sbase, slen, t0;
        if (tile < 256) { sbase = (tile >> 7) * SEQ; slen = SEQ; t0 = (tile & 127) * 64; } else { const int cc = tile - 256; sbase = NLAT + (cc >> 2) * CTXL; slen = CTXL; t0 = (cc & 3) * 64; }
        {
            v2u gv[12], gg[12];
#pragma unroll
            for (int m = 0; m < 12; ++m) { const int idx = F.tid + NTHR * m, i = idx >> 6, c4 = (idx & 63) * 4, t = t0 - 15 + i; gv[m] = (v2u){0u, 0u}; gg[m] = (v2u){0u, 0u};
                if (i < 94 && t >= 0 && t < slen) { const bf16* pr = P + (size_t)(sbase + t) * PN; gv[m] = *(const v2u*)(pr + PC_GV + c4); gg[m] = *(const v2u*)(pr + PC_GG + c4); } }
#pragma unroll
            for (int m = 0; m < 12; ++m) { const int idx = F.tid + NTHR * m, i = idx >> 6, c4 = (idx & 63) * 4;
                const f32x4 a = {bflo(gv[m].x), bfhi(gv[m].x), bflo(gv[m].y), bfhi(gv[m].y)}, g = {bflo(gg[m].x), bfhi(gg[m].x), bflo(gg[m].y), bfhi(gg[m].y)};
                if (i < 94) *(LAS f32x4*)(Gl + i * 256 + c4) = (f32x4){a[0] * fsigmoid(g[0]), a[1] * fsigmoid(g[1]), a[2] * fsigmoid(g[2]), a[3] * fsigmoid(g[3])}; }
        }
        __syncthreads();
        float o[32];
#pragma unroll
        for (int tt = 0; tt < 32; ++tt) o[tt] = cb;
#pragma unroll
        for (int tb = 0; tb < 4; ++tb) {
            float xw[38];
#pragma unroll
            for (int ii = 0; ii < 38; ++ii) xw[ii] = Gl[(hf * 32 + tb * 8 + ii) * 256 + c];
#pragma unroll
            for (int t8 = 0; t8 < 8; ++t8)
#pragma unroll
                for (int j = 0; j < 31; ++j) o[tb * 8 + t8] += xw[t8 + j] * wv[j];
        }
        __syncthreads();
#pragma unroll
        for (int tt = 0; tt < 32; ++tt) Gl[(hf * 32 + tt) * 256 + c] = o[tt];
        __syncthreads();
#pragma unroll
        for (int q = 0; q < 8; ++q) { const int tok = F.wave * 8 + q; const f32x4 x = *(const LAS f32x4*)(Gl + tok * 256 + 4 * F.lane);
            const float mean = wave_sum((x[0] + x[1]) + (x[2] + x[3])) * (1.0f / 256.0f); const f32x4 d = x - mean;
            const float rstd = rsqrtf(wave_sum(dot4(d, d)) * (1.0f / 256.0f) + EPS);
            f32x4 y = d * rstd * lg + lb; y = (f32x4){pg8::silu_f(y[0]), pg8::silu_f(y[1]), pg8::silu_f(y[2]), pg8::silu_f(y[3])};
            st_bf4(CF + (size_t)(sbase + t0 + tok) * 256 + 4 * F.lane, y); }
        __syncthreads();
    }
}

__device__ __forceinline__ float quad_bcast(float v, int q) { switch (q) { case 0: return dpp_f<0x00>(v); case 1: return dpp_f<0x55>(v); case 2: return dpp_f<0xAA>(v); default: return dpp_f<0xFF>(v); } }
#ifndef MK_GDN_REP
#define MK_GDN_REP -1
#endif
#define GREP(k) ((MK_GDN_REP == (k)) ? 2 : 1)
__device__ __forceinline__ float fexp(float x) { return __builtin_amdgcn_exp2f(x * 1.4426950408889634f); }
#define MFMA16P(a, b, c) __builtin_amdgcn_mfma_f32_16x16x32_bf16(a, b, c, 0, 0, 0)
__device__ __forceinline__ void phase_gdn_prep(Frame& F, const Args& A, int layer) {
    relane(F);
    LAS unsigned char* LB = F.lds;
    LAS float* feat = (LAS float*)LB;
    LAS float* KKm = (LAS float*)(LB + 49920);
    LAS float* QKm = (LAS float*)(LB + 66560);
    LAS float* Am = (LAS float*)(LB + 83200);
    LAS float* sm = (LAS float*)(LB + 115968);
    LAS unsigned char* VT = LB + 118016;
    LAS unsigned char* KT = LB + 133120;
    LAS float* raw = (LAS float*)(LB + 66560);
    LAS float* Tm = KKm;
    LAS unsigned char* Kb = LB + 83200; LAS unsigned char* Qb = LB + 92416;
    LAS unsigned char* TU = LB;
    const bf16* P = wsp<bf16>(F, WS_P); const float* AB = wsp<float>(F, WS_AB);
    unsigned char* GD = F.ws + WS_GDN; float* GLp = wsp<float>(F, WS_GL);
    const float* cw = A.in[15] + (size_t)layer * 5 * 768;
    const int lane = F.lane, wave = F.wave, l15 = lane & 15, g4 = lane >> 4;
    v2u pre[7]; float pa = 0.f, pb = 0.f;
#define GDN_ITEM_GEOM(item_) const int sc = (item_) >> 2, h = (item_) & 3; int b, n, sbase, slen, isctx; \
        if (sc < 256) { b = sc >> 7; n = sc & 127; sbase = b * SEQ; slen = SEQ; isctx = 0; } else { const int cc = sc - 256; b = cc >> 2; n = cc & 3; sbase = NLAT + b * CTXL; slen = CTXL; isctx = 1; } \
        const int t0 = 64 * n;
#define GDN_PREFETCH(item_) do { GDN_ITEM_GEOM(item_) (void)isctx; \
        _Pragma("unroll") for (int m = 0; m < 7; ++m) { const int idx = F.tid + NTHR * m; const int s = idx / (68 * 16), rem = idx % (68 * 16), i = rem >> 4, c4 = (rem & 15) * 4, t = t0 - 2 + i; \
            pre[m] = (v2u){0u, 0u}; if (idx < 3 * 68 * 16 && t >= 0 && t < slen) pre[m] = *(const v2u*)(P + (size_t)(sbase + t) * PN + s * 256 + h * 64 + c4); } \
        if (F.tid < 128) { const int d = F.tid >> 6, i = F.tid & 63, ti = d ? 63 - i : i; const size_t row = (size_t)sbase + t0 + ti; pa = AB[row * 16 + d * 4 + h]; pb = AB[row * 16 + 8 + d * 4 + h]; } } while (0)
    if ((int)blockIdx.x < 264 * 4) GDN_PREFETCH((int)blockIdx.x);
    for (int item = blockIdx.x; item < 264 * 4; item += F.G) {
        GDN_ITEM_GEOM(item) (void)slen;
        float cwr[3][5];
#pragma unroll
        for (int s = 0; s < 3; ++s)
#pragma unroll
            for (int j = 0; j < 5; ++j) cwr[s][j] = cw[j * 768 + s * 256 + h * 64 + (F.tid & 63)];
#pragma unroll
        for (int m = 0; m < 7; ++m) { const int idx = F.tid + NTHR * m; const int s = idx / (68 * 16), rem = idx % (68 * 16), i = rem >> 4, c4 = (rem & 15) * 4;
            if (idx < 3 * 68 * 16) *(LAS f32x4*)(raw + (s * 68 + i) * 64 + c4) = (f32x4){bflo(pre[m].x), bfhi(pre[m].x), bflo(pre[m].y), bfhi(pre[m].y)}; }
        const float ga = pa, gb2 = pb;
        __syncthreads();
        if (item + F.G < 264 * 4) GDN_PREFETCH(item + F.G);
        for (int rp_ = 0; rp_ < GREP(0); ++rp_) {
        { const int c = F.tid & 63, ib = F.tid >> 6;
#pragma unroll
            for (int s = 0; s < 3; ++s) { float xw[12];
#pragma unroll
                for (int ii = 0; ii < 12; ++ii) xw[ii] = raw[(s * 68 + 8 * ib + ii) * 64 + c];
#pragma unroll
                for (int t8 = 0; t8 < 8; ++t8) { float acc = 0.f;
#pragma unroll
                    for (int j = 0; j < 5; ++j) acc += xw[t8 + j] * cwr[s][j];
                    feat[(s * 64 + 8 * ib + t8) * 65 + c] = pg8::silu_f(acc); } } }
        __syncthreads();
        }
        for (int rp_ = 0; rp_ < GREP(1); ++rp_) {
#pragma unroll 4
        for (int q = 0; q < 16; ++q) { const int rid = wave * 16 + q, s = rid >> 6, i = rid & 63; const float x = feat[(s * 64 + i) * 65 + lane];
            const float scl = rsqrtf(wave_sum(x * x) + EPS) * (s == 0 ? 0.125f : 1.0f); feat[(s * 64 + i) * 65 + lane] = x * scl; }
        if (F.tid < 128) { const int d = F.tid >> 6, i = F.tid & 63;
            const float xg = ga + A.in[17][layer * 8 + d * 4 + h];
            float gsum = -fexp(A.in[16][layer * 8 + d * 4 + h]) * (xg > 20.f ? xg : __logf(1.0f + fexp(xg)));
#pragma unroll
            for (int o = 1; o < 64; o <<= 1) { const float up = __shfl_up(gsum, o); if (i >= o) gsum += up; }
            sm[d * 64 + i] = gsum; sm[128 + d * 64 + i] = fsigmoid(gb2); }
        __syncthreads();
        }
        for (int rp_ = 0; rp_ < GREP(2); ++rp_) {
        { const int t = F.tid >> 3, c8 = (F.tid & 7) * 8;
            float x[8];
#pragma unroll
            for (int e = 0; e < 8; ++e) x[e] = feat[(64 + t) * 65 + c8 + e];
            v4u o; o.x = pk2(x[0], x[1]); o.y = pk2(x[2], x[3]); o.z = pk2(x[4], x[5]); o.w = pk2(x[6], x[7]); *(LAS v4u*)(Kb + t * 144 + c8 * 2) = o;
#pragma unroll
            for (int e = 0; e < 8; ++e) x[e] = feat[t * 65 + c8 + e];
            o.x = pk2(x[0], x[1]); o.y = pk2(x[2], x[3]); o.z = pk2(x[4], x[5]); o.w = pk2(x[6], x[7]); *(LAS v4u*)(Qb + t * 144 + c8 * 2) = o;
            const int c = F.tid & 63, t8 = (F.tid >> 6) * 8;
#pragma unroll
            for (int e = 0; e < 8; ++e) x[e] = feat[(64 + t8 + e) * 65 + c];
            o.x = pk2(x[0], x[1]); o.y = pk2(x[2], x[3]); o.z = pk2(x[4], x[5]); o.w = pk2(x[6], x[7]); *(LAS v4u*)(KT + c * 144 + t8 * 2) = o;
#pragma unroll
            for (int e = 0; e < 8; ++e) x[e] = feat[(128 + t8 + e) * 65 + c];
            o.x = pk2(x[0], x[1]); o.y = pk2(x[2], x[3]); o.z = pk2(x[4], x[5]); o.w = pk2(x[6], x[7]); *(LAS v4u*)(VT + c * 144 + t8 * 2) = o; }
        __syncthreads();
        }
        for (int rp_ = 0; rp_ < GREP(3); ++rp_) {
        { const int m = wave >> 2, a = wave & 3; const LAS unsigned char* src = m ? Qb : Kb; LAS float* dst = m ? QKm : KKm;
            const bf16x8 fa0 = *(const LAS bf16x8*)(src + (16 * a + l15) * 144 + 16 * g4), fa1 = *(const LAS bf16x8*)(src + (16 * a + l15) * 144 + 64 + 16 * g4);
#pragma unroll
            for (int bq = 0; bq < 4; ++bq) { const bf16x8 fb0 = *(const LAS bf16x8*)(Kb + (16 * bq + l15) * 144 + 16 * g4), fb1 = *(const LAS bf16x8*)(Kb + (16 * bq + l15) * 144 + 64 + 16 * g4);
                f32x4 acc = MFMA16P(fa0, fb0, ((f32x4){0.f, 0.f, 0.f, 0.f})); acc = MFMA16P(fa1, fb1, acc);
#pragma unroll
                for (int r = 0; r < 4; ++r) dst[(16 * a + 4 * g4 + r) * 65 + 16 * bq + l15] = acc[r]; } }
        __syncthreads();
        }
        for (int rp_ = 0; rp_ < GREP(4); ++rp_) {
#pragma unroll
        for (int d = 0; d < 2; ++d) { const int i = lane, ti = d ? 63 - i : i; const float gi = sm[d * 64 + i], bi_ = sm[128 + d * 64 + i];
#pragma unroll
            for (int k = 0; k < 8; ++k) { const int j = wave + 8 * k, tj = d ? 63 - j : j;
                Am[d * 4096 + j * 64 + i] = (j < i) ? bi_ * KKm[ti * 65 + tj] * fexp(gi - sm[d * 64 + j]) : 0.f; } }
        if (F.tid < 128) sm[256 + F.tid] = sm[128 + F.tid] * fexp(sm[F.tid]);
        __syncthreads();
        }
        for (int rp_ = 0; rp_ < GREP(5); ++rp_) {
        const int ch = F.tid, frg = ch >> 6, itl = frg >> 1, sst = frg & 1, rowx = 16 * itl + l15, kA = 32 * sst + 4 * g4;
#pragma unroll 1
        for (int d = 0; d < 2; ++d) {
            const int step = isctx ? (d ? 3 - n : n) : 4 + (d ? 127 - n : n); const size_t itemid = (size_t)((b * 2 + d) * 4 + h) * NSTEP + step;
            unsigned char* gb = GD + itemid * GDN_ITEM_BYTES;
            const LAS float* gam = sm + d * 64; const float glast = gam[63], grow = gam[rowx], erow = fexp(grow);
            float vq[8], vk[8], vp[8];
#pragma unroll
            for (int j = 0; j < 8; ++j) { const int k = kA + (j & 3) + ((j >> 2) << 4);
                const int trow = d ? 63 - rowx : rowx, tk = d ? 63 - k : k; const float gk = gam[k];
                vq[j] = feat[trow * 65 + k] * erow;
                vk[j] = feat[(64 + tk) * 65 + rowx] * fexp(glast - gk);
                vp[j] = (k <= rowx) ? QKm[trow * 65 + tk] * fexp(grow - gk) : 0.f; }
            v4u o;
            o.x = pk2(vk[0], vk[1]); o.y = pk2(vk[2], vk[3]); o.z = pk2(vk[4], vk[5]); o.w = pk2(vk[6], vk[7]); *(v4u*)(gb + 8192 + ch * 16) = o;
            o.x = pk2(vq[0], vq[1]); o.y = pk2(vq[2], vq[3]); o.z = pk2(vq[4], vq[5]); o.w = pk2(vq[6], vq[7]); *(v4u*)(gb + 16384 + ch * 16) = o;
            o.x = pk2(vp[0], vp[1]); o.y = pk2(vp[2], vp[3]); o.z = pk2(vp[4], vp[5]); o.w = pk2(vp[6], vp[7]); *(v4u*)(gb + 24576 + ch * 16) = o;
            if (F.tid == 0) GLp[itemid] = fexp(glast);
        }
        __syncthreads();
        }
        for (int rp_ = 0; rp_ < GREP(6); ++rp_) {
        { LAS unsigned char* Ab = LB; LAS unsigned char* TTb = LB + 18432; LAS unsigned char* Dfr = LB + 36864;
#pragma unroll
            for (int d = 0; d < 2; ++d)
#pragma unroll
                for (int k = 0; k < 8; ++k) { const int j = wave + 8 * k; *(LAS unsigned short*)(Ab + d * 9216 + lane * 144 + j * 2) = (unsigned short)(pk2(Am[d * 4096 + j * 64 + lane], 0.f) & 0xffffu); }
            for (int idx = F.tid; idx < 2 * 64 * 4; idx += NTHR) { const int d = idx >> 8, col = (idx >> 2) & 63, rb = idx & 3;
                if (rb != (col >> 4)) { *(LAS v4u*)(TTb + d * 9216 + col * 144 + rb * 32) = (v4u){0u, 0u, 0u, 0u}; *(LAS v4u*)(TTb + d * 9216 + col * 144 + rb * 32 + 16) = (v4u){0u, 0u, 0u, 0u}; } }
            { const int d = F.tid >> 8, b = (F.tid >> 6) & 3, cc = (F.tid >> 2) & 15, q = F.tid & 3; const LAS float* At = Am + d * 4096;
                float tb[4];
#pragma unroll
                for (int e = 0; e < 4; ++e) tb[e] = (4 * q + e == cc) ? 1.0f : 0.0f;
#pragma unroll
                for (int rp = 0; rp < 15; ++rp) { const float val = quad_bcast(tb[rp & 3], rp >> 2); const f32x4 a = *(const LAS f32x4*)(At + (16 * b + rp) * 64 + 16 * b + 4 * q);
#pragma unroll
                    for (int e = 0; e < 4; ++e) { const float upd = tb[e] - a[e] * val; tb[e] = (4 * q + e > rp) ? upd : tb[e]; } }
                LAS float* Td = Tm + d * 4160;
#pragma unroll
                for (int e = 0; e < 4; ++e) { const int r = 4 * q + e; Td[(16 * b + r) * 65 + 16 * b + cc] = tb[e];
                    LAS unsigned char* fr = Dfr + (size_t)(((d * 4 + b) * 64 + 16 * (cc >> 2) + r) * 16);
                    *(LAS unsigned short*)(fr + (cc & 3) * 2) = (unsigned short)(pk2(tb[e], 0.f) & 0xffffu);
                    if ((cc & 3) == 0) *(LAS v2u*)(fr + 8) = (v2u){0u, 0u}; }
                v2u o; o.x = pk2(tb[0], tb[1]); o.y = pk2(tb[2], tb[3]);
                *(LAS v2u*)(TTb + d * 9216 + (16 * b + cc) * 144 + (16 * b + 4 * q) * 2) = o; }
            { const int d = wave >> 2, cb = wave & 3; LAS float* Td = Tm + d * 4160;
#pragma unroll
                for (int bi = 0; bi < 3; ++bi) if (bi < cb) {
#pragma unroll
                    for (int r = 0; r < 4; ++r) Td[(16 * bi + 4 * g4 + r) * 65 + 16 * cb + l15] = 0.f; } }
            __syncthreads();
#pragma unroll
            for (int bi = 1; bi < 4; ++bi) {
                const int d = wave >> 2, cb = wave & 3;
                if (cb < bi) {
                    const LAS unsigned char* ap = Ab + d * 9216 + (16 * bi + l15) * 144 + 16 * g4; const LAS unsigned char* tp = TTb + d * 9216 + (16 * cb + l15) * 144 + 16 * g4;
                    f32x4 x = MFMA16P(*(const LAS bf16x8*)ap, *(const LAS bf16x8*)tp, ((f32x4){0.f, 0.f, 0.f, 0.f}));
                    if (bi == 3) x = MFMA16P(*(const LAS bf16x8*)(ap + 64), *(const LAS bf16x8*)(tp + 64), x);
                    v4u yb; yb.x = pk2(-x[0], -x[1]); yb.y = pk2(-x[2], -x[3]); yb.z = 0u; yb.w = 0u;
                    const bf16x8 df = *(const LAS bf16x8*)(Dfr + (size_t)(((d * 4 + bi) * 64 + lane) * 16));
                    const f32x4 tt = MFMA16P(df, __builtin_bit_cast(bf16x8, yb), ((f32x4){0.f, 0.f, 0.f, 0.f}));
                    LAS float* Td = Tm + d * 4160;
#pragma unroll
                    for (int r = 0; r < 4; ++r) Td[(16 * bi + 4 * g4 + r) * 65 + 16 * cb + l15] = tt[r];
                    v2u tw; tw.x = pk2(tt[0], tt[1]); tw.y = pk2(tt[2], tt[3]);
                    *(LAS v2u*)(TTb + d * 9216 + (16 * cb + l15) * 144 + (16 * bi + 4 * g4) * 2) = tw;
                }
                __syncthreads();
            }
        }
        }
        for (int rp_ = 0; rp_ < GREP(7); ++rp_) {
#pragma unroll
        for (int m = 0; m < 2; ++m) { const int q = F.tid + NTHR * m, d = q >> 9, i = (q >> 3) & 63, c8 = (q & 7) * 8; const LAS float* Td = Tm + d * 4160 + i * 65;
            float xu[8], xw[8];
#pragma unroll
            for (int e = 0; e < 8; ++e) { const int ip = d ? 63 - (c8 + e) : c8 + e; const float t = Td[ip]; xu[e] = t * sm[128 + d * 64 + ip]; xw[e] = t * sm[256 + d * 64 + ip]; }
            v4u o; o.x = pk2(xu[0], xu[1]); o.y = pk2(xu[2], xu[3]); o.z = pk2(xu[4], xu[5]); o.w = pk2(xu[6], xu[7]); *(LAS v4u*)(TU + d * 9216 + i * 144 + c8 * 2) = o;
            o.x = pk2(xw[0], xw[1]); o.y = pk2(xw[2], xw[3]); o.z = pk2(xw[4], xw[5]); o.w = pk2(xw[6], xw[7]); *(LAS v4u*)(TU + 18432 + d * 9216 + i * 144 + c8 * 2) = o; }
        __syncthreads();
        }
        for (int rp_ = 0; rp_ < GREP(8); ++rp_) {
        { const int d = wave >> 2, it = wave & 3;
            const int step = isctx ? (d ? 3 - n : n) : 4 + (d ? 127 - n : n); const size_t itemid = (size_t)((b * 2 + d) * 4 + h) * NSTEP + step;
            unsigned char* gb = GD + itemid * GDN_ITEM_BYTES;
            const LAS unsigned char* tu = TU + d * 9216 + (16 * it + l15) * 144 + 16 * g4; const LAS unsigned char* tw = TU + 18432 + d * 9216 + (16 * it + l15) * 144 + 16 * g4;
            const bf16x8 ta0 = *(const LAS bf16x8*)tu, ta1 = *(const LAS bf16x8*)(tu + 64), tw0 = *(const LAS bf16x8*)tw, tw1 = *(const LAS bf16x8*)(tw + 64);
#pragma unroll
            for (int sl = 0; sl < 4; ++sl) { const LAS unsigned char* vp = VT + (16 * sl + l15) * 144 + 16 * g4;
                f32x4 acc = MFMA16P(ta0, *(const LAS bf16x8*)vp, ((f32x4){0.f, 0.f, 0.f, 0.f})); acc = MFMA16P(ta1, *(const LAS bf16x8*)(vp + 64), acc);
                *(f32x4*)(gb + 32768 + (size_t)((it * 4 + sl) * 64 + lane) * 16) = acc; }
#pragma unroll
            for (int sp = 0; sp < 2; ++sp) { const LAS unsigned char* k0 = KT + (16 * (2 * sp) + l15) * 144 + 16 * g4; const LAS unsigned char* k1 = KT + (16 * (2 * sp + 1) + l15) * 144 + 16 * g4;
                f32x4 c0 = MFMA16P(*(const LAS bf16x8*)k0, tw0, ((f32x4){0.f, 0.f, 0.f, 0.f})); c0 = MFMA16P(*(const LAS bf16x8*)(k0 + 64), tw1, c0);
                f32x4 c1 = MFMA16P(*(const LAS bf16x8*)k1, tw0, ((f32x4){0.f, 0.f, 0.f, 0.f})); c1 = MFMA16P(*(const LAS bf16x8*)(k1 + 64), tw1, c1);
                v4u o; o.x = pk2(-c0[0], -c0[1]); o.y = pk2(-c0[2], -c0[3]); o.z = pk2(-c1[0], -c1[1]); o.w = pk2(-c1[2], -c1[3]);
                *(v4u*)(gb + (size_t)((it * 2 + sp) * 64 + lane) * 16) = o; } }
        __syncthreads();
        }
    }
}

#undef GDN_PREFETCH
#undef GDN_ITEM_GEOM
__device__ __forceinline__ bf16x8 pack_tiles(f32x4 t0, f32x4 t1) { v4u o; o.x = pk2(t0[0], t0[1]); o.y = pk2(t0[2], t0[3]); o.z = pk2(t1[0], t1[1]); o.w = pk2(t1[2], t1[3]); return __builtin_bit_cast(bf16x8, o); }
#define MFMA16(a, b, c) __builtin_amdgcn_mfma_f32_16x16x32_bf16(a, b, c, 0, 0, 0)
constexpr int SCAN_SLOT = 20480, SCAN_NSLOT = 6, SCAN_AHEAD = 5, NSCANBLK = NSCAN * 4;
__device__ __forceinline__ void phase_gdn_scan(Frame& F, const Args& A, int layer) {
    relane(F);
    const int xq_ = (int)blockIdx.x >> 3, bd = ((int)blockIdx.x & 7) + 8 * (xq_ >> 2), sl = xq_ & 3, lane = F.lane, wave = F.wave;
    const unsigned char* gbase = F.ws + WS_GDN + (size_t)bd * NSTEP * GDN_ITEM_BYTES;
    unsigned char* svb = F.ws + WS_OG + (size_t)bd * NSTEP * 16384;
    LAS unsigned char* ring = F.lds;
    LAS float* glL = (LAS float*)(F.lds + RING_BYTES + 1024);
    for (int i = F.tid; i < NSTEP; i += NTHR) glL[i] = wsp<float>(F, WS_GL)[bd * NSTEP + i];
    const bool loader = wave >= 1; const int lw = wave - 1;
#define SCAN_ISSUE(stp) do { LAS unsigned char* sb_ = ring + ((stp) % SCAN_NSLOT) * SCAN_SLOT; const unsigned char* gb_ = gbase + (size_t)(stp) * GDN_ITEM_BYTES + lane * 16; \
        _Pragma("unroll") for (int q_ = 0; q_ < 3; ++q_) { const int p0_ = lw * 3 + q_, p_ = p0_ < 20 ? p0_ : 19;   \
            __builtin_amdgcn_global_load_lds((const unsigned*)(gb_ + (p_ < 16 ? p_ * 1024 : 32768 + ((p_ - 16) * 4 + sl) * 1024)), (LAS unsigned*)(sb_ + p_ * 1024), 16, 0, 0); } } while (0)
    if (loader) { SCAN_ISSUE(0); SCAN_ISSUE(1); SCAN_ISSUE(2); SCAN_ISSUE(3); SCAN_ISSUE(4); }
    f32x4 S[4];
#pragma unroll
    for (int j = 0; j < 4; ++j) S[j] = (f32x4){0.f, 0.f, 0.f, 0.f};
    bf16x8 wfA[4][2], kfA[4][2], wfB[4][2], kfB[4][2]; f32x4 vnA[4], vnB[4]; float glA = 0.f, glB = 0.f;
    asm volatile("s_waitcnt lgkmcnt(0)" ::: "memory");
#define SCAN_SYNC(n_) do { if ((n_) < NSTEP) { \
        if (loader) { const int rem = NSTEP - 1 - (n_); \
            if (rem >= 4) asm volatile("s_waitcnt vmcnt(12)" ::: "memory"); else if (rem == 3) asm volatile("s_waitcnt vmcnt(9)" ::: "memory"); else if (rem == 2) asm volatile("s_waitcnt vmcnt(6)" ::: "memory"); \
            else if (rem == 1) asm volatile("s_waitcnt vmcnt(3)" ::: "memory"); else asm volatile("s_waitcnt vmcnt(0)" ::: "memory"); } \
        asm volatile("s_waitcnt lgkmcnt(0)" ::: "memory"); __builtin_amdgcn_s_barrier(); asm volatile("" ::: "memory"); \
        if (loader) { if ((n_) + SCAN_AHEAD < NSTEP) SCAN_ISSUE((n_) + SCAN_AHEAD); } } } while (0)
#define SCAN_READ(n_, WF, KF, VN, GL) do { if ((n_) < NSTEP) { const LAS unsigned char* slot = ring + ((n_) % SCAN_NSLOT) * SCAN_SLOT + lane * 16; \
        _Pragma("unroll") for (int i = 0; i < 4; ++i) { WF[i][0] = *(const LAS bf16x8*)(slot + (i * 2) * 1024); WF[i][1] = *(const LAS bf16x8*)(slot + (i * 2 + 1) * 1024); VN[i] = *(const LAS f32x4*)(slot + 16384 + i * 1024); } \
        _Pragma("unroll") for (int j = 0; j < 4; ++j) { KF[j][0] = *(const LAS bf16x8*)(slot + 8192 + (j * 2) * 1024); KF[j][1] = *(const LAS bf16x8*)(slot + 8192 + (j * 2 + 1) * 1024); } \
        GL = glL[(n_)]; } } while (0)
#define SCAN_COMP(m_, WF, KF, VN, GL) do { \
        const bf16x8 bs0 = pack_tiles(S[0], S[1]), bs1 = pack_tiles(S[2], S[3]); \
        _Pragma("unroll") for (int i = 0; i < 4; ++i) VN[i] = MFMA16(WF[i][0], bs0, VN[i]); \
        _Pragma("unroll") for (int i = 0; i < 4; ++i) VN[i] = MFMA16(WF[i][1], bs1, VN[i]); \
        _Pragma("unroll") for (int j = 0; j < 4; ++j) S[j] = S[j] * GL; \
        const bf16x8 bv0 = pack_tiles(VN[0], VN[1]), bv1 = pack_tiles(VN[2], VN[3]); \
        _Pragma("unroll") for (int j = 0; j < 4; ++j) S[j] = MFMA16(KF[j][0], bv0, S[j]); \
        _Pragma("unroll") for (int j = 0; j < 4; ++j) S[j] = MFMA16(KF[j][1], bv1, S[j]); \
        if (!((m_) < 4 && layer == 1)) { unsigned char* sv = svb + ((size_t)(m_) * 4 + sl) * 4096 + lane * 16; \
            *(bf16x8*)(sv) = bs0; *(bf16x8*)(sv + 1024) = bs1; *(bf16x8*)(sv + 2048) = bv0; *(bf16x8*)(sv + 3072) = bv1; } } while (0)
    SCAN_SYNC(0); if (wave == 0) SCAN_READ(0, wfA, kfA, vnA, glA);
#pragma unroll 1
    for (int n = 1; n <= NSTEP; n += 2) {
        SCAN_SYNC(n);
        if (wave == 0) { SCAN_READ(n, wfB, kfB, vnB, glB); SCAN_COMP(n - 1, wfA, kfA, vnA, glA); }
        SCAN_SYNC(n + 1);
        if (wave == 0) { SCAN_READ(n + 1, wfA, kfA, vnA, glA); SCAN_COMP(n, wfB, kfB, vnB, glB); }
    }
#undef SCAN_SYNC
#undef SCAN_READ
#undef SCAN_COMP
#undef SCAN_ISSUE
    asm volatile("s_waitcnt vmcnt(0) lgkmcnt(0)" ::: "memory");
    __builtin_amdgcn_s_barrier();
    asm volatile("" ::: "memory");
}

__device__ __forceinline__ void phase_gdn_out(Frame& F, const Args& A, int layer) {
    relane(F);
    const int nitems = (layer == 0 ? 264 : 256) * 4;
    LAS float* oL = (LAS float*)F.lds;
    const bf16* P = wsp<bf16>(F, WS_P); bf16* MIX = wsp<bf16>(F, WS_H);
    const unsigned char* GD = F.ws + WS_GDN; const unsigned char* SV = F.ws + WS_OG;
    const int lane = F.lane, d = F.wave >> 2, sl = F.wave & 3;
    for (int item = blockIdx.x; item < nitems; item += F.G) {
        const int sc = item >> 2, h = item & 3;
        int b, n, sbase, isctx;
        if (sc < 256) { b = sc >> 7; n = sc & 127; sbase = b * SEQ; isctx = 0; } else { const int cc = sc - 256; b = cc >> 2; n = cc & 3; sbase = NLAT + b * CTXL; isctx = 1; }
        const int step = isctx ? (d ? 3 - n : n) : 4 + (d ? 127 - n : n); const size_t itemid = (size_t)((b * 2 + d) * 4 + h) * NSTEP + step;
        const unsigned char* gb = GD + itemid * GDN_ITEM_BYTES; const unsigned char* sv = SV + (itemid * 4 + sl) * 4096 + lane * 16;
        bf16x8 qg[4][2], pp[4][2];
#pragma unroll
        for (int i = 0; i < 4; ++i)
#pragma unroll
            for (int s = 0; s < 2; ++s) { qg[i][s] = *(const bf16x8*)(gb + 16384 + ((i * 2 + s) * 64 + lane) * 16); pp[i][s] = *(const bf16x8*)(gb + 24576 + ((i * 2 + s) * 64 + lane) * 16); }
        const bf16x8 bs0 = *(const bf16x8*)(sv), bs1 = *(const bf16x8*)(sv + 1024), bv0 = *(const bf16x8*)(sv + 2048), bv1 = *(const bf16x8*)(sv + 3072);
        const v4u zw = *(const v4u*)(P + ((size_t)sbase + 64 * n + (F.tid >> 3)) * PN + PC_Z + h * 64 + (F.tid & 7) * 8);
#pragma unroll
        for (int i = 0; i < 4; ++i) { f32x4 o = MFMA16(qg[i][0], bs0, ((f32x4){0.f, 0.f, 0.f, 0.f})); o = MFMA16(qg[i][1], bs1, o); o = MFMA16(pp[i][0], bv0, o); o = MFMA16(pp[i][1], bv1, o);
#pragma unroll
            for (int r = 0; r < 4; ++r) { const int c = 16 * i + 4 * (lane >> 4) + r, tr = d ? 63 - c : c; oL[(d * 64 + tr) * 68 + sl * 16 + (lane & 15)] = o[r]; } }
        __syncthreads();
        { const int tok = F.tid >> 3, d8 = (F.tid & 7) * 8; const size_t row = (size_t)sbase + 64 * n + tok;
            const f32x4 a0 = *(const LAS f32x4*)(oL + tok * 68 + d8) + *(const LAS f32x4*)(oL + (64 + tok) * 68 + d8), a1 = *(const LAS f32x4*)(oL + tok * 68 + d8 + 4) + *(const LAS f32x4*)(oL + (64 + tok) * 68 + d8 + 4);
            float ss = dot4(a0, a0) + dot4(a1, a1); ss += __shfl_xor(ss, 1); ss += __shfl_xor(ss, 2); ss += __shfl_xor(ss, 4);
            const float rstd = rsqrtf(ss * (1.0f / 64.0f) + EPS);
            const f32x4 g0 = *(const f32x4*)(A.in[18] + layer * 64 + d8), g1 = *(const f32x4*)(A.in[18] + layer * 64 + d8 + 4);
            const f32x4 z0 = {bflo(zw.x), bfhi(zw.x), bflo(zw.y), bfhi(zw.y)}, z1 = {bflo(zw.z), bfhi(zw.z), bflo(zw.w), bfhi(zw.w)};
            const f32x4 y0 = a0 * rstd * g0 * (f32x4){silu_acc(z0[0]), silu_acc(z0[1]), silu_acc(z0[2]), silu_acc(z0[3])};
            const f32x4 y1 = a1 * rstd * g1 * (f32x4){silu_acc(z1[0]), silu_acc(z1[1]), silu_acc(z1[2]), silu_acc(z1[3])};
            v4u o; o.x = pk2(y0[0], y0[1]); o.y = pk2(y0[2], y0[3]); o.z = pk2(y1[0], y1[1]); o.w = pk2(y1[2], y1[3]);
            *(v4u*)(MIX + row * 1024 + 256 + h * 64 + d8) = o; }
        __syncthreads();
    }
}

__device__ __forceinline__ void phase_attn_merge(Frame& F) {
    relane(F);
    if (F.G != 256) return;
    bf16* MIX = wsp<bf16>(F, WS_H); const bf16* PO = wsp<bf16>(F, WS_PARTO); const float* PL = wsp<float>(F, WS_PARTL);
    for (int q4 = blockIdx.x; q4 < NSCANBLK * 4; q4 += F.G) {
        const int su = q4 >> 2;
        const int vs = (su % 8) * (F.G / 8) + su / 8, U = vs + F.G;
        const int x = (U & 255) >> 5, j = U & 31, i = U >> 8, pair = x >> 1, b = pair >> 1, kvh = pair & 1, head = kvh * 4 + (x & 1) * 2 + i;
        const size_t qrow = (size_t)b * SEQ + (size_t)j * 256;
        const int r = (q4 & 3) * 64 + (F.tid >> 3), d8 = (F.tid & 7) * 8;
        float L[4], w[4]; float lm = -INFINITY;
        bf16* mp = MIX + (qrow + r) * 1024 + 512 + head * 64 + d8;
        f32x4 pv[4][2];
        pv[0][0] = ld_bf4(mp); pv[0][1] = ld_bf4(mp + 4);
#pragma unroll
        for (int p = 0; p < 3; ++p) { const bf16* pp = PO + (((size_t)su * 3 + p) * 256 + r) * 64 + d8; pv[1 + p][0] = ld_bf4(pp); pv[1 + p][1] = ld_bf4(pp + 4); }
#pragma unroll
        for (int p = 0; p < 4; ++p) { L[p] = PL[((size_t)su * 4 + p) * 256 + r]; lm = fmaxf(lm, L[p]); }
        float ws = 0.f;
#pragma unroll
        for (int p = 0; p < 4; ++p) { w[p] = __builtin_amdgcn_exp2f(L[p] - lm); ws += w[p]; }
        const float inv = 1.0f / ws;
        f32x4 a0 = pv[0][0] * (w[0] * inv), a1 = pv[0][1] * (w[0] * inv);
#pragma unroll
        for (int p = 1; p < 4; ++p) { a0 = a0 + pv[p][0] * (w[p] * inv); a1 = a1 + pv[p][1] * (w[p] * inv); }
        st_bf4(mp, a0); st_bf4(mp + 4, a1);
    }
}

__device__ __forceinline__ void phase_route(Frame& F, const Args& A, int layer, bool dry = false) {
    relane(F);
    const int nrows = layer == 0 ? NTOK : NLAT;
    LAS int* hist = (LAS int*)(F.lds + RING_BYTES + 4096);
    if (F.tid < 32) hist[F.tid] = 0;
    const float* mod = wsp<float>(F, WS_MOD) + layer * 3 * 6144; const float* g2n = A.in[7] + layer * 1024;
    const float* WGT = wsp<float>(F, WS_WGT) + layer * 4096; const float* WETg = wsp<float>(F, WS_WET) + layer * 32768;
    LAS float* WET = (LAS float*)F.lds;
    { const unsigned lds0 = (unsigned)(uintptr_t)F.lds_g;
#pragma unroll
        for (int q = 0; q < 16; ++q) { const int piece = F.wave * 16 + q; attn_body::glds16(WETg + piece * 256 + F.lane * 4, (unsigned)__builtin_amdgcn_readfirstlane(lds0 + piece * 1024)); } }
    f32x4 wg[4][4], gn4[4], sc4[4], sh4[4]; int msc = -1;
#pragma unroll
    for (int gi = 0; gi < 4; ++gi)
#pragma unroll
        for (int j = 0; j < 4; ++j) wg[gi][j] = *(const f32x4*)(WGT + gi * 1024 + 4 * F.lane + 256 * j);
#pragma unroll
    for (int j = 0; j < 4; ++j) gn4[j] = *(const f32x4*)(g2n + 4 * F.lane + 256 * j);
    asm volatile("s_waitcnt vmcnt(0)" ::: "memory");
    __syncthreads();
    const float* brg = A.in[23] + layer * 4; const float* bre = A.in[25] + layer * 32;
    bf16* H2 = wsp<bf16>(F, WS_H); int* EID = wsp<int>(F, WS_EID); float* WTS = wsp<float>(F, WS_WTS);
    ROW_BATCH_BEGIN(nrows)
        f32x4 vv[3][4];
#pragma unroll
        for (int u = 0; u < 3; ++u) { const int r = row[u]; const bf16* xr = r < NLAT ? (layer == 0 ? (const bf16*)F.out : wsp<bf16>(F, WS_P)) + (size_t)r * 1024 : wsp<bf16>(F, WS_XCTX) + (size_t)(r - NLAT) * 1024;
#pragma unroll
            for (int j = 0; j < 4; ++j) vv[u][j] = ld_bf4(xr + 4 * F.lane + 256 * j); }
#pragma unroll
        for (int u = 0; u < 3; ++u) { const int r = row[u], ms = msel_of(r);
        f32x4 v[4]; float ss = 0.f;
#pragma unroll
        for (int j = 0; j < 4; ++j) { v[j] = vv[u][j]; ss += dot4(v[j], v[j]); }
        const float rstd = rsqrtf(wave_sum(ss) * (1.0f / 1024.0f) + EPS);
        if (ms != msc) { msc = ms;
#pragma unroll
            for (int j = 0; j < 4; ++j) { sc4[j] = *(const f32x4*)(mod + ms * 6144 + 4096 + 4 * F.lane + 256 * j); sh4[j] = *(const f32x4*)(mod + ms * 6144 + 3072 + 4 * F.lane + 256 * j); } }
#pragma unroll
        for (int j = 0; j < 4; ++j) { const int k = 4 * F.lane + 256 * j;
            v[j] = v[j] * rstd * gn4[j] * (sc4[j] + 1.0f) + sh4[j];
            if (!dry) st_bf4(H2 + (size_t)r * 1024 + k, v[j]); }
        float lg[4];
#pragma unroll
        for (int gi = 0; gi < 4; ++gi) { float a = 0.f;
#pragma unroll
            for (int j = 0; j < 4; ++j) a += dot4(v[j], wg[gi][j]);
            lg[gi] = wave_sum(a) + brg[gi]; }
        int grp = 0; float lmax = lg[0];
#pragma unroll
        for (int gi = 1; gi < 4; ++gi) if (lg[gi] > lmax) { lmax = lg[gi]; grp = gi; }
        float den = 0.f;
#pragma unroll
        for (int gi = 0; gi < 4; ++gi) den += expf(lg[gi] - lmax);
        const float pg_sel = 1.0f / den;
        grp = __builtin_amdgcn_readfirstlane(grp);
        float le[8];
#pragma unroll
        for (int e = 0; e < 8; ++e) { float a = 0.f;
#pragma unroll
            for (int j = 0; j < 4; ++j) a += dot4(v[j], *(const LAS f32x4*)(WET + (grp * 8 + e) * 1024 + 4 * F.lane + 256 * j));
            le[e] = wave_sum(a) + bre[grp * 8 + e]; }
        int i1 = 0; float l1 = le[0];
#pragma unroll
        for (int e = 1; e < 8; ++e) if (le[e] > l1) { l1 = le[e]; i1 = e; }
        int i2 = -1; float l2 = -INFINITY;
#pragma unroll
        for (int e = 0; e < 8; ++e) if (e != i1 && le[e] > l2) { l2 = le[e]; i2 = e; }
        const float p2 = expf(l2 - l1), inv = 1.0f / (1.0f + p2);
        if (F.lane == 0 && valid[u] && !dry) { const int e0 = grp * 8 + i1, e1 = grp * 8 + i2; EID[r * 2] = e0; EID[r * 2 + 1] = e1; WTS[r * 2] = pg_sel * inv; WTS[r * 2 + 1] = pg_sel * p2 * inv;
            __hip_atomic_fetch_add(&hist[e0], 1, __ATOMIC_RELAXED, __HIP_MEMORY_SCOPE_WORKGROUP); __hip_atomic_fetch_add(&hist[e1], 1, __ATOMIC_RELAXED, __HIP_MEMORY_SCOPE_WORKGROUP); }
        }
    ROW_BATCH_END
    __syncthreads();
    if (F.tid < 32 && hist[F.tid] != 0) atomicAdd(wsp<int>(F, WS_CTL) + CW_CNT + layer * 32 + F.tid, hist[F.tid]);
}

__device__ __forceinline__ void phase_slots(Frame& F, const Args& A, int layer) {
    relane(F);
    const int nrows = layer == 0 ? NTOK : NLAT;
    LAS int* li = (LAS int*)F.lds;
    int* ctl = wsp<int>(F, WS_CTL);
    if (F.tid < 32) { li[F.tid] = 0; li[32 + F.tid] = 0; }
    if (F.tid < 64) {
        const int e = F.tid & 31; const int c = __hip_atomic_load(ctl + CW_CNT + layer * 32 + e, __ATOMIC_RELAXED, __HIP_MEMORY_SCOPE_AGENT); const int nt = (c + 255) >> 8; int incl = nt;
#pragma unroll
        for (int o = 1; o < 32; o <<= 1) { const int t = __shfl_up(incl, o, 32); if (e >= o) incl += t; }
        const int excl = incl - nt;
        if (F.tid < 32) { li[64 + e] = excl * 256; li[128 + e] = c;
            if (blockIdx.x == 0) { for (int t = 0; t < nt; ++t) ctl[CW_TE + layer * 256 + excl + t] = e; if (e == 31) ctl[CW_NT + layer] = incl; } } }
    __syncthreads();
    const int* EID = wsp<int>(F, WS_EID); int* SLOT = wsp<int>(F, WS_SLOT);
    { const int RPW = (nrows + F.NGW - 1) / F.NGW, r0 = F.gw * RPW, r1 = (r0 + RPW < nrows) ? r0 + RPW : nrows;
      for (int i = r0 * 2 + F.lane; i < r1 * 2; i += 64) __hip_atomic_fetch_add(&li[EID[i]], 1, __ATOMIC_RELAXED, __HIP_MEMORY_SCOPE_WORKGROUP); }
    __syncthreads();
    if (F.tid < 32) li[96 + F.tid] = li[F.tid] ? atomicAdd(ctl + CW_CUR + layer * 32 + F.tid, li[F.tid]) : 0;
    __syncthreads();
    int* STOK = wsp<int>(F, WS_STOK);
    if (blockIdx.x == 0) {
        for (int e = 0; e < 32; ++e) { const int c = li[128 + e]; const int base = li[64 + e], pad = ((c + 255) & ~255);
            for (int s = c + F.tid; s < pad; s += NTHR) STOK[base + s] = 0; } }
    { const int RPW = (nrows + F.NGW - 1) / F.NGW, r0 = F.gw * RPW, r1 = (r0 + RPW < nrows) ? r0 + RPW : nrows;
      for (int i = r0 * 2 + F.lane; i < r1 * 2; i += 64) { const int e = EID[i]; const int slot = li[64 + e] + li[96 + e] + __hip_atomic_fetch_add(&li[32 + e], 1, __ATOMIC_RELAXED, __HIP_MEMORY_SCOPE_WORKGROUP);
          SLOT[i] = slot; STOK[slot] = i >> 1; } }
}

__device__ __forceinline__ void phase_final(Frame& F, const Args& A, bool dry = false) {
    relane(F);
    const float* mod = wsp<float>(F, WS_MOD) + 3 * 6144; const float* gf = A.in[29];
    const int* SLOT = wsp<int>(F, WS_SLOT); const float* WTS = wsp<float>(F, WS_WTS); const bf16* Y = wsp<bf16>(F, WS_GDN);
    f32x4 gf4[4], g24[4]; int msc = -1;
#pragma unroll
    for (int j = 0; j < 4; ++j) gf4[j] = *(const f32x4*)(gf + 4 * F.lane + 256 * j);
    ROW_RANGE(NLAT)
    int sl_all = 0; float wt_all = 0.f;
    if (rbeg_ * 2 + F.lane < rend_ * 2) { sl_all = SLOT[rbeg_ * 2 + F.lane]; wt_all = WTS[rbeg_ * 2 + F.lane]; }
    ROW_BATCH_LOOP
        f32x4 v[3][4]; v2u y0[3][4], y1[3][4]; float w0[3], w1[3];
#pragma unroll
        for (int u = 0; u < 3; ++u) { const int r = row[u]; const bf16* xr = wsp<bf16>(F, WS_P) + (size_t)r * 1024; const int li_ = (r - rbeg_) * 2; const int s0 = __builtin_amdgcn_readlane(sl_all, li_), s1 = __builtin_amdgcn_readlane(sl_all, li_ + 1);
            w0[u] = __int_as_float(__builtin_amdgcn_readlane(__float_as_int(wt_all), li_)); w1[u] = __int_as_float(__builtin_amdgcn_readlane(__float_as_int(wt_all), li_ + 1));
#pragma unroll
            for (int j = 0; j < 4; ++j) { const int k = 4 * F.lane + 256 * j; v[u][j] = ld_bf4(xr + k); y0[u][j] = *(const v2u*)(Y + (size_t)s0 * 1024 + k); y1[u][j] = *(const v2u*)(Y + (size_t)s1 * 1024 + k); } }
#pragma unroll
        for (int u = 0; u < 3; ++u) { const int r = row[u], ms = r >> 13; float* xr = F.out + (size_t)r * 1024; float ss = 0.f;
            if (ms != msc) { msc = ms;
#pragma unroll
                for (int j = 0; j < 4; ++j) g24[j] = *(const f32x4*)(mod + ms * 6144 + 5120 + 4 * F.lane + 256 * j); }
#pragma unroll
            for (int j = 0; j < 4; ++j) { const int k = 4 * F.lane + 256 * j;
                const f32x4 a0 = {bflo(y0[u][j].x), bfhi(y0[u][j].x), bflo(y0[u][j].y), bfhi(y0[u][j].y)}, a1 = {bflo(y1[u][j].x), bfhi(y1[u][j].x), bflo(y1[u][j].y), bfhi(y1[u][j].y)};
                v[u][j] = v[u][j] + g24[j] * (a0 * w0[u] + a1 * w1[u]); ss += dot4(v[u][j], v[u][j]); }
            const float rstd = rsqrtf(wave_sum(ss) * (1.0f / 1024.0f) + EPS);
            if (valid[u] && !dry) {
#pragma unroll
                for (int j = 0; j < 4; ++j) { const int k = 4 * F.lane + 256 * j; *(f32x4*)(xr + k) = v[u][j] * rstd * gf4[j]; } } }
    ROW_BATCH_END
}

#ifndef MK_MULTI
#define MK_MULTI 0
#endif
#ifndef MK_ONLY
#define MK_ONLY -1
#endif
#define EN(c) (MK_ONLY < 0 || MK_ONLY == (c))
#ifndef MK_EXTRA_BARRIERS
#define MK_EXTRA_BARRIERS 0
#endif
#ifndef MK_ATT_DV
#define MK_ATT_DV 0
#endif
#ifndef MK_FORCE_NOMAX
#define MK_FORCE_NOMAX 0
#endif
#ifndef MK_REP_MASK
#define MK_REP_MASK 0
#endif
#define REPS(c) (((MK_REP_MASK >> (c)) & 1) ? 2 : 1)
constexpr int N_PHASES = 22;

__device__ __forceinline__ void phase_mixers(Frame& F, const Args& A, int layer) {
    if (EN(6) && blockIdx.x < NSCANBLK) for (int rep = 0; rep < REPS(6); ++rep) phase_gdn_scan(F, A, layer);
    if (EN(7)) {
        const int M = layer == 0 ? NTOK : NLAT;
        pg8::Gemm g{wsp<bf16>(F, WS_CF), wsp<bf16>(F, WS_WPW) + (size_t)layer * 65536, M, 256, 256, nullptr};
        pg8::StaticOrder S; S.init(M, 256, F.G, (int)blockIdx.x - NSCANBLK);
        pg8::EpiBf16<true> E{wsp<bf16>(F, WS_H), 1024, A.in[14] + layer * 256};
        pg8::gemm_phase<pg8::EpiBf16<true>, pg8::StaticOrder, true, true>(F.lds, g, S, E);
        __syncthreads();
    }
    if (EN(8)) for (int rep = 0; rep < REPS(8); ++rep) {
        using abf = attn_body::bf16;
        const abf* Q = (const abf*)wsp<bf16>(F, WS_Q); const abf* K = (const abf*)wsp<bf16>(F, WS_K); const abf* V = (const abf*)wsp<bf16>(F, WS_V); abf* MIX = (abf*)wsp<bf16>(F, WS_H);
        const bool split_ok = (F.G == 256);
        const float* gqp = A.in[19] + layer * 64; const float* gkp = A.in[20] + layer * 64;
#define ATTN_CALL(OPITCH, ...) do { float M0; { const int l6 = opaque_tid() & 63; float gq = fabsf(gqp[l6]), gk = fabsf(gkp[l6]); \
            _Pragma("unroll") for (int o = 1; o < 64; o <<= 1) { gq = fmaxf(gq, __shfl_xor(gq, o)); gk = fmaxf(gk, __shfl_xor(gk, o)); } \
            M0 = 8.0f * 1.4426950408889634f * gq * gk; } \
        if (MK_FORCE_NOMAX || __builtin_amdgcn_readfirstlane((int)(M0 < 56.0f))) { if (MK_ATT_DV && rep + 1 < REPS(8)) attn_body::attn_unit<8, OPITCH, true, MK_ATT_DV>(__VA_ARGS__, M0); else attn_body::attn_unit<8, OPITCH, true>(__VA_ARGS__, M0); } else attn_body::attn_unit<8, OPITCH, false>(__VA_ARGS__, 0.f); } while (0)
        bf16* PO = wsp<bf16>(F, WS_PARTO); float* PL = wsp<float>(F, WS_PARTL);
        for (int U = F.vcu; U < 512; U += F.G) {
            const int x = (U & 255) >> 5, j = U & 31, i = U >> 8, pair = x >> 1, b = pair >> 1, kvh = pair & 1, head = kvh * 4 + (x & 1) * 2 + i;
            const size_t qrow = (size_t)b * SEQ + (size_t)j * 256;
            const bool split = split_ok && i == 1 && (int)blockIdx.x < NSCANBLK;
            ATTN_CALL(1024, Q + qrow * 512 + head * 64, K + (size_t)b * KVROWS * 128 + kvh * 64, V + (size_t)b * KVROWS * 128 + kvh * 64, MIX + qrow * 1024 + 512 + head * 64,
                                          split ? ATT_SPLIT_MAIN : ATT_NT, (char*)F.lds_g, split ? PL + ((size_t)blockIdx.x * 4) * 256 : nullptr);
        }
        if (split_ok && (int)blockIdx.x >= NSCANBLK) {
            const int hb = (int)blockIdx.x - NSCANBLK, su = hb / 3, part = hb % 3;
            const int vs = (su % 8) * (F.G / 8) + su / 8, U = vs + F.G;
            const int x = (U & 255) >> 5, j = U & 31, i = U >> 8, pair = x >> 1, b = pair >> 1, kvh = pair & 1, head = kvh * 4 + (x & 1) * 2 + i;
            const size_t qrow = (size_t)b * SEQ + (size_t)j * 256; const size_t koff = (size_t)b * KVROWS * 128 + (size_t)(ATT_SPLIT_MAIN + ATT_SPLIT_PART * part) * 64 * 128 + kvh * 64;
            ATTN_CALL(64, Q + qrow * 512 + head * 64, K + koff, V + koff, (abf*)(PO + ((size_t)su * 3 + part) * 256 * 64), ATT_SPLIT_PART, (char*)F.lds_g, PL + ((size_t)su * 4 + 1 + part) * 256);
        }
        if (layer == 0) {
            for (int U = F.vcu; U < 16; U += F.G) {
                const int b = U >> 3, head = U & 7, kvh = head >> 2; const size_t qrow = (size_t)NLAT + (size_t)b * CTXL;
                ATTN_CALL(1024, Q + qrow * 512 + head * 64, K + (size_t)b * KVROWS * 128 + kvh * 64, V + (size_t)b * KVROWS * 128 + kvh * 64, MIX + qrow * 1024 + 512 + head * 64, 4, (char*)F.lds_g, nullptr);
            }
        }
    }
}

__device__ __forceinline__ void run_layer(Frame& F, const Args& A, const XcdBarrier& bar, const int layer, const int lo, const int hi) {
#define RUN(p) (lo <= (p) && (p) < hi)
#define SEAM(p) do { if (RUN(p) && RUN((p) + 1)) { xcd_barrier(bar); } } while (0)
        const int pb = 1 + 10 * layer;
        if (EN(1) && RUN(pb + 0)) for (int rep = 0; rep < REPS(1); ++rep) { phase_norm1(F, A, layer, rep + 1 < REPS(1)); __syncthreads(); }
        SEAM(pb + 0);
        if (EN(2) && RUN(pb + 1)) for (int rep = 0; rep < REPS(2); ++rep) {
            pg8::Gemm g{wsp<bf16>(F, WS_H), wsp<bf16>(F, WS_WIN) + (size_t)layer * PNW * 1024, NTOK, PNW, 1024, nullptr};
            pg8::StaticOrder S; S.init(NTOK, PNW, F.G, (int)blockIdx.x);
            pg8::EpiInProj E{wsp<bf16>(F, WS_P), PN, wsp<float>(F, WS_AB)};
            pg8::gemm_phase<pg8::EpiInProj, pg8::StaticOrder, true, true>(F.lds, g, S, E);
            { const int nu = (NTOK / 256) * (PNW / 256); const int idle = max_units(nu, F.G) - my_units(nu, F.G, (int)blockIdx.x); if (idle > 0) convert_pull(F, A, 2 * idle, 0, 1); }
        }
        SEAM(pb + 1);
        if (RUN(pb + 2)) { if (EN(3)) for (int rep = 0; rep < REPS(3); ++rep) phase_attn_prep(F, A, layer); if (EN(4)) for (int rep = 0; rep < REPS(4); ++rep) phase_conformer(F, A, layer); __syncthreads(); if (EN(5)) for (int rep = 0; rep < REPS(5); ++rep) phase_gdn_prep(F, A, layer); }
        SEAM(pb + 2);
        if (RUN(pb + 3)) phase_mixers(F, A, layer);
        SEAM(pb + 3);
        if (EN(9) && RUN(pb + 4)) { phase_attn_merge(F); for (int rep = 0; rep < REPS(9); ++rep) phase_gdn_out(F, A, layer); }
        SEAM(pb + 4);
        if (EN(10) && RUN(pb + 5)) for (int rep = 0; rep < (layer == 0 ? REPS(10) : 1); ++rep) {
            const int M = layer == 0 ? NTOK : NLAT;
            pg8::Gemm g{wsp<bf16>(F, WS_H), wsp<bf16>(F, WS_WOUT) + (size_t)layer * 1024 * 1024, M, 1024, 1024, nullptr};
            pg8::StaticOrder S; S.init(M, 1024, F.G, (int)blockIdx.x);
            bf16* xb0 = (bf16*)F.out; bf16* xcb = wsp<bf16>(F, WS_XCTX); bf16* xb1 = wsp<bf16>(F, WS_P);
            if (layer == 0) { pg8::EpiResid<true> E{A.in[0], A.in[2], xb0, xcb, wsp<float>(F, WS_MOD) + 2048};
                pg8::gemm_phase<pg8::EpiResid<true>, pg8::StaticOrder, true, true>(F.lds, g, S, E); }
            else { pg8::EpiResid<false> E{xb0, xcb, xb1, xcb, wsp<float>(F, WS_MOD) + 3 * 6144 + 2048};
                pg8::gemm_phase<pg8::EpiResid<false>, pg8::StaticOrder, true, true>(F.lds, g, S, E); }
            { const int nu = (M / 256) * 4; const int idle = max_units(nu, F.G) - my_units(nu, F.G, (int)blockIdx.x); if (idle > 0) convert_pull(F, A, 3 * idle, 0, 1); }
        }
        SEAM(pb + 5);
        if (EN(11) && RUN(pb + 6)) for (int rep = 0; rep < REPS(11); ++rep) { phase_route(F, A, layer, rep + 1 < REPS(11)); __syncthreads(); }
        SEAM(pb + 6);
        if (EN(12) && RUN(pb + 7)) { phase_slots(F, A, layer); __syncthreads(); convert_pull(F, A, CONV_CHUNKS, layer, layer); }
        SEAM(pb + 7);
        if (EN(13) && RUN(pb + 8)) for (int rep = 0; rep < REPS(13); ++rep) {
            const int* ctl = wsp<int>(F, WS_CTL);
            const int nt = __builtin_amdgcn_readfirstlane(__hip_atomic_load(ctl + CW_NT + layer, __ATOMIC_RELAXED, __HIP_MEMORY_SCOPE_AGENT));
            pg8::Gemm g{wsp<bf16>(F, WS_H), wsp<bf16>(F, WS_WGU) + (size_t)layer * 32 * 1024 * 1024, NSLOT_MAX, 32 * 1024, 1024, wsp<int>(F, WS_STOK)};
            pg8::MoeOrder S{ctl + CW_TE + layer * 256, nt, F.G, F.vcu};
            pg8::EpiSwiGLU E{wsp<bf16>(F, WS_OG), 512};
            pg8::gemm_phase<pg8::EpiSwiGLU, pg8::MoeOrder, true, true, true>(F.lds, g, S, E);
            { const int idle = max_units(nt * 4, F.G) - my_units(nt * 4, F.G, F.vcu); if (idle > 0) convert_pull(F, A, 2 * idle, 0, 1); }
        }
        SEAM(pb + 8);
        if (EN(14) && RUN(pb + 9)) for (int rep = 0; rep < REPS(14); ++rep) {
            const int* ctl = wsp<int>(F, WS_CTL);
            const int nt = __builtin_amdgcn_readfirstlane(__hip_atomic_load(ctl + CW_NT + layer, __ATOMIC_RELAXED, __HIP_MEMORY_SCOPE_AGENT));
            pg8::Gemm g{wsp<bf16>(F, WS_OG), wsp<bf16>(F, WS_WD) + (size_t)layer * 32 * 1024 * 512, NSLOT_MAX, 32 * 1024, 512, nullptr};
            pg8::MoeOrder S{ctl + CW_TE + layer * 256, nt, F.G, F.vcu};
            pg8::EpiBf16<false> E{wsp<bf16>(F, WS_GDN), 1024, nullptr};
            pg8::gemm_phase<pg8::EpiBf16<false>, pg8::MoeOrder, true, true>(F.lds, g, S, E);
            { const int idle = max_units(nt * 4, F.G) - my_units(nt * 4, F.G, F.vcu); if (idle > 0) convert_pull(F, A, idle, 0, 1); }
        }
        SEAM(pb + 9);
#undef RUN
#undef SEAM
}

__global__ void __launch_bounds__(NTHR, 2) mk_fwd(const Args A) {
    extern __shared__ __attribute__((aligned(16))) unsigned char lds[];
    Frame F;
    F.lds = (LAS unsigned char*)lds; F.lds_g = lds;
    F.tid = threadIdx.x; F.lane = F.tid & 63; F.wave = __builtin_amdgcn_readfirstlane(F.tid >> 6);
    F.G = gridDim.x; { const int bx = blockIdx.x; F.vcu = (F.G % 8 == 0) ? (bx % 8) * (F.G / 8) + bx / 8 : bx; }
    F.gw = blockIdx.x * NWAVES + F.wave; F.NGW = F.G * NWAVES;
    F.out = A.out; F.ws = A.ws;
    const int lo = A.ph_lo, hi = A.ph_hi;
    for (int u = F.tid; u < (LDS_BYTES - RING_BYTES) / 4; u += NTHR) ((LAS unsigned*)(F.lds + RING_BYTES))[u] = 0u;
    __syncthreads();
    XcdBarrier bar = xcd_barrier_post((unsigned*)(F.ws + WS_CTL) + CW_BAR, (volatile XLAS unsigned*)(F.lds + MISC_OFF + 32));
#define RUN(p) (lo <= (p) && (p) < hi)
#define SEAM(p) do { if (RUN(p) && RUN((p) + 1)) { xcd_barrier(bar); } } while (0)
    if (hi > N_PHASES + 1) cg::this_grid().sync();

    if (EN(0) && RUN(0)) for (int rep = 0; rep < REPS(0); ++rep) { p0_prologue(F, A); __syncthreads(); }
    SEAM(0);
    run_layer(F, A, bar, 0, lo, hi);
    run_layer(F, A, bar, 1, lo, hi);
    for (int xb_ = 0; xb_ < MK_EXTRA_BARRIERS; ++xb_) xcd_barrier(bar);
    if (EN(15) && RUN(21)) for (int rep = 0; rep < REPS(15); ++rep) phase_final(F, A, rep + 1 < REPS(15));
#undef RUN
#undef SEAM
}

extern "C" void kernel_launch(void* const* d_in, const int* in_sizes, int n_in, void* d_out, int out_size, void* d_ws, size_t ws_size, hipStream_t stream) {
    static int grid = 0;
    if (grid == 0) {
        if (n_in != 30 || out_size != NLAT * DM || ws_size < WS_END) { fprintf(stderr, "kernel_launch: unexpected shapes: n_in %d out %d ws %zu (need %zu)\n", n_in, out_size, ws_size, (size_t)WS_END); grid = -1; return; }
        int dev = 0, cus = 0, per_cu = 0;
        hipGetDevice(&dev); hipDeviceGetAttribute(&cus, hipDeviceAttributeMultiprocessorCount, dev);
        if (hipFuncSetAttribute((const void*)mk_fwd, hipFuncAttributeMaxDynamicSharedMemorySize, LDS_BYTES) != hipSuccess) { fprintf(stderr, "kernel_launch: hipFuncSetAttribute failed\n"); grid = -1; return; }
        if (hipOccupancyMaxActiveBlocksPerMultiprocessor(&per_cu, (const void*)mk_fwd, NTHR, LDS_BYTES) != hipSuccess || per_cu < 1) { fprintf(stderr, "kernel_launch: occupancy query says %d blocks per CU\n", per_cu); (void)hipGetLastError(); per_cu = 1; }
        grid = cus;
        fprintf(stderr, "kernel_launch: %d CUs, occupancy %d per CU, grid %d\n", cus, per_cu, grid);
    }
    if (grid < 0) return;
    hipMemsetAsync((char*)d_ws + WS_CTL, 0, CTL_ZERO_BYTES, stream);
    Args a{};
    for (int i = 0; i < 30; ++i) a.in[i] = (const float*)d_in[i];
    a.out = (float*)d_out; a.ws = (unsigned char*)d_ws;
#if MK_MULTI
    for (int p = 0; p < N_PHASES; ++p) { a.ph_lo = p; a.ph_hi = p + 1; hipLaunchKernelGGL(mk_fwd, dim3(grid), dim3(NTHR), LDS_BYTES, stream, a); }
#else
    a.ph_lo = 0; a.ph_hi = N_PHASES;
    void* kargs[] = {&a};
    hipError_t e = hipLaunchCooperativeKernel((const void*)mk_fwd, dim3(grid), dim3(NTHR), kargs, LDS_BYTES, stream);
    if (e != hipSuccess) fprintf(stderr, "kernel_launch: cooperative launch failed: %s (grid %d)\n", hipGetErrorString(e), grid);
#endif
}
```

```cpp
#include <hip/hip_runtime.h>
#include <hip/hip_bf16.h>
#include <hip/hip_cooperative_groups.h>
#include <cstdio>
#include <cstdint>
#include <cmath>
namespace cg = cooperative_groups;
__device__ __forceinline__ int opaque_tid() { int t = threadIdx.x; asm volatile("" : "+v"(t)); return t; }

namespace pg8 {
#define PG8_LAS __attribute__((address_space(3)))
typedef unsigned short bf16_t;
typedef short bf16x8 __attribute__((ext_vector_type(8)));
typedef float f32x4 __attribute__((ext_vector_type(4)));
typedef unsigned u32x4 __attribute__((ext_vector_type(4)));
constexpr int BM = 256, BK = 64, HALF = 128, HTB = HALF * BK * 2  , STAGE_BYTES = 8 * HTB, NXCD = 8, WGM = 8;

__host__ __device__ __forceinline__ int lds_byte(int r, int c) { const int st = (r >> 4) * 2 + (c >> 5), rr = r & 15, cc = c & 31, ob = rr * 64 + cc * 2; return st * 1024 + (ob ^ (((ob >> 9) & 1) << 5)); }
__host__ __device__ __forceinline__ void stage_rc(int b, int& R, int& C) { const int st = b / 1024, sb = b % 1024, swz = sb ^ (((sb >> 9) & 1) << 5); R = (st >> 1) * 16 + swz / 64; C = (st & 1) * 32 + (swz % 64) / 2; }
__host__ __device__ __forceinline__ int perm32(int rho) { const int n = rho >> 4, i = rho & 15; return 8 * (i >> 2) + 4 * n + (i & 3); }

struct Unit { int pm, pn, pc; };
struct Gemm { const bf16_t* A; const bf16_t* Bt; int M, N, K; const int* gather; };

struct StaticOrder {
    int nM, nN, nwg, G, c;
    __host__ __device__ void init(int M, int N, int G_, int c_) { nM = M / BM; nN = N / BM; nwg = nM * nN; G = G_; c = c_; }
    __host__ __device__ bool next(int i, Unit& u) const {
        if (c < 0) return false;
        const long L = (long)i * G + c; if (L >= nwg) return false;
        int wgid = (int)L; { const int q = nwg / NXCD, r = nwg % NXCD, xcd = wgid % NXCD, off = wgid / NXCD; wgid = (xcd < r ? xcd * (q + 1) : r * (q + 1) + (xcd - r) * q) + off; }
        const int nig = WGM * nN, gid = wgid / nig, fm = gid * WGM, gsz = (nM - fm) < WGM ? (nM - fm) : WGM;
        u.pm = fm + ((wgid % nig) % gsz); u.pn = (wgid % nig) / gsz; u.pc = u.pn; return true;
    }
    __device__ __forceinline__ void a_ready(const Unit&) const {}
    __device__ __forceinline__ void done(const Unit&) const {}
};
struct MoeOrder {
    const int* tile_expert; int ntiles, G, c;
    __device__ __forceinline__ bool next(int i, Unit& u) const {
        const long L = (long)i * G + c; if (L >= (long)ntiles * 4) return false;
        const int t = (int)(L >> 2), j = (int)(L & 3);
        const int e = __builtin_amdgcn_readfirstlane(__hip_atomic_load(tile_expert + t, __ATOMIC_RELAXED, __HIP_MEMORY_SCOPE_AGENT));
        u.pm = t; u.pn = e * 4 + j; u.pc = j; return true;
    }
    __device__ __forceinline__ void a_ready(const Unit&) const {}
    __device__ __forceinline__ void done(const Unit&) const {}
};

typedef float f32x2_t __attribute__((ext_vector_type(2))); typedef __bf16 bf16x2_t __attribute__((ext_vector_type(2)));
__device__ __forceinline__ unsigned cvt_pk_bf16(float lo, float hi) { f32x2_t v = {lo, hi}; bf16x2_t b = __builtin_convertvector(v, bf16x2_t); return __builtin_bit_cast(unsigned, b); }

template <bool BIAS> struct EpiBf16 {
    static constexpr bool PERM = true, AFTER_DRAIN = false;
    bf16_t* O; int ldc; const float* bias;
    __device__ __forceinline__ void init(f32x4 (&acc)[2][2][4][2], const Unit& u, int wr, int wc, int fr, int fq) const {
        const int col0 = u.pc * BM + wc * 32 + 8 * fq;
#pragma unroll
        for (int bj = 0; bj < 2; ++bj)
#pragma unroll
            for (int n = 0; n < 2; ++n) { const f32x4 b = BIAS ? *(const f32x4*)(bias + col0 + bj * HALF + 4 * n) : (f32x4){0.f, 0.f, 0.f, 0.f};
#pragma unroll
                for (int ai = 0; ai < 2; ++ai)
#pragma unroll
                    for (int m = 0; m < 4; ++m) acc[ai][bj][m][n] = b; }
    }
    __device__ __forceinline__ void operator()(const f32x4 (&acc)[2][2][4][2], const Unit& u, int wr, int wc, int fr, int fq) const {
        const int row0 = u.pm * BM + wr * 64 + fr; const int col0 = u.pc * BM + wc * 32 + 8 * fq;
#pragma unroll
        for (int ai = 0; ai < 2; ++ai)
#pragma unroll
            for (int m = 0; m < 4; ++m) { bf16_t* rowp = O + (size_t)(row0 + ai * HALF + m * 16) * ldc + col0;
#pragma unroll
                for (int bj = 0; bj < 2; ++bj) { const f32x4 v0 = acc[ai][bj][m][0], v1 = acc[ai][bj][m][1];
                    u32x4 w; w.x = cvt_pk_bf16(v0[0], v0[1]); w.y = cvt_pk_bf16(v0[2], v0[3]); w.z = cvt_pk_bf16(v1[0], v1[1]); w.w = cvt_pk_bf16(v1[2], v1[3]);
                    *(u32x4*)(rowp + bj * HALF) = w; } }
    }
};
__device__ __forceinline__ float silu_f(float x) { return x * __builtin_amdgcn_rcpf(1.0f + __builtin_amdgcn_exp2f(-1.4426950408889634f * x)); }
struct EpiSwiGLU {
    static constexpr bool PERM = true, AFTER_DRAIN = false;
    bf16_t* O; int ldc;
    __device__ __forceinline__ void init(f32x4 (&acc)[2][2][4][2], const Unit&, int, int, int, int) const {
#pragma unroll
        for (int a = 0; a < 2; ++a)
#pragma unroll
            for (int b = 0; b < 2; ++b)
#pragma unroll
                for (int m = 0; m < 4; ++m)
#pragma unroll
                    for (int n = 0; n < 2; ++n) acc[a][b][m][n] = (f32x4){0.f, 0.f, 0.f, 0.f};
    }
    __device__ __forceinline__ void operator()(const f32x4 (&acc)[2][2][4][2], const Unit& u, int wr, int wc, int fr, int fq) const {
        const int row0 = u.pm * BM + wr * 64 + fr; const int col0 = u.pc * HALF + wc * 32 + 8 * fq;
#pragma unroll
        for (int ai = 0; ai < 2; ++ai)
#pragma unroll
            for (int m = 0; m < 4; ++m) { bf16_t* rowp = O + (size_t)(row0 + ai * HALF + m * 16) * ldc + col0;
                const f32x4 g0 = acc[ai][0][m][0], g1 = acc[ai][0][m][1], u0 = acc[ai][1][m][0], u1 = acc[ai][1][m][1];
                u32x4 w; w.x = cvt_pk_bf16(silu_f(g0[0]) * u0[0], silu_f(g0[1]) * u0[1]); w.y = cvt_pk_bf16(silu_f(g0[2]) * u0[2], silu_f(g0[3]) * u0[3]);
                w.z = cvt_pk_bf16(silu_f(g1[0]) * u1[0], silu_f(g1[1]) * u1[1]); w.w = cvt_pk_bf16(silu_f(g1[2]) * u1[2], silu_f(g1[3]) * u1[3]);
                *(u32x4*)rowp = w; }
    }
};
struct EpiInProj {
    static constexpr bool PERM = true, AFTER_DRAIN = false;
    bf16_t* O; int ldc; float* AB;
    __device__ __forceinline__ void init(f32x4 (&acc)[2][2][4][2], const Unit&, int, int, int, int) const {
#pragma unroll
        for (int a = 0; a < 2; ++a)
#pragma unroll
            for (int b = 0; b < 2; ++b)
#pragma unroll
                for (int m = 0; m < 4; ++m)
#pragma unroll
                    for (int n = 0; n < 2; ++n) acc[a][b][m][n] = (f32x4){0.f, 0.f, 0.f, 0.f};
    }
    __device__ __forceinline__ void operator()(const f32x4 (&acc)[2][2][4][2], const Unit& u, int wr, int wc, int fr, int fq) const {
        const int row0 = u.pm * BM + wr * 64 + fr;
        if (u.pc == 9) {
            if (wc == 0 && fq < 2) {
#pragma unroll
                for (int ai = 0; ai < 2; ++ai)
#pragma unroll
                    for (int m = 0; m < 4; ++m) { float* rowp = AB + (size_t)(row0 + ai * HALF + m * 16) * 16 + 8 * fq;
                        *(f32x4*)rowp = acc[ai][0][m][0]; *(f32x4*)(rowp + 4) = acc[ai][0][m][1]; } }
            return; }
        const int col0 = u.pc * BM + wc * 32 + 8 * fq;
#pragma unroll
        for (int ai = 0; ai < 2; ++ai)
#pragma unroll
            for (int m = 0; m < 4; ++m) { bf16_t* rowp = O + (size_t)(row0 + ai * HALF + m * 16) * ldc + col0;
#pragma unroll
                for (int bj = 0; bj < 2; ++bj) { const f32x4 v0 = acc[ai][bj][m][0], v1 = acc[ai][bj][m][1];
                    u32x4 w; w.x = cvt_pk_bf16(v0[0], v0[1]); w.y = cvt_pk_bf16(v0[2], v0[3]); w.z = cvt_pk_bf16(v1[0], v1[1]); w.w = cvt_pk_bf16(v1[2], v1[3]);
                    *(u32x4*)(rowp + bj * HALF) = w; } }
    }
};
template <bool BASE_F32> struct EpiResid {
    static constexpr bool PERM = true, AFTER_DRAIN = false;
    __device__ __forceinline__ void init(f32x4 (&acc)[2][2][4][2], const Unit&, int, int, int, int) const {
#pragma unroll
        for (int a = 0; a < 2; ++a)
#pragma unroll
            for (int b = 0; b < 2; ++b)
#pragma unroll
                for (int m = 0; m < 4; ++m)
#pragma unroll
                    for (int n = 0; n < 2; ++n) acc[a][b][m][n] = (f32x4){0.f, 0.f, 0.f, 0.f};
    }
    const void* base_l; const void* base_c; bf16_t* out_l; bf16_t* out_c; const float* gate;
    __device__ __forceinline__ void operator()(const f32x4 (&acc)[2][2][4][2], const Unit& u, int wr, int wc, int fr, int fq) const {
        const bool isc = u.pm >= 64; const int msel = isc ? 2 : (u.pm >> 5);
        const void* base = isc ? base_c : base_l; bf16_t* out = isc ? out_c : out_l; const int rbase = isc ? (u.pm - 64) * BM : u.pm * BM;
        const float* gp = gate + msel * 6144;
        const int col0 = u.pc * BM + wc * 32 + 8 * fq;
        f32x4 gv[2][2];
#pragma unroll
        for (int bj = 0; bj < 2; ++bj)
#pragma unroll
            for (int n = 0; n < 2; ++n) gv[bj][n] = *(const f32x4*)(gp + col0 + bj * HALF + 4 * n);
#pragma unroll
        for (int ai = 0; ai < 2; ++ai)
#pragma unroll
            for (int m = 0; m < 4; ++m) { const size_t off = (size_t)(rbase + ai * HALF + wr * 64 + m * 16 + fr) * 1024 + col0;
#pragma unroll
                for (int bj = 0; bj < 2; ++bj) { f32x4 b0, b1;
                    if constexpr (BASE_F32) { b0 = __builtin_nontemporal_load((const f32x4*)((const float*)base + off + bj * HALF)); b1 = __builtin_nontemporal_load((const f32x4*)((const float*)base + off + bj * HALF + 4)); }
                    else { const u32x4 w = *(const u32x4*)((const bf16_t*)base + off + bj * HALF);
                        b0 = (f32x4){__uint_as_float(w.x << 16), __uint_as_float(w.x & 0xffff0000u), __uint_as_float(w.y << 16), __uint_as_float(w.y & 0xffff0000u)};
                        b1 = (f32x4){__uint_as_float(w.z << 16), __uint_as_float(w.z & 0xffff0000u), __uint_as_float(w.w << 16), __uint_as_float(w.w & 0xffff0000u)}; }
                    const f32x4 v0 = b0 + gv[bj][0] * acc[ai][bj][m][0], v1 = b1 + gv[bj][1] * acc[ai][bj][m][1];
                    u32x4 o; o.x = cvt_pk_bf16(v0[0], v0[1]); o.y = cvt_pk_bf16(v0[2], v0[3]); o.z = cvt_pk_bf16(v1[0], v1[1]); o.w = cvt_pk_bf16(v1[2], v1[3]);
                    *(u32x4*)(out + off + bj * HALF) = o; } }
    }
};

template <class Epi, class Sched, bool ALIGN_EPI = false, bool SP2 = false, bool GATHER = false>
__device__ __forceinline__ void gemm_phase(PG8_LAS unsigned char* lds, const Gemm g, const Sched& S, const Epi& E) {
    const int tid = opaque_tid(), wid = __builtin_amdgcn_readfirstlane(tid >> 6), lane = tid & 63, wr = wid >> 2, wc = wid & 3, fr = lane & 15, fq = lane >> 4;
    const int K = g.K, nt = K / BK;
    unsigned voffA[2], voffB[2]; int Rr[2], Cc[2];
#pragma unroll
    for (int i = 0; i < 2; ++i) { int R, C; stage_rc(tid * 16 + i * 8192, R, C); const int Rb = Epi::PERM ? ((R & ~31) + perm32(R & 31)) : R; Rr[i] = R; Cc[i] = C;
        voffA[i] = (unsigned)(R * K + C) * 2u; voffB[i] = (unsigned)(Rb * K + C) * 2u; }
    const size_t kstep = (size_t)(BK * 2);
    const size_t hstep = (size_t)HALF * K * 2;
    const size_t tstep = 2 * hstep;
    const unsigned ldsw = (unsigned)wid * 1024u;
    const int aoff = lds_byte(wr * 64 + fr, fq * 8), boff = lds_byte(wc * 32 + fr, fq * 8);
#define PG8_SA(b, h) (((b) * 2 + (h)) * HTB)
#define PG8_SB(b, h) ((4 + (b) * 2 + (h)) * HTB)
#define PG8_STAGE(bufoff, gbase, voff) do { _Pragma("unroll") for (int _i = 0; _i < 2; ++_i) \
        __builtin_amdgcn_global_load_lds((const unsigned*)((const char*)(gbase) + (voff)[_i]), (PG8_LAS unsigned*)(lds + (bufoff) + ldsw + _i * 8192), 16, 0, 0); } while (0)
#define PG8_LDA(dst, b, h) do { _Pragma("unroll") for (int m = 0; m < 4; ++m) _Pragma("unroll") for (int k = 0; k < 2; ++k) dst[m][k] = *(const PG8_LAS bf16x8*)(lds + PG8_SA(b, h) + aoff + m * 2048 + k * 1024); } while (0)
#define PG8_LDB(dst, b, h) do { _Pragma("unroll") for (int n = 0; n < 2; ++n) _Pragma("unroll") for (int k = 0; k < 2; ++k) dst[n][k] = *(const PG8_LAS bf16x8*)(lds + PG8_SB(b, h) + boff + n * 2048 + k * 1024); } while (0)
#define PG8_MMA(ai, bj, At, Bt) do { __builtin_amdgcn_s_setprio(1); _Pragma("unroll") for (int m = 0; m < 4; ++m) _Pragma("unroll") for (int n = 0; n < 2; ++n) _Pragma("unroll") for (int k = 0; k < 2; ++k) \
        acc[ai][bj][m][n] = __builtin_amdgcn_mfma_f32_16x16x32_bf16(Bt[n][k], At[m][k], acc[ai][bj][m][n], 0, 0, 0); __builtin_amdgcn_s_setprio(0); } while (0)
#define PG8_WAIT_V(n) asm volatile("s_waitcnt vmcnt(" #n ")" ::: "memory")
#define PG8_WAIT_L(n) asm volatile("s_waitcnt lgkmcnt(" #n ")" ::: "memory")
#define PG8_BAR __builtin_amdgcn_s_barrier()
#define PG8_SCHED __builtin_amdgcn_sched_barrier(0)
    Unit cur, nxt; int ui = 0;
    if (!S.next(0, cur)) return;
    f32x4 acc[2][2][4][2];
    E.init(acc, cur, wr, wc, fr, fq);
    bf16x8 At[4][2], B0[2][2], B1[2][2];
    const char* cA = GATHER ? (const char*)g.A : (const char*)g.A + (size_t)cur.pm * tstep; const char* cB = (const char*)g.Bt + (size_t)cur.pn * tstep;
    unsigned cv0[2], cv1[2], nv0[2], nv1[2];
#pragma unroll
    for (int i = 0; i < 2; ++i) {
        if constexpr (GATHER) { cv0[i] = (unsigned)(g.gather[cur.pm * BM + Rr[i]] * K + Cc[i]) * 2u; cv1[i] = (unsigned)(g.gather[cur.pm * BM + HALF + Rr[i]] * K + Cc[i]) * 2u; }
        else { cv0[i] = voffA[i]; cv1[i] = voffA[i] + (unsigned)hstep; }
        nv0[i] = cv0[i]; nv1[i] = cv1[i]; }
    S.a_ready(cur);
    if constexpr (SP2) {
        PG8_STAGE(PG8_SB(0, 0), cB, voffB); PG8_STAGE(PG8_SB(0, 1), cB + hstep, voffB); PG8_STAGE(PG8_SA(0, 0), cA, cv0); PG8_STAGE(PG8_SA(0, 1), cA, cv1);
        if (wr == 1) PG8_BAR;
        PG8_WAIT_V(2); PG8_BAR;
        PG8_STAGE(PG8_SB(1, 0), cB + kstep, voffB); PG8_STAGE(PG8_SA(1, 0), cA + kstep, cv0); PG8_STAGE(PG8_SB(1, 1), cB + hstep + kstep, voffB);
        PG8_WAIT_V(6); PG8_BAR;
    } else {
        PG8_STAGE(PG8_SB(0, 0), cB, voffB); PG8_STAGE(PG8_SA(0, 0), cA, cv0); PG8_STAGE(PG8_SB(0, 1), cB + hstep, voffB); PG8_STAGE(PG8_SA(0, 1), cA, cv1);
        if (wr == 1) PG8_BAR;
        PG8_WAIT_V(4); PG8_BAR;
        PG8_STAGE(PG8_SB(1, 0), cB + kstep, voffB); PG8_STAGE(PG8_SA(1, 0), cA + kstep, cv0); PG8_STAGE(PG8_SB(1, 1), cB + hstep + kstep, voffB);
        PG8_WAIT_V(6); PG8_BAR;
    }
    for (;;) {
        const bool has_next = S.next(ui + 1, nxt);
        const char* nA = (has_next && !GATHER) ? (const char*)g.A + (size_t)nxt.pm * tstep : cA; const char* nB = has_next ? (const char*)g.Bt + (size_t)nxt.pn * tstep : cB;
        if constexpr (GATHER) { if (has_next) {
#pragma unroll
            for (int i = 0; i < 2; ++i) { nv0[i] = (unsigned)(g.gather[nxt.pm * BM + Rr[i]] * K + Cc[i]) * 2u; nv1[i] = (unsigned)(g.gather[nxt.pm * BM + HALF + Rr[i]] * K + Cc[i]) * 2u; } } }
        for (int t = 0; t < nt; t += 2) {
            const bool last = (t == nt - 2);
            const char* a1 = cA + (size_t)(t + 1) * kstep;
            const char* a2 = last ? nA : cA + (size_t)(t + 2) * kstep; const char* b2 = last ? nB : cB + (size_t)(t + 2) * kstep;
            const char* a3 = a2 + kstep; const char* b3 = b2 + kstep;
            unsigned sv0[2], sv1[2];
#pragma unroll
            for (int i = 0; i < 2; ++i) { sv0[i] = last ? nv0[i] : cv0[i]; sv1[i] = last ? nv1[i] : cv1[i]; }
            if (last && has_next) S.a_ready(nxt);
            if constexpr (SP2) {
            PG8_LDB(B0, 0, 0); PG8_LDB(B1, 0, 1); PG8_SCHED; PG8_LDA(At, 0, 0); PG8_STAGE(PG8_SA(1, 1), a1, cv1);
            PG8_WAIT_V(8); PG8_WAIT_L(0); PG8_BAR; PG8_MMA(0, 0, At, B0); PG8_MMA(0, 1, At, B1); PG8_BAR; PG8_SCHED;
            PG8_LDA(At, 0, 1); PG8_STAGE(PG8_SB(0, 0), b2, voffB); PG8_STAGE(PG8_SB(0, 1), b2 + hstep, voffB); PG8_STAGE(PG8_SA(0, 0), a2, sv0);
            PG8_WAIT_V(8); PG8_WAIT_L(0); PG8_BAR; PG8_MMA(1, 0, At, B0); PG8_MMA(1, 1, At, B1); PG8_BAR; PG8_SCHED;
            PG8_LDB(B0, 1, 0); PG8_LDB(B1, 1, 1); PG8_SCHED; PG8_LDA(At, 1, 0); PG8_STAGE(PG8_SA(0, 1), a2, sv1);
            PG8_WAIT_V(8); PG8_WAIT_L(0); PG8_BAR; PG8_MMA(0, 0, At, B0); PG8_MMA(0, 1, At, B1); PG8_BAR; PG8_SCHED;
            PG8_LDA(At, 1, 1); PG8_STAGE(PG8_SB(1, 0), b3, voffB); PG8_STAGE(PG8_SB(1, 1), b3 + hstep, voffB); PG8_STAGE(PG8_SA(1, 0), a3, sv0);
            PG8_WAIT_V(8); PG8_WAIT_L(0); PG8_BAR; PG8_MMA(1, 0, At, B0); PG8_MMA(1, 1, At, B1); PG8_BAR; PG8_SCHED;
            } else {
            PG8_LDB(B0, 0, 0); PG8_SCHED; PG8_LDA(At, 0, 0); PG8_STAGE(PG8_SA(1, 1), a1, cv1);
            PG8_WAIT_L(8); PG8_BAR; PG8_WAIT_L(0); PG8_MMA(0, 0, At, B0); PG8_BAR; PG8_SCHED;
            PG8_LDB(B1, 0, 1); PG8_STAGE(PG8_SB(0, 0), b2, voffB);
            PG8_BAR; PG8_WAIT_L(0); PG8_MMA(0, 1, At, B1); PG8_BAR;
            PG8_LDA(At, 0, 1); PG8_STAGE(PG8_SA(0, 0), a2, sv0);
            PG8_BAR; PG8_WAIT_L(0); PG8_MMA(1, 0, At, B0); PG8_BAR; PG8_SCHED;
            PG8_STAGE(PG8_SB(0, 1), b2 + hstep, voffB);
            PG8_WAIT_V(6); PG8_BAR; PG8_MMA(1, 1, At, B1); PG8_BAR;
            PG8_LDB(B0, 1, 0); PG8_SCHED; PG8_LDA(At, 1, 0); PG8_STAGE(PG8_SA(0, 1), a2, sv1);
            PG8_WAIT_L(8); PG8_BAR; PG8_WAIT_L(0); PG8_MMA(0, 0, At, B0); PG8_BAR; PG8_SCHED;
            PG8_LDB(B1, 1, 1); PG8_STAGE(PG8_SB(1, 0), b3, voffB);
            PG8_BAR; PG8_WAIT_L(0); PG8_MMA(0, 1, At, B1); PG8_BAR;
            PG8_LDA(At, 1, 1); PG8_STAGE(PG8_SA(1, 0), a3, sv0);
            PG8_BAR; PG8_WAIT_L(0); PG8_MMA(1, 0, At, B0); PG8_BAR; PG8_SCHED;
            PG8_STAGE(PG8_SB(1, 1), b3 + hstep, voffB);
            PG8_WAIT_V(6); PG8_BAR; PG8_MMA(1, 1, At, B1); PG8_BAR;
            }
        }
        if constexpr (ALIGN_EPI) { if (wr == 0) PG8_BAR; }
        if constexpr (!Epi::AFTER_DRAIN) { E(acc, cur, wr, wc, fr, fq); S.done(cur); }
        if (!has_next) break;
        E.init(acc, nxt, wr, wc, fr, fq);
        cur = nxt; cA = nA; cB = nB; ++ui;
#pragma unroll
        for (int i = 0; i < 2; ++i) { cv0[i] = nv0[i]; cv1[i] = nv1[i]; }
        if constexpr (ALIGN_EPI) { if (wr == 1) PG8_BAR; }
    }
    PG8_WAIT_V(0);
    if constexpr (!ALIGN_EPI) { if (wr == 0) PG8_BAR; }
    PG8_BAR;
    if constexpr (Epi::AFTER_DRAIN) { E.fused(acc, cur, wr, wc, fr, fq, lds, wid, lane); S.done(cur); }
#undef PG8_SA
#undef PG8_SB
#undef PG8_STAGE
#undef PG8_LDA
#undef PG8_LDB
#undef PG8_MMA
#undef PG8_WAIT_V
#undef PG8_WAIT_L
#undef PG8_BAR
#undef PG8_SCHED
}
}
namespace attn_body {
using bf16=__hip_bfloat16;
using bf16x8=__attribute__((ext_vector_type(8)))short;
using s16x4=__attribute__((ext_vector_type(4)))short;
using f32x16=__attribute__((ext_vector_type(16)))float;
using u32x4=__attribute__((ext_vector_type(4)))unsigned;
constexpr int D=64,QP=512,KP=128;
constexpr int NW=8,QBLK=32,QB=QBLK*NW,KVBLK=64;
constexpr int ATTN_UNIT_ROWS=QB;
__device__ __forceinline__ int crow(int r,int hi){return (r&3)+8*(r>>2)+4*hi;}
#define SBAR() __builtin_amdgcn_sched_barrier(0)
__device__ __forceinline__ void cmask(f32x16&p0,f32x16&p1,int jb,int qrel,int hi){
  const float NEG=-INFINITY; int kb=64*jb+4*hi;
  #pragma unroll
  for(int r=0;r<16;++r){int kv=kb+(r&3)+8*(r>>2); if(kv>qrel)p0[r]=NEG; if(kv+32>qrel)p1[r]=NEG;}
}

constexpr int NSLOT=3, SLOTB=8192;
constexpr int LDS_K=0, LDS_V=NSLOT*SLOTB, LDS_WS=2*NSLOT*SLOTB, LDS_OST=LDS_WS+NW*64*4, LDS_BYTES=LDS_OST+NW*4096;
constexpr float C2=0.125f*1.4426950408889634f;
__device__ __forceinline__ void glds16(const void*gsrc,unsigned lds_dst){unsigned keep;
  asm volatile("s_mov_b32 %0, m0\n\ts_mov_b32 m0, %2\n\ts_nop 0\n\tglobal_load_lds_dwordx4 %1, off\n\ts_mov_b32 m0, %0":"=&s"(keep):"v"(gsrc),"s"(lds_dst):"memory");}
__device__ __forceinline__ float max3f(float a,float b,float c){float r;asm("v_max3_f32 %0, %1, %2, %3":"=v"(r):"v"(a),"v"(b),"v"(c));return r;}
__device__ __forceinline__ float max2f(float a,float b){float r;asm("v_max_f32_e32 %0, %1, %2":"=v"(r):"v"(a),"v"(b));return r;}
__device__ __forceinline__ float fadd_s(float a,float b){float r;asm("v_add_f32_e32 %0, %1, %2":"=v"(r):"v"(a),"v"(b));return r;}
__device__ __forceinline__ float fsub_s(float a,float b){float r;asm("v_sub_f32_e32 %0, %1, %2":"=v"(r):"v"(a),"v"(b));return r;}
typedef float f32x2_t __attribute__((ext_vector_type(2))); typedef __bf16 bf16x2_t __attribute__((ext_vector_type(2)));
__device__ __forceinline__ unsigned cvtpk_s(float lo,float hi){f32x2_t v={lo,hi};bf16x2_t b=__builtin_convertvector(v,bf16x2_t);return __builtin_bit_cast(unsigned,b);}
#define WAIT_BAR(N) asm volatile("s_waitcnt vmcnt(" #N ") lgkmcnt(0)\n\ts_barrier":::"memory")

__device__ __forceinline__ void qkt(f32x16&p0,f32x16&p1,const char*Kslot,const bf16x8*qr,const f32x16&negm,int r32,int hi){
  const char*kb=Kslot+hi*1024+r32*16;
  #pragma unroll
  for(int d0=0;d0<4;++d0){
    const bf16x8 b0=*reinterpret_cast<const bf16x8*>(kb+d0*2048);
    const bf16x8 b1=*reinterpret_cast<const bf16x8*>(kb+d0*2048+512);
    if(d0==0){p0=__builtin_amdgcn_mfma_f32_32x32x16_bf16(b0,qr[0],negm,0,0,0);p1=__builtin_amdgcn_mfma_f32_32x32x16_bf16(b1,qr[0],negm,0,0,0);}
    else{p0=__builtin_amdgcn_mfma_f32_32x32x16_bf16(b0,qr[d0],p0,0,0,0);p1=__builtin_amdgcn_mfma_f32_32x32x16_bf16(b1,qr[d0],p1,0,0,0);}}
}
typedef __attribute__((address_space(3))) const char* lds_cptr;
typedef short v4i16_t __attribute__((ext_vector_type(4)));
__device__ __forceinline__ void kload8(bf16x8*kf,lds_cptr kp){
  kf[0]=*(const __attribute__((address_space(3))) bf16x8*)(kp);      kf[1]=*(const __attribute__((address_space(3))) bf16x8*)(kp+512);
  kf[2]=*(const __attribute__((address_space(3))) bf16x8*)(kp+2048); kf[3]=*(const __attribute__((address_space(3))) bf16x8*)(kp+2560);
  kf[4]=*(const __attribute__((address_space(3))) bf16x8*)(kp+4096); kf[5]=*(const __attribute__((address_space(3))) bf16x8*)(kp+4608);
  kf[6]=*(const __attribute__((address_space(3))) bf16x8*)(kp+6144); kf[7]=*(const __attribute__((address_space(3))) bf16x8*)(kp+6656);
}
__device__ __forceinline__ void kload2(bf16x8*kf,lds_cptr kp,int j){ kf[2*j]=*(const __attribute__((address_space(3))) bf16x8*)(kp+j*2048); kf[2*j+1]=*(const __attribute__((address_space(3))) bf16x8*)(kp+j*2048+512); }
__device__ __forceinline__ s16x4 vtr(lds_cptr p){ return __builtin_bit_cast(s16x4,__builtin_amdgcn_ds_read_tr16_b64_v4i16((__attribute__((address_space(3))) v4i16_t*)p)); }
__device__ __forceinline__ float rowmax(const f32x16&p0,const f32x16&p1){
  float a=max3f(p0[0],p0[1],p1[0]),b=max3f(p0[2],p0[3],p1[1]);a=max3f(a,p1[2],p1[3]);
  #pragma unroll
  for(int r=4;r<16;r+=4){a=max3f(a,p0[r],p0[r+1]);b=max3f(b,p0[r+2],p0[r+3]);a=max3f(a,p1[r],p1[r+1]);b=max3f(b,p1[r+2],p1[r+3]);}
  const float m=max2f(a,b);
  auto rr=__builtin_amdgcn_permlane32_swap(__float_as_uint(m),__float_as_uint(m),false,false);
  return max2f(__uint_as_float(rr[0]),__uint_as_float(rr[1]));
}
__device__ __forceinline__ void pv(f32x16*o,int vb,bf16x8 pa0,bf16x8 pa1,bf16x8 pa2,bf16x8 pa3){
  #pragma unroll
  for(int d0=0;d0<2;++d0){s16x4 lo[4],hi[4];
    #pragma unroll
    for(int ks=0;ks<4;++ks){
      asm volatile("ds_read_b64_tr_b16 %0,%1 offset:%c2":"=&v"(lo[ks]):"v"(vb),"i"(d0*4096+ks*1024):"memory");
      asm volatile("ds_read_b64_tr_b16 %0,%1 offset:%c2":"=&v"(hi[ks]):"v"(vb),"i"(d0*4096+ks*1024+512):"memory");}
    asm volatile("s_waitcnt lgkmcnt(0)":::"memory");SBAR();
    #define PK(k) (bf16x8){lo[k][0],lo[k][1],lo[k][2],lo[k][3],hi[k][0],hi[k][1],hi[k][2],hi[k][3]}
    o[d0]=__builtin_amdgcn_mfma_f32_32x32x16_bf16(pa0,PK(0),o[d0],0,0,0);
    o[d0]=__builtin_amdgcn_mfma_f32_32x32x16_bf16(pa1,PK(1),o[d0],0,0,0);
    o[d0]=__builtin_amdgcn_mfma_f32_32x32x16_bf16(pa2,PK(2),o[d0],0,0,0);
    o[d0]=__builtin_amdgcn_mfma_f32_32x32x16_bf16(pa3,PK(3),o[d0],0,0,0);
    #undef PK
  }
}

#ifndef ATTN_STORE16
#define ATTN_STORE16(p,v) (*(u32x4*)(p)=(v))
#endif
template<int THRL,int OP,bool NOMAX,int DV=0> __device__ __forceinline__ void attn_unit(const bf16*Qu,const bf16*Kh,const bf16*Vh,bf16*Ou,const int NT,char*shm,float*lse_out,const float M0){
  const int tid=opaque_tid(),lane=tid&63,r32=lane&31,hi=lane>>5; const int wid=__builtin_amdgcn_readfirstlane(tid>>6);
  const bf16*Qw=Qu+(long)(wid*QBLK)*QP;
  const unsigned lds0=(unsigned)(uintptr_t)shm;
  float*wsf=(float*)(shm+LDS_WS)+wid*64;
  const bf16*ksrc=Kh+(long)lane*KP+wid*8;
  const bf16*vsrc=Vh+(long)(16*(wid&3)+(lane>>2))*KP+(wid>>2)*32+(lane&3)*8;
  const unsigned kdst=lds0+LDS_K+wid*1024, vdst=lds0+LDS_V+wid*1024;
  #define DMA_K(t,slot) glds16(ksrc+(long)(t)*KVBLK*KP,(unsigned)__builtin_amdgcn_readfirstlane(kdst+(slot)))
  #define DMA_V(t,slot) glds16(vsrc+(long)(t)*KVBLK*KP,(unsigned)__builtin_amdgcn_readfirstlane(vdst+(slot)))
  const int vb0=(int)(lds0+LDS_V)+((lane>>4)&1)*32+(lane&3)*8+(4*hi+((lane&15)>>2))*64;
  const char*Kbase=shm+LDS_K; bf16x8 kf[8];
  const lds_cptr shm3=(lds_cptr)shm; const lds_cptr kp0=shm3+LDS_K+hi*1024+r32*16; const lds_cptr vp0=shm3+LDS_V+((lane>>4)&1)*32+(lane&3)*8+(4*hi+((lane&15)>>2))*64;
  DMA_K(0,0);DMA_V(0,0);DMA_K(1,SLOTB);
  bf16x8 qr[4];
  #pragma unroll
  for(int d0=0;d0<4;++d0)qr[d0]=*reinterpret_cast<const bf16x8*>(&Qw[(long)r32*QP+d0*16+hi*8]);
  float mhat=NOMAX?M0:0.f,l_reg=0.f;f32x16 o[2];o[0]=f32x16{};o[1]=f32x16{};f32x16 negm=f32x16{};
  if(NOMAX){_Pragma("unroll") for(int r=0;r<16;++r)negm[r]=-M0;} asm volatile("":"+v"(negm));
  #define CMASK(P0,P1,t) do{}while(0)
  bool resc=false;
  #define START(P0,P1) do{ resc=false; \
    if(!NOMAX){ const float rm=rowmax(P0,P1); const float dl=rm; mhat=fadd_s(mhat,dl); \
      _Pragma("unroll") for(int r=0;r<16;++r){P0[r]=fsub_s(P0[r],dl);P1[r]=fsub_s(P1[r],dl);} \
      _Pragma("unroll") for(int r=0;r<16;++r)negm[r]=-mhat; asm volatile("":"+v"(negm)); } \
    _Pragma("unroll") for(int r=0;r<16;++r)P0[r]=__builtin_amdgcn_exp2f(P0[r]); }while(0)
  #define RESC() do{ if(!NOMAX&&resc){ asm volatile("s_waitcnt lgkmcnt(0)":::"memory"); \
      _Pragma("unroll") for(int d_=0;d_<2;++d_) _Pragma("unroll") for(int r=0;r<16;++r)o[d_][r]*=wsf[crow(r,hi)]; } }while(0)
  f32x16 pA0,pA1,pB0,pB1;
  int sl_prev=0,sl_cur=0,sl_next=SLOTB;
  #define ROT() do{sl_prev=sl_cur;sl_cur=sl_next;sl_next=(sl_next==(NSLOT-1)*SLOTB)?0:sl_next+SLOTB;}while(0)
  DMA_K(2,2*SLOTB);
  WAIT_BAR(3);
  qkt(pA0,pA1,Kbase,qr,negm,r32,hi);asm volatile("s_nop 15\n\ts_nop 7":"+v"(pA0),"+v"(pA1));CMASK(pA0,pA1,0);
  START(pA0,pA1);
  _Pragma("unroll") for(int r=0;r<16;++r)pA1[r]=__builtin_amdgcn_exp2f(pA1[r]);
  WAIT_BAR(0);
  DMA_K(3,0);DMA_V(1,SLOTB);
  ROT();
  kload8(kf,kp0+sl_cur);
  WAIT_BAR(2);
  s16x4 vlo[8],vhi[8]; u32x4 pw0,pw1,pw2,pw3;
  if(DV==5||DV==6){_Pragma("unroll") for(int i=0;i<8;++i){vlo[i]=(s16x4){kf[i][0],kf[i][1],kf[i][2],kf[i][3]};vhi[i]=(s16x4){kf[i][4],kf[i][5],kf[i][6],kf[i][7]};asm volatile("":"+v"(vlo[i]),"+v"(vhi[i]));}}
  #define PKW(P,B) cvtpk_s(P[B],P[B+1])
  #define PAF(k) __builtin_bit_cast(bf16x8,pw##k)
  #define VFR(i) (bf16x8){vlo[i][0],vlo[i][1],vlo[i][2],vlo[i][3],vhi[i][0],vhi[i][1],vhi[i][2],vhi[i][3]}
  #define PIN(x) asm volatile("":"+v"(x))
  #define MX3(a,b,c) __builtin_fmaxf(__builtin_fmaxf((a),(b)),(c))
  #define GAPA(MF,A0,A1,A2,A3,W0,W1,PW) do{ MF; if(DV!=2){sacc+=A0; sacc+=A1; sacc+=A2; sacc+=A3;} PIN(sacc); if(DV!=4){W0; W1;} PIN(PW); SBAR(); }while(0)
  #define EX(v) (DV==1?(v)*0.5f:__builtin_amdgcn_exp2f(v))
  #define GAPB(MF,X,B) do{ if(DV!=9){MF;} X[B]=EX(X[B]); X[B+1]=EX(X[B+1]); X[B+2]=EX(X[B+2]); X[B+3]=EX(X[B+3]); PIN(X); SBAR(); }while(0)
  #define VRD(i) do{ if(DV==5||DV==6)break; vlo[i]=vtr(vp_+(((i)>>2)*4096+((i)&3)*1024)); vhi[i]=vtr(vp_+(((i)>>2)*4096+((i)&3)*1024+512)); }while(0)
  #define KRD(G,j) do{ if((G)&&DV!=5&&DV!=8){ kload2(kf,kp0+sl_next,j); SBAR(); } }while(0)
  #define STEP(C0,C1,P0,P1,t,GK,GV,GL) do{ SBAR(); \
    const lds_cptr vp_=vp0+sl_prev; \
    VRD(0); SBAR(); float sacc=(P0[0]+P0[1]); \
    GAPA(C0=__builtin_amdgcn_mfma_f32_32x32x16_bf16(kf[0],qr[0],negm,0,0,0), P0[2],P0[3],P0[4],P0[5],     pw0[0]=PKW(P0,0), pw0[1]=PKW(P0,2), pw0); \
    VRD(4); SBAR(); GAPA(C1=__builtin_amdgcn_mfma_f32_32x32x16_bf16(kf[1],qr[0],negm,0,0,0), P0[6],P0[7],P0[8],P0[9],     pw0[2]=PKW(P0,4), pw0[3]=PKW(P0,6), pw0); \
    VRD(1); SBAR(); GAPA(C0=__builtin_amdgcn_mfma_f32_32x32x16_bf16(kf[2],qr[1],C0,0,0,0),   P0[10],P0[11],P0[12],P0[13], pw1[0]=PKW(P0,8), pw1[1]=PKW(P0,10), pw1); \
    VRD(5); SBAR(); GAPA(C1=__builtin_amdgcn_mfma_f32_32x32x16_bf16(kf[3],qr[1],C1,0,0,0),   P0[14],P0[15],P1[0],P1[1],   pw1[2]=PKW(P0,12),pw1[3]=PKW(P0,14), pw1); \
    VRD(2); SBAR(); GAPA(C0=__builtin_amdgcn_mfma_f32_32x32x16_bf16(kf[4],qr[2],C0,0,0,0),   P1[2],P1[3],P1[4],P1[5],     pw2[0]=PKW(P1,0), pw2[1]=PKW(P1,2), pw2); \
    VRD(6); SBAR(); GAPA(C1=__builtin_amdgcn_mfma_f32_32x32x16_bf16(kf[5],qr[2],C1,0,0,0),   P1[6],P1[7],P1[8],P1[9],     pw2[2]=PKW(P1,4), pw2[3]=PKW(P1,6), pw2); \
    VRD(3); SBAR(); GAPA(C0=__builtin_amdgcn_mfma_f32_32x32x16_bf16(kf[6],qr[3],C0,0,0,0),   P1[10],P1[11],P1[12],P1[13], pw3[0]=PKW(P1,8), pw3[1]=PKW(P1,10), pw3); \
    VRD(7); SBAR(); GAPA(C1=__builtin_amdgcn_mfma_f32_32x32x16_bf16(kf[7],qr[3],C1,0,0,0),   P1[14],P1[15],0.f,0.f,       pw3[2]=PKW(P1,12),pw3[3]=PKW(P1,14), pw3); \
    l_reg+=sacc; \
    if((GK)&&DV!=7){DMA_K((t)+3,sl_cur);} if((GV)&&DV!=7){DMA_V((t)+1,sl_next);} \
    CMASK(C0,C1,t); \
    if(!NOMAX){ float a=MX3(C0[0],C0[1],C1[0]),b=MX3(C0[2],C0[3],C1[1]); a=MX3(a,C1[2],C1[3]); \
      _Pragma("unroll") for(int r=4;r<16;r+=4){a=MX3(a,C0[r],C0[r+1]);b=MX3(b,C0[r+2],C0[r+3]);a=MX3(a,C1[r],C1[r+1]);b=MX3(b,C1[r+2],C1[r+3]);} \
      float rm=__builtin_fmaxf(a,b); { auto rr=__builtin_amdgcn_permlane32_swap(__float_as_uint(rm),__float_as_uint(rm),false,false); rm=__builtin_fmaxf(__uint_as_float(rr[0]),__uint_as_float(rr[1])); } \
      resc=false; \
      if(__builtin_expect(__any(rm>(float)THRL),0)){ const float dl=__builtin_fmaxf(rm,0.f); mhat+=dl; \
        _Pragma("unroll") for(int r=0;r<16;++r){C0[r]-=dl;C1[r]-=dl;} \
        _Pragma("unroll") for(int r=0;r<16;++r)negm[r]=-mhat; asm volatile("":"+v"(negm)); \
        const float f=__builtin_amdgcn_exp2f(-dl); l_reg*=f; if(hi==0)wsf[r32]=f; resc=true; } } \
    SBAR(); \
    GAPB(o[0]=__builtin_amdgcn_mfma_f32_32x32x16_bf16(PAF(0),VFR(0),o[0],0,0,0), C0,0); \
    GAPB(o[1]=__builtin_amdgcn_mfma_f32_32x32x16_bf16(PAF(0),VFR(4),o[1],0,0,0), C0,4); \
    KRD(GL,0); GAPB(o[0]=__builtin_amdgcn_mfma_f32_32x32x16_bf16(PAF(1),VFR(1),o[0],0,0,0), C0,8); \
    KRD(GL,1); GAPB(o[1]=__builtin_amdgcn_mfma_f32_32x32x16_bf16(PAF(1),VFR(5),o[1],0,0,0), C0,12); \
    KRD(GL,2); GAPB(o[0]=__builtin_amdgcn_mfma_f32_32x32x16_bf16(PAF(2),VFR(2),o[0],0,0,0), C1,0); \
    KRD(GL,3); GAPB(o[1]=__builtin_amdgcn_mfma_f32_32x32x16_bf16(PAF(2),VFR(6),o[1],0,0,0), C1,4); \
    GAPB(o[0]=__builtin_amdgcn_mfma_f32_32x32x16_bf16(PAF(3),VFR(3),o[0],0,0,0), C1,8); \
    GAPB(o[1]=__builtin_amdgcn_mfma_f32_32x32x16_bf16(PAF(3),VFR(7),o[1],0,0,0), C1,12); \
    }while(0)
  int t=1;
  #undef CMASK
  #define CMASK(P0,P1,t) do{}while(0)
  for(;t+5<NT;t+=2){
    STEP(pB0,pB1,pA0,pA1,t,true,true,true);     if(DV==3){asm volatile("s_waitcnt vmcnt(2) lgkmcnt(0)":::"memory");}else{WAIT_BAR(2);} RESC(); ROT();
    STEP(pA0,pA1,pB0,pB1,t+1,true,true,true);   if(DV==3){asm volatile("s_waitcnt vmcnt(2) lgkmcnt(0)":::"memory");}else{WAIT_BAR(2);} RESC(); ROT();
  }
  #undef CMASK
  #define CMASK(P0,P1,t) do{}while(0)
  #define ENDW(tt) do{ if((tt)+3<NT){WAIT_BAR(2);} else if((tt)+2<NT){WAIT_BAR(1);} else {WAIT_BAR(0);} }while(0)
  for(;t+1<NT;t+=2){
    STEP(pB0,pB1,pA0,pA1,t,(t+3<NT),(t+1<NT),(t+1<NT));       ENDW(t);   RESC(); ROT();
    STEP(pA0,pA1,pB0,pB1,t+1,(t+4<NT),(t+2<NT),(t+2<NT));     ENDW(t+1); RESC(); ROT();
  }
  STEP(pB0,pB1,pA0,pA1,NT-1,false,false,false); RESC();
  { float sacc=pB0[0]+pB0[1]; _Pragma("unroll") for(int r=2;r<16;++r)sacc+=pB0[r]; _Pragma("unroll") for(int r=0;r<16;++r)sacc+=pB1[r]; l_reg+=sacc;
    pw0=(u32x4){PKW(pB0,0),PKW(pB0,2),PKW(pB0,4),PKW(pB0,6)};pw1=(u32x4){PKW(pB0,8),PKW(pB0,10),PKW(pB0,12),PKW(pB0,14)};pw2=(u32x4){PKW(pB1,0),PKW(pB1,2),PKW(pB1,4),PKW(pB1,6)};pw3=(u32x4){PKW(pB1,8),PKW(pB1,10),PKW(pB1,12),PKW(pB1,14)};
    SBAR(); pv(o,vb0+sl_cur,PAF(0),PAF(1),PAF(2),PAF(3)); }
  #undef PKW
  #undef PAF
  #undef VFR
  #undef PIN
  #undef MX3
  #undef GAPA
  #undef GAPB
  #undef EX
  #undef VRD
  #undef KRD
  #undef STEP
  #undef ENDW
  {auto rr=__builtin_amdgcn_permlane32_swap(__float_as_uint(l_reg),__float_as_uint(l_reg),false,false);l_reg=__uint_as_float(rr[0])+__uint_as_float(rr[1]);}
  if(lse_out!=nullptr&&hi==0)lse_out[wid*QBLK+r32]=mhat+__log2f(l_reg);
  if(hi==0)wsf[32+r32]=l_reg;asm volatile("s_waitcnt lgkmcnt(0)":::"memory");
  float rli[16];
  #pragma unroll
  for(int r=0;r<16;++r)rli[r]=__builtin_amdgcn_rcpf(wsf[32+crow(r,hi)]);
  bf16*Ow=Ou+(long)(wid*QBLK)*OP;
  { bf16*stg=(bf16*)(shm+LDS_OST)+wid*2048;
    #pragma unroll
    for(int r=0;r<16;++r){const int orow=crow(r,hi);
      #pragma unroll
      for(int d0=0;d0<2;++d0)stg[orow*64+d0*32+r32]=__float2bfloat16(o[d0][r]*rli[r]);}
    asm volatile("s_waitcnt lgkmcnt(0)":::"memory");
    #pragma unroll
    for(int i=0;i<4;++i){const int row=i*8+(lane>>3),ch=lane&7; const u32x4 v=*(const u32x4*)(stg+row*64+ch*8); ATTN_STORE16(Ow+(long)row*OP+ch*8,v);} }
  asm volatile("s_waitcnt lgkmcnt(0)\n\ts_barrier":::"memory");
  #undef DMA_K
  #undef DMA_V
  #undef CMASK
  #undef START
  #undef RESC
  #undef ROT
}
constexpr int ATTN_LDS_BYTES=LDS_BYTES;
#undef SBAR
#undef WAIT_BAR
}

#define XLAS __attribute__((address_space(3)))
#define XB_TMO      128
#define XB_XCNT(j)  (256  + 64 * (j))
#define XB_XSUB(j)  (1280 + 64 * (j))
#define XB_XGEN(j)  (2304 + 64 * (j))
#define XB_TOP      3328
#define XB_TOPGEN   3392
#define XCD_BAR_WORDS 3456
#define XB_SPIN_CAP (1u << 18)

__device__ __forceinline__ unsigned xb_ld(unsigned* p)              { return __hip_atomic_load(p, __ATOMIC_RELAXED, __HIP_MEMORY_SCOPE_AGENT); }
__device__ __forceinline__ unsigned xb_add(unsigned* p, unsigned v) { return __hip_atomic_fetch_add(p, v, __ATOMIC_RELAXED, __HIP_MEMORY_SCOPE_AGENT); }
__device__ __forceinline__ unsigned xb_xcc_id() { return (unsigned)__builtin_amdgcn_s_getreg((3 << 11) | 20) & 0xFu; }
#define XB_SPIN(cond, bar) do { unsigned _sp = 0; while (cond) { __builtin_amdgcn_s_sleep(1); \
    if ((++_sp & 255u) == 0u) { if (xb_ld(&(bar)[XB_TMO])) break; if (_sp > XB_SPIN_CAP) { atomicAdd(&(bar)[XB_TMO], 1u); break; } } } } while (0)

struct XcdBarrier {
    unsigned* bar; unsigned x;
    volatile XLAS unsigned* st;
};

__device__ __forceinline__ XcdBarrier xcd_barrier_post(unsigned* bar, volatile XLAS unsigned* st) {
    XcdBarrier b; b.bar = bar; b.x = xb_xcc_id(); b.st = st;
    if (threadIdx.x == 0) (void)xb_add(&bar[XB_XCNT(b.x)], 1u);
    return b;
}
__device__ __forceinline__ void xcd_barrier_complete(unsigned* bar, unsigned x, unsigned& nloc, unsigned& nx) {
    const unsigned G = gridDim.x * gridDim.y * gridDim.z;
    unsigned sum, cnt, mine, sp = 0u;
    for (;;) {
        sum = 0u; cnt = 0u; mine = 0u;
#pragma unroll
        for (unsigned j = 0; j < 16; ++j) { const unsigned c = xb_ld(&bar[XB_XCNT(j)]); sum += c; cnt += (c > 0u) ? 1u : 0u; mine = (j == x) ? c : mine; }
        if (sum == G) break;
        __builtin_amdgcn_s_sleep(1);
        if ((++sp & 255u) == 0u) { if (xb_ld(&bar[XB_TMO])) break; if (sp > XB_SPIN_CAP) { atomicAdd(&bar[XB_TMO], 1u); break; } }
    }
    nloc = mine > 0u ? mine : 1u; nx = cnt > 0u ? cnt : 1u;
}

__device__ __forceinline__ void xcd_barrier(const XcdBarrier& b) {
    asm volatile("s_waitcnt vmcnt(0)" ::: "memory");
    __syncthreads();
    if (threadIdx.x == 0) {
        unsigned* bar = b.bar;
        __builtin_amdgcn_s_waitcnt(0);
        unsigned nloc = b.st[0], nx = b.st[1];
        if (nloc == 0u) { xcd_barrier_complete(bar, b.x, nloc, nx); b.st[0] = nloc; b.st[1] = nx; }
        const unsigned old = xb_add(&bar[XB_XSUB(b.x)], 1u);
        const unsigned gen = old / nloc;
        if (old + 1u == (gen + 1u) * nloc) {
            __builtin_amdgcn_fence(__ATOMIC_RELEASE, "agent");
            asm volatile("s_waitcnt vmcnt(0)" ::: "memory");
            const unsigned og = xb_add(&bar[XB_TOP], 1u);
            const unsigned tg = og / nx;
            if (og + 1u == (tg + 1u) * nx) xb_add(&bar[XB_TOPGEN], 1u);
            else XB_SPIN(xb_ld(&bar[XB_TOPGEN]) == tg, bar);
            __builtin_amdgcn_fence(__ATOMIC_ACQUIRE, "agent");
            xb_add(&bar[XB_XGEN(b.x)], 1u);
            asm volatile("s_waitcnt vmcnt(0)" ::: "memory");
        } else {
            XB_SPIN(xb_ld(&bar[XB_XGEN(b.x)]) == gen, bar);
            __builtin_amdgcn_fence(__ATOMIC_ACQUIRE, "agent");
            asm volatile("s_waitcnt vmcnt(0)" ::: "memory");
        }
    }
    __syncthreads();
}

constexpr int NWAVES = 8, NTHR = 512;
constexpr int DM = 1024, BATCH = 2, SEQ = 8192, CTXL = 256, NLAT = BATCH * SEQ, NCTX = BATCH * CTXL, NTOK = NLAT + NCTX;
constexpr int DIN = 2320, PN = 2304, PNW = 2560;
constexpr int PC_QKV = 0, PC_K = 768, PC_V = 896, PC_GV = 1024, PC_GG = 1280, PC_Z = 1536, PC_Q = 1792;
constexpr int KVROWS = CTXL + SEQ;
constexpr int NEXP = 32, DEXP = 512, NTILE_MAX = 164, NSLOT_MAX = NTILE_MAX * 256;
constexpr int NSCAN = 16, NSTEP = 132, GDN_ITEM_BYTES = 49152;
constexpr float EPS = 1e-6f;
constexpr float ATT_C2 = 0.125f * 1.4426950408889634f;
constexpr int ATT_NT = 132, ATT_SPLIT_MAIN = 96, ATT_SPLIT_PART = 12;

constexpr size_t MiB = 1u << 20, KiB = 1024;
constexpr size_t WS_CTL = 0, CTL_ZERO_BYTES = 32 * KiB;
constexpr size_t WS_MOD = 1 * MiB;
constexpr size_t WS_ROPE = 1 * MiB + 256 * KiB;
constexpr size_t WS_WGT = 1 * MiB + 320 * KiB;
constexpr size_t WS_WET = 1 * MiB + 512 * KiB;
constexpr size_t WS_GL = 1 * MiB + 768 * KiB;
constexpr size_t WS_WABT = 1 * MiB + 896 * KiB;
constexpr size_t WS_AB = 2 * MiB;
constexpr size_t WS_EID = 4 * MiB;
constexpr size_t WS_WTS = 4 * MiB + 256 * KiB;
constexpr size_t WS_SLOT = 4 * MiB + 512 * KiB;
constexpr size_t WS_STOK = 4 * MiB + 768 * KiB;
constexpr size_t WS_XCTX = 5 * MiB;
constexpr size_t WS_WIN = 6 * MiB;
constexpr size_t WS_WOUT = 17 * MiB;
constexpr size_t WS_WPW = 21 * MiB;
constexpr size_t WS_Q = 22 * MiB;
constexpr size_t WS_K = 39 * MiB, WS_V = 44 * MiB;
constexpr size_t WS_CF = 49 * MiB;
constexpr size_t WS_H = 58 * MiB;
constexpr size_t WS_OG = 92 * MiB;
constexpr size_t WS_P = 134 * MiB;
constexpr size_t WS_PARTO = 209 * MiB;
constexpr size_t WS_PARTL = 315 * MiB;
constexpr size_t WS_GDN = 216 * MiB;
constexpr size_t WS_WGU = 316 * MiB;
constexpr size_t WS_WD = 444 * MiB;
constexpr size_t WS_END = 508 * MiB;
constexpr int CW_CNT = 64;
constexpr int CW_CUR = 192;
constexpr int CW_NT = 320;
constexpr int CW_TE = 384;
constexpr int CW_CQ = 352;
constexpr int CW_BAR = 4096;

constexpr int RING_BYTES = 131072, MISC_OFF = RING_BYTES + 320, LDS_BYTES = 147456;

#define LAS __attribute__((address_space(3)))
typedef unsigned short bf16;
typedef unsigned v4u __attribute__((ext_vector_type(4)));
typedef unsigned v2u __attribute__((ext_vector_type(2)));
typedef float f32x4 __attribute__((ext_vector_type(4)));
typedef float f32x2 __attribute__((ext_vector_type(2)));
typedef short bf16x8 __attribute__((ext_vector_type(8)));
#define LDS_WAIT() asm volatile("s_waitcnt lgkmcnt(0)" ::: "memory")

__device__ __forceinline__ unsigned pk2(float lo, float hi) { return pg8::cvt_pk_bf16(lo, hi); }
__device__ __forceinline__ float bflo(unsigned u) { return __uint_as_float(u << 16); }
__device__ __forceinline__ float bfhi(unsigned u) { return __uint_as_float(u & 0xffff0000u); }
__device__ __forceinline__ f32x4 ld_bf4(const bf16* p) { const v2u w = *(const v2u*)p; return (f32x4){bflo(w.x), bfhi(w.x), bflo(w.y), bfhi(w.y)}; }
__device__ __forceinline__ void st_bf4(bf16* p, f32x4 v) { v2u w; w.x = pk2(v[0], v[1]); w.y = pk2(v[2], v[3]); *(v2u*)p = w; }
template <int CTRL> __device__ __forceinline__ float dpp_f(float v) { return __int_as_float(__builtin_amdgcn_mov_dpp(__float_as_int(v), CTRL, 0xF, 0xF, true)); }
__device__ __forceinline__ float grp16_sum(float v) { v += dpp_f<0xB1>(v); v += dpp_f<0x4E>(v); v += dpp_f<0x141>(v); v += dpp_f<0x140>(v); return v; }
__device__ __forceinline__ float wave_sum(float v) {
    v = grp16_sum(v);
    const int iv = __float_as_int(v);
    return (__int_as_float(__builtin_amdgcn_readlane(iv, 0)) + __int_as_float(__builtin_amdgcn_readlane(iv, 16))) + (__int_as_float(__builtin_amdgcn_readlane(iv, 32)) + __int_as_float(__builtin_amdgcn_readlane(iv, 48)));
}
#define BR4(k) ((((k) & 1) << 3) | (((k) & 2) << 1) | (((k) & 4) >> 1) | (((k) & 8) >> 3))
#define BR3(k) ((((k) & 1) << 2) | ((k) & 2) | (((k) & 4) >> 2))
__device__ __forceinline__ float rdlane_f(float v, int l) { return __int_as_float(__builtin_amdgcn_readlane(__float_as_int(v), l)); }
template <int CTRL> __device__ __forceinline__ float tr_step(float lo, float hi, bool side) { const float a = lo + dpp_f<CTRL>(lo), b = hi + dpp_f<CTRL>(hi); return side ? b : a; }
__device__ __forceinline__ float xrow_total(float z) {
    { auto rr = __builtin_amdgcn_permlane32_swap(__float_as_uint(z), __float_as_uint(z), false, false); z = __uint_as_float(rr[0]) + __uint_as_float(rr[1]); }
    { auto rr = __builtin_amdgcn_permlane16_swap(__float_as_uint(z), __float_as_uint(z), false, false); z = __uint_as_float(rr[0]) + __uint_as_float(rr[1]); }
    return z;
}
__device__ __forceinline__ float treduce16(const float (&v)[16], int lane) {
    const bool s3 = (lane & 8) != 0, s2 = (lane & 4) != 0, s1 = (lane & 2) != 0, s0 = (lane & 1) != 0;
    float w[8], x[4], y[2];
#pragma unroll
    for (int j = 0; j < 8; ++j) w[j] = tr_step<0x140>(v[2 * j], v[2 * j + 1], s3);
#pragma unroll
    for (int j = 0; j < 4; ++j) x[j] = tr_step<0x141>(w[2 * j], w[2 * j + 1], s2);
#pragma unroll
    for (int j = 0; j < 2; ++j) y[j] = tr_step<0x4E>(x[2 * j], x[2 * j + 1], s1);
    return xrow_total(tr_step<0xB1>(y[0], y[1], s0));
}
__device__ __forceinline__ float treduce8(const float (&v)[8], int lane) {
    const bool s2 = (lane & 4) != 0, s1 = (lane & 2) != 0, s0 = (lane & 1) != 0;
    float x[4], y[2];
#pragma unroll
    for (int j = 0; j < 4; ++j) x[j] = tr_step<0x141>(v[2 * j], v[2 * j + 1], s2);
#pragma unroll
    for (int j = 0; j < 2; ++j) y[j] = tr_step<0x4E>(x[2 * j], x[2 * j + 1], s1);
    float z = tr_step<0xB1>(y[0], y[1], s0);
    z += dpp_f<0x128>(z);
    return xrow_total(z);
}
__device__ __forceinline__ float fsigmoid(float x) { return __builtin_amdgcn_rcpf(1.0f + __builtin_amdgcn_exp2f(-1.4426950408889634f * x)); }
__device__ __forceinline__ float sigmoid_f(float x) { return 1.0f / (1.0f + expf(-x)); }
__device__ __forceinline__ float silu_acc(float x) { return x / (1.0f + expf(-x)); }
__device__ __forceinline__ float softplus_f(float x) { return x > 20.f ? x : log1pf(expf(x)); }
__device__ __forceinline__ float dot4(f32x4 a, f32x4 b) { return (a[0] * b[0] + a[1] * b[1]) + (a[2] * b[2] + a[3] * b[3]); }

struct Frame {
    LAS unsigned char* lds; unsigned char* lds_g;
    int tid, lane, wave, G, vcu, gw, NGW;
    float* out; unsigned char* ws;
};
struct Args { const float* in[30]; float* out; unsigned char* ws; int ph_lo, ph_hi; };
__device__ __forceinline__ void relane(Frame& F) { F.tid = opaque_tid(); F.lane = F.tid & 63; }
template <class T> __device__ __forceinline__ T* wsp(const Frame& F, size_t off) { return (T*)(F.ws + off); }
__device__ __forceinline__ int msel_of(int r) { return r < NLAT ? (r >> 13) : 2; }

__device__ __forceinline__ void tt_load(float (&w)[32], const float* Wt, int ldw, int lane) {
#pragma unroll
    for (int j = 0; j < 8; ++j) { const f32x4 x = __builtin_nontemporal_load((const f32x4*)(Wt + (size_t)(8 * j + (lane >> 3)) * ldw + (lane & 7) * 4)); w[4 * j] = x[0]; w[4 * j + 1] = x[1]; w[4 * j + 2] = x[2]; w[4 * j + 3] = x[3]; }
}
__device__ __forceinline__ void tt_store(const float (&w)[32], bf16* WTt, int ldwt, LAS float* scr, int lane) {
#pragma unroll
    for (int j = 0; j < 8; ++j)
#pragma unroll
        for (int e = 0; e < 4; ++e) scr[(8 * j + (lane >> 3)) * 33 + (lane & 7) * 4 + e] = w[4 * j + e];
    LDS_WAIT(); asm volatile("" ::: "memory");
    const int c = lane & 7;
#pragma unroll
    for (int j = 0; j < 4; ++j) { const int n = (lane >> 3) + 8 * j; const LAS float* s = scr + (8 * c) * 33 + n;
        v4u o; o.x = pk2(s[0 * 33], s[1 * 33]); o.y = pk2(s[2 * 33], s[3 * 33]); o.z = pk2(s[4 * 33], s[5 * 33]); o.w = pk2(s[6 * 33], s[7 * 33]);
        __builtin_nontemporal_store(o, (v4u*)(WTt + (size_t)n * ldwt + 8 * c)); }
    LDS_WAIT(); asm volatile("" ::: "memory");
}
__device__ __forceinline__ void transpose_tile(const float* Wt, int ldw, bf16* WTt, int ldwt, LAS float* scr, int lane) { float w[32]; tt_load(w, Wt, ldw, lane); tt_store(w, WTt, ldwt, scr, lane); }
__device__ __forceinline__ void sincos_d(double x, double& s, double& c) {
    const double TWO_PI_HI = 6.283185307179586232, TWO_PI_LO = 2.449293598294706414e-16;
    const double n = rint(x * 0.15915494309189534561);
    double r = fma(-n, TWO_PI_HI, x); r = fma(-n, TWO_PI_LO, r);
    const double r2 = r * r; double ss = 1.0, cc = 1.0;
#pragma unroll
    for (int k = 15; k >= 1; --k) { ss = 1.0 - ss * r2 * (1.0 / (double)((2 * k) * (2 * k + 1))); cc = 1.0 - cc * r2 * (1.0 / (double)((2 * k - 1) * (2 * k))); }
    s = r * ss; c = cc;
}
__device__ __forceinline__ void p0_prologue(Frame& F, const Args& A) {
    relane(F);
    LAS float* Lf = (LAS float*)F.lds;
    if (blockIdx.x < 192) {
        const int bt = blockIdx.x, l = bt / 96, cgp = bt % 96;
        LAS float* sc = Lf; LAS float* red = Lf + 3072;
        { float cv[6];
#pragma unroll
          for (int m = 0; m < 6; ++m) { const int idx = F.tid + NTHR * m, v = idx >> 10, k = idx & 1023; cv[m] = v < 2 ? A.in[1][v * 1024 + k] : A.in[3][k]; }
#pragma unroll
          for (int m = 0; m < 6; ++m) sc[F.tid + NTHR * m] = silu_acc(cv[m]); }
        __syncthreads();
        const float* mw = A.in[4] + (size_t)l * 1024 * 6144 + 64 * cgp + F.lane;
        float a0 = 0.f, a1 = 0.f, a2 = 0.f;
#pragma unroll 64
        for (int kk = 0; kk < 128; ++kk) { const int k = F.wave * 128 + kk; const float w = __builtin_nontemporal_load(mw + (size_t)k * 6144); a0 += sc[k] * w; a1 += sc[1024 + k] * w; a2 += sc[2048 + k] * w; }
        red[(F.wave * 3 + 0) * 64 + F.lane] = a0; red[(F.wave * 3 + 1) * 64 + F.lane] = a1; red[(F.wave * 3 + 2) * 64 + F.lane] = a2;
        __syncthreads();
        if (F.tid < 192) { const int v = F.tid >> 6, cc = F.tid & 63; float s = A.in[5][l * 6144 + 64 * cgp + cc];
#pragma unroll
            for (int w = 0; w < 8; ++w) s += red[(w * 3 + v) * 64 + cc];
            wsp<float>(F, WS_MOD)[(l * 3 + v) * 6144 + 64 * cgp + cc] = s; }
        __syncthreads();
    }
    {
        const int gt = blockIdx.x * NTHR + F.tid;
        if (gt < 2048) {
            const double INV[16] = {1.0, 5.6234132519034907e-01, 3.1622776601683794e-01, 1.7782794100389229e-01, 1.0e-01, 5.6234132519034911e-02, 3.1622776601683791e-02, 1.7782794100389229e-02,
                                    1.0e-02, 5.6234132519034910e-03, 3.1622776601683794e-03, 1.7782794100389228e-03, 1.0e-03, 5.6234132519034910e-04, 3.1622776601683794e-04, 1.7782794100389227e-04};
            const int pos = gt >> 4, f = gt & 15; double iv = INV[0];
#pragma unroll
            for (int q = 1; q < 16; ++q) iv = (f == q) ? INV[q] : iv;
            const float ang = (float)pos * (float)iv; double s, c; sincos_d((double)ang, s, c);
            float* rt = wsp<float>(F, WS_ROPE); rt[gt * 2] = (float)c; rt[gt * 2 + 1] = (float)s;
        }
        if (gt < 32768) { const int l = gt >> 14, c = (gt >> 10) & 15, k = gt & 1023;
            wsp<bf16>(F, WS_WIN)[((size_t)l * PNW + PN + c) * 1024 + k] = (bf16)(pk2(A.in[8][((size_t)l * 1024 + k) * DIN + 768 + c], 0.f) & 0xffffu); }
        for (int i = gt; i < 2 * 240 * 512; i += F.G * NTHR) { const int l = i / (240 * 512), rem = i % (240 * 512); ((unsigned*)(wsp<bf16>(F, WS_WIN) + ((size_t)l * PNW + PN + 16) * 1024))[rem] = 0u; }
        if (gt < 65536) { const int l = gt >> 15, e = (gt >> 10) & 31, k = gt & 1023; wsp<float>(F, WS_WET)[gt] = A.in[24][((size_t)l * 1024 + k) * 32 + e]; }
        else if (gt < 65536 + 8192) { const int i2 = gt - 65536, l = i2 >> 12, g = (i2 >> 10) & 3, k = i2 & 1023; wsp<float>(F, WS_WGT)[i2] = A.in[22][((size_t)l * 1024 + k) * 4 + g]; }
    }
    LAS float* scr = Lf + F.wave * 2112;
    constexpr int NI_IN = 2 * 16 * 72, NI_OUT = 2 * 16 * 32, NI_PW = 2 * 4 * 8;
    constexpr int NITEMS = NI_IN + NI_OUT + NI_PW;
    bf16* WIN = wsp<bf16>(F, WS_WIN); bf16* WOUT = wsp<bf16>(F, WS_WOUT); bf16* WPW = wsp<bf16>(F, WS_WPW);
    for (int it = F.gw; it < NITEMS; it += F.NGW) {
        int r = it; const float* src; bf16* dst; int ldw, ldwt;
        if (r < NI_IN) { const int l = r / 1152, q = r % 1152, kb = q / 72, nb = q % 72; const int sc = nb < 24 ? 32 * nb : 784 + 32 * (nb - 24), dr = nb < 24 ? 32 * nb : 768 + 32 * (nb - 24);
            src = A.in[8] + ((size_t)l * 1024 + 64 * kb) * DIN + sc; ldw = DIN; dst = WIN + ((size_t)l * PNW + dr) * 1024 + 64 * kb; ldwt = 1024; }
        else if ((r -= NI_IN) < NI_OUT) { const int l = r / 512, q = r % 512, kb = q / 32, nb = q % 32;
            src = A.in[21] + ((size_t)l * 1024 + 64 * kb) * 1024 + 32 * nb; ldw = 1024; dst = WOUT + ((size_t)l * 1024 + 32 * nb) * 1024 + 64 * kb; ldwt = 1024; }
        else { r -= NI_OUT; const int l = r / 32, q = r % 32, kb = q / 8, nb = q % 8;
            src = A.in[13] + ((size_t)l * 256 + 64 * kb) * 256 + 32 * nb; ldw = 256; dst = WPW + ((size_t)l * 256 + 32 * nb) * 256 + 64 * kb; ldwt = 256; }
        transpose_tile(src, ldw, dst, ldwt, scr, F.lane);
    }
}
constexpr int CONV_ITEMS = 32 * 512 + 32 * 256, CONV_CHUNKS = CONV_ITEMS / 32;
__device__ __forceinline__ void convert_pull(Frame& F, const Args& A, int budget, int qlo, int qhi) {
    relane(F);
    LAS float* scr = (LAS float*)F.lds + F.wave * 2112;
    LAS int* box = (LAS int*)(F.lds + RING_BYTES + 8192);
    bf16* WGU = wsp<bf16>(F, WS_WGU); bf16* WD = wsp<bf16>(F, WS_WD); int* ctl = wsp<int>(F, WS_CTL);
    constexpr int NI_GU = 32 * 512;
    for (int kq = 0; kq < budget; ++kq) {
        if (F.tid == 0) { int c = -1, lw = qlo;
            for (; lw <= qhi; ++lw) { c = atomicAdd(ctl + CW_CQ + lw, 1); if (c < CONV_CHUNKS) break; c = -1; }
            box[0] = c; box[1] = lw; }
        __syncthreads();
        const int c = box[0], layer = box[1];
        if (c < 0) break;
#define EXP_ITEM(it_, src, dst, ldw, ldwt) do { int r = (it_); \
        if (r < NI_GU) { const int le = layer * 32 + r / 512, q = r % 512, which = q / 256, q2 = q % 256, kb = q2 / 16, nb = q2 % 16, n0 = 32 * nb, dr = 256 * (n0 >> 7) + (n0 & 127) + 128 * which; \
            src = (which ? A.in[27] : A.in[26]) + ((size_t)le * 1024 + 64 * kb) * 512 + n0; ldw = 512; dst = WGU + ((size_t)le * 1024 + dr) * 1024 + 64 * kb; ldwt = 1024; } \
        else { r -= NI_GU; const int le = layer * 32 + r / 256, q = r % 256, kb = q / 32, nb = q % 32; \
            src = A.in[28] + ((size_t)le * 512 + 64 * kb) * 1024 + 32 * nb; ldw = 1024; dst = WD + ((size_t)le * 1024 + 32 * nb) * 512 + 64 * kb; ldwt = 512; } } while (0)
        const int it0 = c * 32 + F.wave * 4;
        float wc[32], wn[32]; const float* src; bf16* dst; int ldw, ldwt;
        EXP_ITEM(it0, src, dst, ldw, ldwt); tt_load(wc, src, ldw, F.lane);
#pragma unroll 1
        for (int m = 0; m < 4; ++m) {
            const float* src2 = src; bf16* dst2 = dst; int ldw2 = ldw, ldwt2 = ldwt;
            if (m < 3) { EXP_ITEM(it0 + m + 1, src2, dst2, ldw2, ldwt2); tt_load(wn, src2, ldw2, F.lane); }
            tt_store(wc, dst, ldwt, scr, F.lane);
            if (m < 3) {
#pragma unroll
                for (int i = 0; i < 32; ++i) wc[i] = wn[i];
                dst = dst2; ldwt = ldwt2; }
        }
#undef EXP_ITEM
        __syncthreads();
    }
    __syncthreads();
}
__device__ __forceinline__ int my_units(int n, int G, int c) { return c < n ? (n - c + G - 1) / G : 0; }
__device__ __forceinline__ int max_units(int n, int G) { return (n + G - 1) / G; }

#ifndef MK_DRY_AB
#define MK_DRY_AB 1
#endif
#define ROW_RANGE(N_) const int RPW_ = ((N_) + F.NGW - 1) / F.NGW; const int rbeg_ = F.gw * RPW_, rend_ = (rbeg_ + RPW_ < (N_)) ? rbeg_ + RPW_ : (N_);
#define ROW_BATCH_LOOP for (int rb_ = rbeg_; rb_ < rend_; rb_ += 3) { int row[3]; bool valid[3]; _Pragma("unroll") for (int u = 0; u < 3; ++u) { valid[u] = rb_ + u < rend_; row[u] = valid[u] ? rb_ + u : rend_ - 1; }
#define ROW_BATCH_BEGIN(N_) ROW_RANGE(N_) ROW_BATCH_LOOP
#define ROW_BATCH_END }

__device__ __forceinline__ void phase_norm1(Frame& F, const Args& A, int layer, bool dry = false) {
    relane(F);
    const float* mod = wsp<float>(F, WS_MOD) + layer * 3 * 6144;
    const float* g1n = A.in[6] + layer * 1024;
    bf16* H = wsp<bf16>(F, WS_H);
    const float* modp = wsp<float>(F, WS_MOD);
    const int* SLOT = wsp<int>(F, WS_SLOT); const float* WTS = wsp<float>(F, WS_WTS); const bf16* Y = wsp<bf16>(F, WS_GDN);
    f32x4 gn4[4], sc4[4], sh4[4], g24[4]; int msc = -1;
#pragma unroll
    for (int j = 0; j < 4; ++j) gn4[j] = *(const f32x4*)(g1n + 4 * F.lane + 256 * j);
    ROW_RANGE(NTOK)
    int sl_all = 0; float wt_all = 0.f;
    if (layer == 1 && rbeg_ * 2 + F.lane < rend_ * 2) { sl_all = SLOT[rbeg_ * 2 + F.lane]; wt_all = WTS[rbeg_ * 2 + F.lane]; }
    ROW_BATCH_LOOP
        bf16* xr[3]; f32x4 v[3][4];
#pragma unroll
        for (int u = 0; u < 3; ++u) { const int r = row[u];
            if (layer == 0) { const float* xf = r < NLAT ? A.in[0] + (size_t)r * 1024 : A.in[2] + (size_t)(r - NLAT) * 1024; xr[u] = nullptr;
#pragma unroll
                for (int j = 0; j < 4; ++j) v[u][j] = __builtin_nontemporal_load((const f32x4*)(xf + 4 * F.lane + 256 * j)); }
            else { xr[u] = r < NLAT ? (bf16*)F.out + (size_t)r * 1024 : wsp<bf16>(F, WS_XCTX) + (size_t)(r - NLAT) * 1024;
#pragma unroll
                for (int j = 0; j < 4; ++j) v[u][j] = ld_bf4(xr[u] + 4 * F.lane + 256 * j); } }
        if (layer == 1) {
            v2u y0[3][4], y1[3][4]; float w0[3], w1[3];
#pragma unroll
            for (int u = 0; u < 3; ++u) { const int r = row[u]; const int li_ = (r - rbeg_) * 2; const int s0 = __builtin_amdgcn_readlane(sl_all, li_), s1 = __builtin_amdgcn_readlane(sl_all, li_ + 1);
                w0[u] = __int_as_float(__builtin_amdgcn_readlane(__float_as_int(wt_all), li_)); w1[u] = __int_as_float(__builtin_amdgcn_readlane(__float_as_int(wt_all), li_ + 1));
#pragma unroll
                for (int j = 0; j < 4; ++j) { const int k = 4 * F.lane + 256 * j; y0[u][j] = *(const v2u*)(Y + (size_t)s0 * 1024 + k); y1[u][j] = *(const v2u*)(Y + (size_t)s1 * 1024 + k); } }
#pragma unroll
            for (int u = 0; u < 3; ++u) { const float* g2 = modp + msel_of(row[u]) * 6144 + 5120;
#pragma unroll
                for (int j = 0; j < 4; ++j) g24[j] = *(const f32x4*)(g2 + 4 * F.lane + 256 * j);
#pragma unroll
                for (int j = 0; j < 4; ++j) { const int k = 4 * F.lane + 256 * j;
                    const f32x4 a0 = {bflo(y0[u][j].x), bfhi(y0[u][j].x), bflo(y0[u][j].y), bfhi(y0[u][j].y)}, a1 = {bflo(y1[u][j].x), bfhi(y1[u][j].x), bflo(y1[u][j].y), bfhi(y1[u][j].y)};
                    v[u][j] = v[u][j] + g24[j] * (a0 * w0[u] + a1 * w1[u]); if (valid[u] && !dry) st_bf4(xr[u] + k, v[u][j]); } }
        }
        f32x4 hv[3][4];
#pragma unroll
        for (int u = 0; u < 3; ++u) { const int r = row[u], ms = msel_of(r);
            float ss = 0.f;
#pragma unroll
            for (int j = 0; j < 4; ++j) ss += dot4(v[u][j], v[u][j]);
            const float rstd = rsqrtf(wave_sum(ss) * (1.0f / 1024.0f) + EPS);
            if (ms != msc) { msc = ms;
#pragma unroll
                for (int j = 0; j < 4; ++j) { sc4[j] = *(const f32x4*)(mod + ms * 6144 + 1024 + 4 * F.lane + 256 * j); sh4[j] = *(const f32x4*)(mod + ms * 6144 + 4 * F.lane + 256 * j); } }
#pragma unroll
            for (int j = 0; j < 4; ++j) { const int k = 4 * F.lane + 256 * j;
                hv[u][j] = v[u][j] * rstd * gn4[j] * (sc4[j] + 1.0f) + sh4[j]; if (!dry) st_bf4(H + (size_t)r * 1024 + k, hv[u][j]); } }
    ROW_BATCH_END
}

__device__ __forceinline__ void phase_attn_prep(Frame& F, const Args& A, int layer) {
    relane(F);
    const bf16* P = wsp<bf16>(F, WS_P); bf16* Q = wsp<bf16>(F, WS_Q); bf16* K = wsp<bf16>(F, WS_K); bf16* V = wsp<bf16>(F, WS_V);
    const float* rope = wsp<float>(F, WS_ROPE);
    const int hl = F.lane >> 4, li = F.lane & 15, d0 = 4 * li;
    const f32x4 qg = *(const f32x4*)(A.in[19] + layer * 64 + d0), kg = *(const f32x4*)(A.in[20] + layer * 64 + d0);
    const int axis = li >> 3, half = (li >> 2) & 1, f0 = 4 * (li & 3);
    const int kvh = hl & 1; const bool isv = hl >= 2;
    ROW_BATCH_BEGIN(NTOK)
        v2u xq[3][2], xkv[3];
#pragma unroll
        for (int u = 0; u < 3; ++u) { const bf16* pr = P + (size_t)row[u] * PN;
            xq[u][0] = *(const v2u*)(pr + PC_Q + hl * 64 + d0); xq[u][1] = *(const v2u*)(pr + PC_Q + (4 + hl) * 64 + d0); xkv[u] = *(const v2u*)(pr + (isv ? PC_V : PC_K) + kvh * 64 + d0); }
#pragma unroll
        for (int u = 0; u < 3; ++u) { const int r = row[u];
            const bool lat = r < NLAT; const int t = lat ? (r & (SEQ - 1)) : ((r - NLAT) & (CTXL - 1)); const int b = lat ? (r >> 13) : ((r - NLAT) >> 8);
            f32x4 cs = {1.f, 1.f, 1.f, 1.f}, sn = {0.f, 0.f, 0.f, 0.f};
            if (lat) { const int pos = axis ? (t & 63) : (t >> 6); const float* rp = rope + (pos * 16 + f0) * 2;
                const f32x4 r0 = *(const f32x4*)rp, r1 = *(const f32x4*)(rp + 4); cs = (f32x4){r0[0], r0[2], r1[0], r1[2]}; sn = (f32x4){r0[1], r0[3], r1[1], r1[3]}; }
            if (lat || layer == 0) {
#pragma unroll
                for (int it = 0; it < 2; ++it) {
                    const int head = it * 4 + hl;
                    f32x4 x = {bflo(xq[u][it].x), bfhi(xq[u][it].x), bflo(xq[u][it].y), bfhi(xq[u][it].y)};
                    const float rstd = rsqrtf(grp16_sum(dot4(x, x)) * (1.0f / 64.0f) + EPS);
                    x = x * rstd * qg;
                    f32x4 xp; xp[0] = __shfl_xor(x[0], 4); xp[1] = __shfl_xor(x[1], 4); xp[2] = __shfl_xor(x[2], 4); xp[3] = __shfl_xor(x[3], 4);
                    const f32x4 o = half ? (x * cs + xp * sn) : (x * cs - xp * sn);
                    st_bf4(Q + (size_t)r * 512 + head * 64 + d0, o * ATT_C2);
                }
            }
            {
                const f32x4 x = {bflo(xkv[u].x), bfhi(xkv[u].x), bflo(xkv[u].y), bfhi(xkv[u].y)};
                const float rstd = rsqrtf(grp16_sum(dot4(x, x)) * (1.0f / 64.0f) + EPS);
                const f32x4 xk = x * rstd * kg;
                f32x4 xp; xp[0] = __shfl_xor(xk[0], 4); xp[1] = __shfl_xor(xk[1], 4); xp[2] = __shfl_xor(xk[2], 4); xp[3] = __shfl_xor(xk[3], 4);
                const f32x4 ok = half ? (xk * cs + xp * sn) : (xk * cs - xp * sn);
                const size_t krow = (size_t)b * KVROWS + (lat ? CTXL + t : t);
                st_bf4((isv ? V : K) + krow * 128 + kvh * 64 + d0, isv ? x : ok);
            } }
    ROW_BATCH_END
}

__device__ __forceinline__ void phase_conformer(Frame& F, const Args& A, int layer) {
    relane(F);
    LAS float* Gl = (LAS float*)F.lds;
    const bf16* P = wsp<bf16>(F, WS_P); bf16* CF = wsp<bf16>(F, WS_CF);
    const int ntile = layer == 0 ? 264 : 256;
    const int c = F.tid & 255, hf = F.tid >> 8;
    float wv[31];
#pragma unroll
    for (int j = 0; j < 31; ++j) wv[j] = A.in[9][((size_t)layer * 31 + j) * 256 + c];
    const float cb = A.in[10][layer * 256 + c];
    const f32x4 lg = *(const f32x4*)(A.in[11] + layer * 256 + 4 * F.lane), lb = *(const f32x4*)(A.in[12] + layer * 256 + 4 * F.lane);
    const int cskip = F.G > 64 ? 32 : 0;
    for (int tile = (int)blockIdx.x - cskip; tile < ntile; tile += F.G - cskip) {
        if (tile < 0) break;
        int sbase, slen, t0;
        if (tile < 256) { sbase = (tile >> 7) * SEQ; slen = SEQ; t0 = (tile & 127) * 64; } else { const int cc = tile - 256; sbase = NLAT + (cc >> 2) * CTXL; slen = CTXL; t0 = (cc & 3) * 64; }
        {
            v2u gv[12], gg[12];
#pragma unroll
            for (int m = 0; m < 12; ++m) { const int idx = F.tid + NTHR * m, i = idx >> 6, c4 = (idx & 63) * 4, t = t0 - 15 + i; gv[m] = (v2u){0u, 0u}; gg[m] = (v2u){0u, 0u};
                if (i < 94 && t >= 0 && t < slen) { const bf16* pr = P + (size_t)(sbase + t) * PN; gv[m] = *(const v2u*)(pr + PC_GV + c4); gg[m] = *(const v2u*)(pr + PC_GG + c4); } }
#pragma unroll
            for (int m = 0; m < 12; ++m) { const int idx = F.tid + NTHR * m, i = idx >> 6, c4 = (idx & 63) * 4;
                const f32x4 a = {bflo(gv[m].x), bfhi(gv[m].x), bflo(gv[m].y), bfhi(gv[m].y)}, g = {bflo(gg[m].x), bfhi(gg[m].x), bflo(gg[m].y), bfhi(gg[m].y)};
                if (i < 94) *(LAS f32x4*)(Gl + i * 256 + c4) = (f32x4){a[0] * fsigmoid(g[0]), a[1] * fsigmoid(g[1]), a[2] * fsigmoid(g[2]), a[3] * fsigmoid(g[3])}; }
        }
        __syncthreads();
        float o[32];
#pragma unroll
        for (int tt = 0; tt < 32; ++tt) o[tt] = cb;
#pragma unroll
        for (int tb = 0; tb < 4; ++tb) {
            float xw[38];
#pragma unroll
            for (int ii = 0; ii < 38; ++ii) xw[ii] = Gl[(hf * 32 + tb * 8 + ii) * 256 + c];
#pragma unroll
            for (int t8 = 0; t8 < 8; ++t8)
#pragma unroll
                for (int j = 0; j < 31; ++j) o[tb * 8 + t8] += xw[t8 + j] * wv[j];
        }
        __syncthreads();
#pragma unroll
        for (int tt = 0; tt < 32; ++tt) Gl[(hf * 32 + tt) * 256 + c] = o[tt];
        __syncthreads();
#pragma unroll
        for (int q = 0; q < 8; ++q) { const int tok = F.wave * 8 + q; const f32x4 x = *(const LAS f32x4*)(Gl + tok * 256 + 4 * F.lane);
            const float mean = wave_sum((x[0] + x[1]) + (x[2] + x[3])) * (1.0f / 256.0f); const f32x4 d = x - mean;
            const float rstd = rsqrtf(wave_sum(dot4(d, d)) * (1.0f / 256.0f) + EPS);
            f32x4 y = d * rstd * lg + lb; y = (f32x4){pg8::silu_f(y[0]), pg8::silu_f(y[1]), pg8::silu_f(y[2]), pg8::silu_f(y[3])};
            st_bf4(CF + (size_t)(sbase + t0 + tok) * 256 + 4 * F.lane, y); }
        __syncthreads();
    }
}

__device__ __forceinline__ float quad_bcast(float v, int q) { switch (q) { case 0: return dpp_f<0x00>(v); case 1: return dpp_f<0x55>(v); case 2: return dpp_f<0xAA>(v); default: return dpp_f<0xFF>(v); } }
#ifndef MK_GDN_REP
#define MK_GDN_REP -1
#endif
#define GREP(k) ((MK_GDN_REP == (k)) ? 2 : 1)
__device__ __forceinline__ float fexp(float x) { return __builtin_amdgcn_exp2f(x * 1.4426950408889634f); }
#define MFMA16P(a, b, c) __builtin_amdgcn_mfma_f32_16x16x32_bf16(a, b, c, 0, 0, 0)
__device__ __forceinline__ void phase_gdn_prep(Frame& F, const Args& A, int layer) {
    relane(F);
    LAS unsigned char* LB = F.lds;
    LAS float* feat = (LAS float*)LB;
    LAS float* KKm = (LAS float*)(LB + 49920);
    LAS float* QKm = (LAS float*)(LB + 66560);
    LAS float* Am = (LAS float*)(LB + 83200);
    LAS float* sm = (LAS float*)(LB + 115968);
    LAS unsigned char* VT = LB + 118016;
    LAS unsigned char* KT = LB + 133120;
    LAS float* raw = (LAS float*)(LB + 66560);
    LAS float* Tm = KKm;
    LAS unsigned char* Kb = LB + 83200; LAS unsigned char* Qb = LB + 92416;
    LAS unsigned char* TU = LB;
    const bf16* P = wsp<bf16>(F, WS_P); const float* AB = wsp<float>(F, WS_AB);
    unsigned char* GD = F.ws + WS_GDN; float* GLp = wsp<float>(F, WS_GL);
    const float* cw = A.in[15] + (size_t)layer * 5 * 768;
    const int lane = F.lane, wave = F.wave, l15 = lane & 15, g4 = lane >> 4;
    v2u pre[7]; float pa = 0.f, pb = 0.f;
#define GDN_ITEM_GEOM(item_) const int sc = (item_) >> 2, h = (item_) & 3; int b, n, sbase, slen, isctx; \
        if (sc < 256) { b = sc >> 7; n = sc & 127; sbase = b * SEQ; slen = SEQ; isctx = 0; } else { const int cc = sc - 256; b = cc >> 2; n = cc & 3; sbase = NLAT + b * CTXL; slen = CTXL; isctx = 1; } \
        const int t0 = 64 * n;
#define GDN_PREFETCH(item_) do { GDN_ITEM_GEOM(item_) (void)isctx; \
        _Pragma("unroll") for (int m = 0; m < 7; ++m) { const int idx = F.tid + NTHR * m; const int s = idx / (68 * 16), rem = idx % (68 * 16), i = rem >> 4, c4 = (rem & 15) * 4, t = t0 - 2 + i; \
            pre[m] = (v2u){0u, 0u}; if (idx < 3 * 68 * 16 && t >= 0 && t < slen) pre[m] = *(const v2u*)(P + (size_t)(sbase + t) * PN + s * 256 + h * 64 + c4); } \
        if (F.tid < 128) { const int d = F.tid >> 6, i = F.tid & 63, ti = d ? 63 - i : i; const size_t row = (size_t)sbase + t0 + ti; pa = AB[row * 16 + d * 4 + h]; pb = AB[row * 16 + 8 + d * 4 + h]; } } while (0)
    if ((int)blockIdx.x < 264 * 4) GDN_PREFETCH((int)blockIdx.x);
    for (int item = blockIdx.x; item < 264 * 4; item += F.G) {
        GDN_ITEM_GEOM(item) (void)slen;
        float cwr[3][5];
#pragma unroll
        for (int s = 0; s < 3; ++s)
#pragma unroll
            for (int j = 0; j < 5; ++j) cwr[s][j] = cw[j * 768 + s * 256 + h * 64 + (F.tid & 63)];
#pragma unroll
        for (int m = 0; m < 7; ++m) { const int idx = F.tid + NTHR * m; const int s = idx / (68 * 16), rem = idx % (68 * 16), i = rem >> 4, c4 = (rem & 15) * 4;
            if (idx < 3 * 68 * 16) *(LAS f32x4*)(raw + (s * 68 + i) * 64 + c4) = (f32x4){bflo(pre[m].x), bfhi(pre[m].x), bflo(pre[m].y), bfhi(pre[m].y)}; }
        const float ga = pa, gb2 = pb;
        __syncthreads();
        if (item + F.G < 264 * 4) GDN_PREFETCH(item + F.G);
        for (int rp_ = 0; rp_ < GREP(0); ++rp_) {
        { const int c = F.tid & 63, ib = F.tid >> 6;
#pragma unroll
            for (int s = 0; s < 3; ++s) { float xw[12];
#pragma unroll
                for (int ii = 0; ii < 12; ++ii) xw[ii] = raw[(s * 68 + 8 * ib + ii) * 64 + c];
#pragma unroll
                for (int t8 = 0; t8 < 8; ++t8) { float acc = 0.f;
#pragma unroll
                    for (int j = 0; j < 5; ++j) acc += xw[t8 + j] * cwr[s][j];
                    feat[(s * 64 + 8 * ib + t8) * 65 + c] = pg8::silu_f(acc); } } }
        __syncthreads();
        }
        for (int rp_ = 0; rp_ < GREP(1); ++rp_) {
#pragma unroll 4
        for (int q = 0; q < 16; ++q) { const int rid = wave * 16 + q, s = rid >> 6, i = rid & 63; const float x = feat[(s * 64 + i) * 65 + lane];
            const float scl = rsqrtf(wave_sum(x * x) + EPS) * (s == 0 ? 0.125f : 1.0f); feat[(s * 64 + i) * 65 + lane] = x * scl; }
        if (F.tid < 128) { const int d = F.tid >> 6, i = F.tid & 63;
            const float xg = ga + A.in[17][layer * 8 + d * 4 + h];
            float gsum = -fexp(A.in[16][layer * 8 + d * 4 + h]) * (xg > 20.f ? xg : __logf(1.0f + fexp(xg)));
#pragma unroll
            for (int o = 1; o < 64; o <<= 1) { const float up = __shfl_up(gsum, o); if (i >= o) gsum += up; }
            sm[d * 64 + i] = gsum; sm[128 + d * 64 + i] = fsigmoid(gb2); }
        __syncthreads();
        }
        for (int rp_ = 0; rp_ < GREP(2); ++rp_) {
        { const int t = F.tid >> 3, c8 = (F.tid & 7) * 8;
            float x[8];
#pragma unroll
            for (int e = 0; e < 8; ++e) x[e] = feat[(64 + t) * 65 + c8 + e];
            v4u o; o.x = pk2(x[0], x[1]); o.y = pk2(x[2], x[3]); o.z = pk2(x[4], x[5]); o.w = pk2(x[6], x[7]); *(LAS v4u*)(Kb + t * 144 + c8 * 2) = o;
#pragma unroll
            for (int e = 0; e < 8; ++e) x[e] = feat[t * 65 + c8 + e];
            o.x = pk2(x[0], x[1]); o.y = pk2(x[2], x[3]); o.z = pk2(x[4], x[5]); o.w = pk2(x[6], x[7]); *(LAS v4u*)(Qb + t * 144 + c8 * 2) = o;
            const int c = F.tid & 63, t8 = (F.tid >> 6) * 8;
#pragma unroll
            for (int e = 0; e < 8; ++e) x[e] = feat[(64 + t8 + e) * 65 + c];
            o.x = pk2(x[0], x[1]); o.y = pk2(x[2], x[3]); o.z = pk2(x[4], x[5]); o.w = pk2(x[6], x[7]); *(LAS v4u*)(KT + c * 144 + t8 * 2) = o;
#pragma unroll
            for (int e = 0; e < 8; ++e) x[e] = feat[(128 + t8 + e) * 65 + c];
            o.x = pk2(x[0], x[1]); o.y = pk2(x[2], x[3]); o.z = pk2(x[4], x[5]); o.w = pk2(x[6], x[7]); *(LAS v4u*)(VT + c * 144 + t8 * 2) = o; }
        __syncthreads();
        }
        for (int rp_ = 0; rp_ < GREP(3); ++rp_) {
        { const int m = wave >> 2, a = wave & 3; const LAS unsigned char* src = m ? Qb : Kb; LAS float* dst = m ? QKm : KKm;
            const bf16x8 fa0 = *(const LAS bf16x8*)(src + (16 * a + l15) * 144 + 16 * g4), fa1 = *(const LAS bf16x8*)(src + (16 * a + l15) * 144 + 64 + 16 * g4);
#pragma unroll
            for (int bq = 0; bq < 4; ++bq) { const bf16x8 fb0 = *(const LAS bf16x8*)(Kb + (16 * bq + l15) * 144 + 16 * g4), fb1 = *(const LAS bf16x8*)(Kb + (16 * bq + l15) * 144 + 64 + 16 * g4);
                f32x4 acc = MFMA16P(fa0, fb0, ((f32x4){0.f, 0.f, 0.f, 0.f})); acc = MFMA16P(fa1, fb1, acc);
#pragma unroll
                for (int r = 0; r < 4; ++r) dst[(16 * a + 4 * g4 + r) * 65 + 16 * bq + l15] = acc[r]; } }
        __syncthreads();
        }
        for (int rp_ = 0; rp_ < GREP(4); ++rp_) {
#pragma unroll
        for (int d = 0; d < 2; ++d) { const int i = lane, ti = d ? 63 - i : i; const float gi = sm[d * 64 + i], bi_ = sm[128 + d * 64 + i];
#pragma unroll
            for (int k = 0; k < 8; ++k) { const int j = wave + 8 * k, tj = d ? 63 - j : j;
                Am[d * 4096 + j * 64 + i] = (j < i) ? bi_ * KKm[ti * 65 + tj] * fexp(gi - sm[d * 64 + j]) : 0.f; } }
        if (F.tid < 128) sm[256 + F.tid] = sm[128 + F.tid] * fexp(sm[F.tid]);
        __syncthreads();
        }
        for (int rp_ = 0; rp_ < GREP(5); ++rp_) {
        const int ch = F.tid, frg = ch >> 6, itl = frg >> 1, sst = frg & 1, rowx = 16 * itl + l15, kA = 32 * sst + 4 * g4;
#pragma unroll 1
        for (int d = 0; d < 2; ++d) {
            const int step = isctx ? (d ? 3 - n : n) : 4 + (d ? 127 - n : n); const size_t itemid = (size_t)((b * 2 + d) * 4 + h) * NSTEP + step;
            unsigned char* gb = GD + itemid * GDN_ITEM_BYTES;
            const LAS float* gam = sm + d * 64; const float glast = gam[63], grow = gam[rowx], erow = fexp(grow);
            float vq[8], vk[8], vp[8];
#pragma unroll
            for (int j = 0; j < 8; ++j) { const int k = kA + (j & 3) + ((j >> 2) << 4);
                const int trow = d ? 63 - rowx : rowx, tk = d ? 63 - k : k; const float gk = gam[k];
                vq[j] = feat[trow * 65 + k] * erow;
                vk[j] = feat[(64 + tk) * 65 + rowx] * fexp(glast - gk);
                vp[j] = (k <= rowx) ? QKm[trow * 65 + tk] * fexp(grow - gk) : 0.f; }
            v4u o;
            o.x = pk2(vk[0], vk[1]); o.y = pk2(vk[2], vk[3]); o.z = pk2(vk[4], vk[5]); o.w = pk2(vk[6], vk[7]); *(v4u*)(gb + 8192 + ch * 16) = o;
            o.x = pk2(vq[0], vq[1]); o.y = pk2(vq[2], vq[3]); o.z = pk2(vq[4], vq[5]); o.w = pk2(vq[6], vq[7]); *(v4u*)(gb + 16384 + ch * 16) = o;
            o.x = pk2(vp[0], vp[1]); o.y = pk2(vp[2], vp[3]); o.z = pk2(vp[4], vp[5]); o.w = pk2(vp[6], vp[7]); *(v4u*)(gb + 24576 + ch * 16) = o;
            if (F.tid == 0) GLp[itemid] = fexp(glast);
        }
        __syncthreads();
        }
        for (int rp_ = 0; rp_ < GREP(6); ++rp_) {
        { LAS unsigned char* Ab = LB; LAS unsigned char* TTb = LB + 18432; LAS unsigned char* Dfr = LB + 36864;
#pragma unroll
            for (int d = 0; d < 2; ++d)
#pragma unroll
                for (int k = 0; k < 8; ++k) { const int j = wave + 8 * k; *(LAS unsigned short*)(Ab + d * 9216 + lane * 144 + j * 2) = (unsigned short)(pk2(Am[d * 4096 + j * 64 + lane], 0.f) & 0xffffu); }
            for (int idx = F.tid; idx < 2 * 64 * 4; idx += NTHR) { const int d = idx >> 8, col = (idx >> 2) & 63, rb = idx & 3;
                if (rb != (col >> 4)) { *(LAS v4u*)(TTb + d * 9216 + col * 144 + rb * 32) = (v4u){0u, 0u, 0u, 0u}; *(LAS v4u*)(TTb + d * 9216 + col * 144 + rb * 32 + 16) = (v4u){0u, 0u, 0u, 0u}; } }
            { const int d = F.tid >> 8, b = (F.tid >> 6) & 3, cc = (F.tid >> 2) & 15, q = F.tid & 3; const LAS float* At = Am + d * 4096;
                float tb[4];
#pragma unroll
                for (int e = 0; e < 4; ++e) tb[e] = (4 * q + e == cc) ? 1.0f : 0.0f;
#pragma unroll
                for (int rp = 0; rp < 15; ++rp) { const float val = quad_bcast(tb[rp & 3], rp >> 2); const f32x4 a = *(const LAS f32x4*)(At + (16 * b + rp) * 64 + 16 * b + 4 * q);
#pragma unroll
                    for (int e = 0; e < 4; ++e) { const float upd = tb[e] - a[e] * val; tb[e] = (4 * q + e > rp) ? upd : tb[e]; } }
                LAS float* Td = Tm + d * 4160;
#pragma unroll
                for (int e = 0; e < 4; ++e) { const int r = 4 * q + e; Td[(16 * b + r) * 65 + 16 * b + cc] = tb[e];
                    LAS unsigned char* fr = Dfr + (size_t)(((d * 4 + b) * 64 + 16 * (cc >> 2) + r) * 16);
                    *(LAS unsigned short*)(fr + (cc & 3) * 2) = (unsigned short)(pk2(tb[e], 0.f) & 0xffffu);
                    if ((cc & 3) == 0) *(LAS v2u*)(fr + 8) = (v2u){0u, 0u}; }
                v2u o; o.x = pk2(tb[0], tb[1]); o.y = pk2(tb[2], tb[3]);
                *(LAS v2u*)(TTb + d * 9216 + (16 * b + cc) * 144 + (16 * b + 4 * q) * 2) = o; }
            { const int d = wave >> 2, cb = wave & 3; LAS float* Td = Tm + d * 4160;
#pragma unroll
                for (int bi = 0; bi < 3; ++bi) if (bi < cb) {
#pragma unroll
                    for (int r = 0; r < 4; ++r) Td[(16 * bi + 4 * g4 + r) * 65 + 16 * cb + l15] = 0.f; } }
            __syncthreads();
#pragma unroll
            for (int bi = 1; bi < 4; ++bi) {
                const int d = wave >> 2, cb = wave & 3;
                if (cb < bi) {
                    const LAS unsigned char* ap = Ab + d * 9216 + (16 * bi + l15) * 144 + 16 * g4; const LAS unsigned char* tp = TTb + d * 9216 + (16 * cb + l15) * 144 + 16 * g4;
                    f32x4 x = MFMA16P(*(const LAS bf16x8*)ap, *(const LAS bf16x8*)tp, ((f32x4){0.f, 0.f, 0.f, 0.f}));
                    if (bi == 3) x = MFMA16P(*(const LAS bf16x8*)(ap + 64), *(const LAS bf16x8*)(tp + 64), x);
                    v4u yb; yb.x = pk2(-x[0], -x[1]); yb.y = pk2(-x[2], -x[3]); yb.z = 0u; yb.w = 0u;
                    const bf16x8 df = *(const LAS bf16x8*)(Dfr + (size_t)(((d * 4 + bi) * 64 + lane) * 16));
                    const f32x4 tt = MFMA16P(df, __builtin_bit_cast(bf16x8, yb), ((f32x4){0.f, 0.f, 0.f, 0.f}));
                    LAS float* Td = Tm + d * 4160;
#pragma unroll
                    for (int r = 0; r < 4; ++r) Td[(16 * bi + 4 * g4 + r) * 65 + 16 * cb + l15] = tt[r];
                    v2u tw; tw.x = pk2(tt[0], tt[1]); tw.y = pk2(tt[2], tt[3]);
                    *(LAS v2u*)(TTb + d * 9216 + (16 * cb + l15) * 144 + (16 * bi + 4 * g4) * 2) = tw;
                }
                __syncthreads();
            }
        }
        }
        for (int rp_ = 0; rp_ < GREP(7); ++rp_) {
#pragma unroll
        for (int m = 0; m < 2; ++m) { const int q = F.tid + NTHR * m, d = q >> 9, i = (q >> 3) & 63, c8 = (q & 7) * 8; const LAS float* Td = Tm + d * 4160 + i * 65;
            float xu[8], xw[8];
#pragma unroll
            for (int e = 0; e < 8; ++e) { const int ip = d ? 63 - (c8 + e) : c8 + e; const float t = Td[ip]; xu[e] = t * sm[128 + d * 64 + ip]; xw[e] = t * sm[256 + d * 64 + ip]; }
            v4u o; o.x = pk2(xu[0], xu[1]); o.y = pk2(xu[2], xu[3]); o.z = pk2(xu[4], xu[5]); o.w = pk2(xu[6], xu[7]); *(LAS v4u*)(TU + d * 9216 + i * 144 + c8 * 2) = o;
            o.x = pk2(xw[0], xw[1]); o.y = pk2(xw[2], xw[3]); o.z = pk2(xw[4], xw[5]); o.w = pk2(xw[6], xw[7]); *(LAS v4u*)(TU + 18432 + d * 9216 + i * 144 + c8 * 2) = o; }
        __syncthreads();
        }
        for (int rp_ = 0; rp_ < GREP(8); ++rp_) {
        { const int d = wave >> 2, it = wave & 3;
            const int step = isctx ? (d ? 3 - n : n) : 4 + (d ? 127 - n : n); const size_t itemid = (size_t)((b * 2 + d) * 4 + h) * NSTEP + step;
            unsigned char* gb = GD + itemid * GDN_ITEM_BYTES;
            const LAS unsigned char* tu = TU + d * 9216 + (16 * it + l15) * 144 + 16 * g4; const LAS unsigned char* tw = TU + 18432 + d * 9216 + (16 * it + l15) * 144 + 16 * g4;
            const bf16x8 ta0 = *(const LAS bf16x8*)tu, ta1 = *(const LAS bf16x8*)(tu + 64), tw0 = *(const LAS bf16x8*)tw, tw1 = *(const LAS bf16x8*)(tw + 64);
#pragma unroll
            for (int sl = 0; sl < 4; ++sl) { const LAS unsigned char* vp = VT + (16 * sl + l15) * 144 + 16 * g4;
                f32x4 acc = MFMA16P(ta0, *(const LAS bf16x8*)vp, ((f32x4){0.f, 0.f, 0.f, 0.f})); acc = MFMA16P(ta1, *(const LAS bf16x8*)(vp + 64), acc);
                *(f32x4*)(gb + 32768 + (size_t)((it * 4 + sl) * 64 + lane) * 16) = acc; }
#pragma unroll
            for (int sp = 0; sp < 2; ++sp) { const LAS unsigned char* k0 = KT + (16 * (2 * sp) + l15) * 144 + 16 * g4; const LAS unsigned char* k1 = KT + (16 * (2 * sp + 1) + l15) * 144 + 16 * g4;
                f32x4 c0 = MFMA16P(*(const LAS bf16x8*)k0, tw0, ((f32x4){0.f, 0.f, 0.f, 0.f})); c0 = MFMA16P(*(const LAS bf16x8*)(k0 + 64), tw1, c0);
                f32x4 c1 = MFMA16P(*(const LAS bf16x8*)k1, tw0, ((f32x4){0.f, 0.f, 0.f, 0.f})); c1 = MFMA16P(*(const LAS bf16x8*)(k1 + 64), tw1, c1);
                v4u o; o.x = pk2(-c0[0], -c0[1]); o.y = pk2(-c0[2], -c0[3]); o.z = pk2(-c1[0], -c1[1]); o.w = pk2(-c1[2], -c1[3]);
                *(v4u*)(gb + (size_t)((it * 2 + sp) * 64 + lane) * 16) = o; } }
        __syncthreads();
        }
    }
}

#undef GDN_PREFETCH
#undef GDN_ITEM_GEOM
__device__ __forceinline__ bf16x8 pack_tiles(f32x4 t0, f32x4 t1) { v4u o; o.x = pk2(t0[0], t0[1]); o.y = pk2(t0[2], t0[3]); o.z = pk2(t1[0], t1[1]); o.w = pk2(t1[2], t1[3]); return __builtin_bit_cast(bf16x8, o); }
#define MFMA16(a, b, c) __builtin_amdgcn_mfma_f32_16x16x32_bf16(a, b, c, 0, 0, 0)
constexpr int SCAN_SLOT = 20480, SCAN_NSLOT = 6, SCAN_AHEAD = 5, NSCANBLK = NSCAN * 4;
__device__ __forceinline__ void phase_gdn_scan(Frame& F, const Args& A, int layer) {
    relane(F);
    const int xq_ = (int)blockIdx.x >> 3, bd = ((int)blockIdx.x & 7) + 8 * (xq_ >> 2), sl = xq_ & 3, lane = F.lane, wave = F.wave;
    const unsigned char* gbase = F.ws + WS_GDN + (size_t)bd * NSTEP * GDN_ITEM_BYTES;
    unsigned char* svb = F.ws + WS_OG + (size_t)bd * NSTEP * 16384;
    LAS unsigned char* ring = F.lds;
    LAS float* glL = (LAS float*)(F.lds + RING_BYTES + 1024);
    for (int i = F.tid; i < NSTEP; i += NTHR) glL[i] = wsp<float>(F, WS_GL)[bd * NSTEP + i];
    const bool loader = wave >= 1; const int lw = wave - 1;
#define SCAN_ISSUE(stp) do { LAS unsigned char* sb_ = ring + ((stp) % SCAN_NSLOT) * SCAN_SLOT; const unsigned char* gb_ = gbase + (size_t)(stp) * GDN_ITEM_BYTES + lane * 16; \
        _Pragma("unroll") for (int q_ = 0; q_ < 3; ++q_) { const int p0_ = lw * 3 + q_, p_ = p0_ < 20 ? p0_ : 19;   \
            __builtin_amdgcn_global_load_lds((const unsigned*)(gb_ + (p_ < 16 ? p_ * 1024 : 32768 + ((p_ - 16) * 4 + sl) * 1024)), (LAS unsigned*)(sb_ + p_ * 1024), 16, 0, 0); } } while (0)
    if (loader) { SCAN_ISSUE(0); SCAN_ISSUE(1); SCAN_ISSUE(2); SCAN_ISSUE(3); SCAN_ISSUE(4); }
    f32x4 S[4];
#pragma unroll
    for (int j = 0; j < 4; ++j) S[j] = (f32x4){0.f, 0.f, 0.f, 0.f};
    bf16x8 wfA[4][2], kfA[4][2], wfB[4][2], kfB[4][2]; f32x4 vnA[4], vnB[4]; float glA = 0.f, glB = 0.f;
    asm volatile("s_waitcnt lgkmcnt(0)" ::: "memory");
#define SCAN_SYNC(n_) do { if ((n_) < NSTEP) { \
        if (loader) { const int rem = NSTEP - 1 - (n_); \
            if (rem >= 4) asm volatile("s_waitcnt vmcnt(12)" ::: "memory"); else if (rem == 3) asm volatile("s_waitcnt vmcnt(9)" ::: "memory"); else if (rem == 2) asm volatile("s_waitcnt vmcnt(6)" ::: "memory"); \
            else if (rem == 1) asm volatile("s_waitcnt vmcnt(3)" ::: "memory"); else asm volatile("s_waitcnt vmcnt(0)" ::: "memory"); } \
        asm volatile("s_waitcnt lgkmcnt(0)" ::: "memory"); __builtin_amdgcn_s_barrier(); asm volatile("" ::: "memory"); \
        if (loader) { if ((n_) + SCAN_AHEAD < NSTEP) SCAN_ISSUE((n_) + SCAN_AHEAD); } } } while (0)
#define SCAN_READ(n_, WF, KF, VN, GL) do { if ((n_) < NSTEP) { const LAS unsigned char* slot = ring + ((n_) % SCAN_NSLOT) * SCAN_SLOT + lane * 16; \
        _Pragma("unroll") for (int i = 0; i < 4; ++i) { WF[i][0] = *(const LAS bf16x8*)(slot + (i * 2) * 1024); WF[i][1] = *(const LAS bf16x8*)(slot + (i * 2 + 1) * 1024); VN[i] = *(const LAS f32x4*)(slot + 16384 + i * 1024); } \
        _Pragma("unroll") for (int j = 0; j < 4; ++j) { KF[j][0] = *(const LAS bf16x8*)(slot + 8192 + (j * 2) * 1024); KF[j][1] = *(const LAS bf16x8*)(slot + 8192 + (j * 2 + 1) * 1024); } \
        GL = glL[(n_)]; } } while (0)
#define SCAN_COMP(m_, WF, KF, VN, GL) do { \
        const bf16x8 bs0 = pack_tiles(S[0], S[1]), bs1 = pack_tiles(S[2], S[3]); \
        _Pragma("unroll") for (int i = 0; i < 4; ++i) VN[i] = MFMA16(WF[i][0], bs0, VN[i]); \
        _Pragma("unroll") for (int i = 0; i < 4; ++i) VN[i] = MFMA16(WF[i][1], bs1, VN[i]); \
        _Pragma("unroll") for (int j = 0; j < 4; ++j) S[j] = S[j] * GL; \
        const bf16x8 bv0 = pack_tiles(VN[0], VN[1]), bv1 = pack_tiles(VN[2], VN[3]); \
        _Pragma("unroll") for (int j = 0; j < 4; ++j) S[j] = MFMA16(KF[j][0], bv0, S[j]); \
        _Pragma("unroll") for (int j = 0; j < 4; ++j) S[j] = MFMA16(KF[j][1], bv1, S[j]); \
        if (!((m_) < 4 && layer == 1)) { unsigned char* sv = svb + ((size_t)(m_) * 4 + sl) * 4096 + lane * 16; \
            *(bf16x8*)(sv) = bs0; *(bf16x8*)(sv + 1024) = bs1; *(bf16x8*)(sv + 2048) = bv0; *(bf16x8*)(sv + 3072) = bv1; } } while (0)
    SCAN_SYNC(0); if (wave == 0) SCAN_READ(0, wfA, kfA, vnA, glA);
#pragma unroll 1
    for (int n = 1; n <= NSTEP; n += 2) {
        SCAN_SYNC(n);
        if (wave == 0) { SCAN_READ(n, wfB, kfB, vnB, glB); SCAN_COMP(n - 1, wfA, kfA, vnA, glA); }
        SCAN_SYNC(n + 1);
        if (wave == 0) { SCAN_READ(n + 1, wfA, kfA, vnA, glA); SCAN_COMP(n, wfB, kfB, vnB, glB); }
    }
#undef SCAN_SYNC
#undef SCAN_READ
#undef SCAN_COMP
#undef SCAN_ISSUE
    asm volatile("s_waitcnt vmcnt(0) lgkmcnt(0)" ::: "memory");
    __builtin_amdgcn_s_barrier();
    asm volatile("" ::: "memory");
}

__device__ __forceinline__ void phase_gdn_out(Frame& F, const Args& A, int layer) {
    relane(F);
    const int nitems = (layer == 0 ? 264 : 256) * 4;
    LAS float* oL = (LAS float*)F.lds;
    const bf16* P = wsp<bf16>(F, WS_P); bf16* MIX = wsp<bf16>(F, WS_H);
    const unsigned char* GD = F.ws + WS_GDN; const unsigned char* SV = F.ws + WS_OG;
    const int lane = F.lane, d = F.wave >> 2, sl = F.wave & 3;
    for (int item = blockIdx.x; item < nitems; item += F.G) {
        const int sc = item >> 2, h = item & 3;
        int b, n, sbase, isctx;
        if (sc < 256) { b = sc >> 7; n = sc & 127; sbase = b * SEQ; isctx = 0; } else { const int cc = sc - 256; b = cc >> 2; n = cc & 3; sbase = NLAT + b * CTXL; isctx = 1; }
        const int step = isctx ? (d ? 3 - n : n) : 4 + (d ? 127 - n : n); const size_t itemid = (size_t)((b * 2 + d) * 4 + h) * NSTEP + step;
        const unsigned char* gb = GD + itemid * GDN_ITEM_BYTES; const unsigned char* sv = SV + (itemid * 4 + sl) * 4096 + lane * 16;
        bf16x8 qg[4][2], pp[4][2];
#pragma unroll
        for (int i = 0; i < 4; ++i)
#pragma unroll
            for (int s = 0; s < 2; ++s) { qg[i][s] = *(const bf16x8*)(gb + 16384 + ((i * 2 + s) * 64 + lane) * 16); pp[i][s] = *(const bf16x8*)(gb + 24576 + ((i * 2 + s) * 64 + lane) * 16); }
        const bf16x8 bs0 = *(const bf16x8*)(sv), bs1 = *(const bf16x8*)(sv + 1024), bv0 = *(const bf16x8*)(sv + 2048), bv1 = *(const bf16x8*)(sv + 3072);
        const v4u zw = *(const v4u*)(P + ((size_t)sbase + 64 * n + (F.tid >> 3)) * PN + PC_Z + h * 64 + (F.tid & 7) * 8);
#pragma unroll
        for (int i = 0; i < 4; ++i) { f32x4 o = MFMA16(qg[i][0], bs0, ((f32x4){0.f, 0.f, 0.f, 0.f})); o = MFMA16(qg[i][1], bs1, o); o = MFMA16(pp[i][0], bv0, o); o = MFMA16(pp[i][1], bv1, o);
#pragma unroll
            for (int r = 0; r < 4; ++r) { const int c = 16 * i + 4 * (lane >> 4) + r, tr = d ? 63 - c : c; oL[(d * 64 + tr) * 68 + sl * 16 + (lane & 15)] = o[r]; } }
        __syncthreads();
        { const int tok = F.tid >> 3, d8 = (F.tid & 7) * 8; const size_t row = (size_t)sbase + 64 * n + tok;
            const f32x4 a0 = *(const LAS f32x4*)(oL + tok * 68 + d8) + *(const LAS f32x4*)(oL + (64 + tok) * 68 + d8), a1 = *(const LAS f32x4*)(oL + tok * 68 + d8 + 4) + *(const LAS f32x4*)(oL + (64 + tok) * 68 + d8 + 4);
            float ss = dot4(a0, a0) + dot4(a1, a1); ss += __shfl_xor(ss, 1); ss += __shfl_xor(ss, 2); ss += __shfl_xor(ss, 4);
            const float rstd = rsqrtf(ss * (1.0f / 64.0f) + EPS);
            const f32x4 g0 = *(const f32x4*)(A.in[18] + layer * 64 + d8), g1 = *(const f32x4*)(A.in[18] + layer * 64 + d8 + 4);
            const f32x4 z0 = {bflo(zw.x), bfhi(zw.x), bflo(zw.y), bfhi(zw.y)}, z1 = {bflo(zw.z), bfhi(zw.z), bflo(zw.w), bfhi(zw.w)};
            const f32x4 y0 = a0 * rstd * g0 * (f32x4){silu_acc(z0[0]), silu_acc(z0[1]), silu_acc(z0[2]), silu_acc(z0[3])};
            const f32x4 y1 = a1 * rstd * g1 * (f32x4){silu_acc(z1[0]), silu_acc(z1[1]), silu_acc(z1[2]), silu_acc(z1[3])};
            v4u o; o.x = pk2(y0[0], y0[1]); o.y = pk2(y0[2], y0[3]); o.z = pk2(y1[0], y1[1]); o.w = pk2(y1[2], y1[3]);
            *(v4u*)(MIX + row * 1024 + 256 + h * 64 + d8) = o; }
        __syncthreads();
    }
}

__device__ __forceinline__ void phase_attn_merge(Frame& F) {
    relane(F);
    if (F.G != 256) return;
    bf16* MIX = wsp<bf16>(F, WS_H); const bf16* PO = wsp<bf16>(F, WS_PARTO); const float* PL = wsp<float>(F, WS_PARTL);
    for (int q4 = blockIdx.x; q4 < NSCANBLK * 4; q4 += F.G) {
        const int su = q4 >> 2;
        const int vs = (su % 8) * (F.G / 8) + su / 8, U = vs + F.G;
        const int x = (U & 255) >> 5, j = U & 31, i = U >> 8, pair = x >> 1, b = pair >> 1, kvh = pair & 1, head = kvh * 4 + (x & 1) * 2 + i;
        const size_t qrow = (size_t)b * SEQ + (size_t)j * 256;
        const int r = (q4 & 3) * 64 + (F.tid >> 3), d8 = (F.tid & 7) * 8;
        float L[4], w[4]; float lm = -INFINITY;
        bf16* mp = MIX + (qrow + r) * 1024 + 512 + head * 64 + d8;
        f32x4 pv[4][2];
        pv[0][0] = ld_bf4(mp); pv[0][1] = ld_bf4(mp + 4);
#pragma unroll
        for (int p = 0; p < 3; ++p) { const bf16* pp = PO + (((size_t)su * 3 + p) * 256 + r) * 64 + d8; pv[1 + p][0] = ld_bf4(pp); pv[1 + p][1] = ld_bf4(pp + 4); }
#pragma unroll
        for (int p = 0; p < 4; ++p) { L[p] = PL[((size_t)su * 4 + p) * 256 + r]; lm = fmaxf(lm, L[p]); }
        float ws = 0.f;
#pragma unroll
        for (int p = 0; p < 4; ++p) { w[p] = __builtin_amdgcn_exp2f(L[p] - lm); ws += w[p]; }
        const float inv = 1.0f / ws;
        f32x4 a0 = pv[0][0] * (w[0] * inv), a1 = pv[0][1] * (w[0] * inv);
#pragma unroll
        for (int p = 1; p < 4; ++p) { a0 = a0 + pv[p][0] * (w[p] * inv); a1 = a1 + pv[p][1] * (w[p] * inv); }
        st_bf4(mp, a0); st_bf4(mp + 4, a1);
    }
}

__device__ __forceinline__ void phase_route(Frame& F, const Args& A, int layer, bool dry = false) {
    relane(F);
    const int nrows = layer == 0 ? NTOK : NLAT;
    LAS int* hist = (LAS int*)(F.lds + RING_BYTES + 4096);
    if (F.tid < 32) hist[F.tid] = 0;
    const float* mod = wsp<float>(F, WS_MOD) + layer * 3 * 6144; const float* g2n = A.in[7] + layer * 1024;
    const float* WGT = wsp<float>(F, WS_WGT) + layer * 4096; const float* WETg = wsp<float>(F, WS_WET) + layer * 32768;
    LAS float* WET = (LAS float*)F.lds;
    { const unsigned lds0 = (unsigned)(uintptr_t)F.lds_g;
#pragma unroll
        for (int q = 0; q < 16; ++q) { const int piece = F.wave * 16 + q; attn_body::glds16(WETg + piece * 256 + F.lane * 4, (unsigned)__builtin_amdgcn_readfirstlane(lds0 + piece * 1024)); } }
    f32x4 wg[4][4], gn4[4], sc4[4], sh4[4]; int msc = -1;
#pragma unroll
    for (int gi = 0; gi < 4; ++gi)
#pragma unroll
        for (int j = 0; j < 4; ++j) wg[gi][j] = *(const f32x4*)(WGT + gi * 1024 + 4 * F.lane + 256 * j);
#pragma unroll
    for (int j = 0; j < 4; ++j) gn4[j] = *(const f32x4*)(g2n + 4 * F.lane + 256 * j);
    asm volatile("s_waitcnt vmcnt(0)" ::: "memory");
    __syncthreads();
    const float* brg = A.in[23] + layer * 4; const float* bre = A.in[25] + layer * 32;
    bf16* H2 = wsp<bf16>(F, WS_H); int* EID = wsp<int>(F, WS_EID); float* WTS = wsp<float>(F, WS_WTS);
    ROW_BATCH_BEGIN(nrows)
        f32x4 vv[3][4];
#pragma unroll
        for (int u = 0; u < 3; ++u) { const int r = row[u]; const bf16* xr = r < NLAT ? (layer == 0 ? (const bf16*)F.out : wsp<bf16>(F, WS_P)) + (size_t)r * 1024 : wsp<bf16>(F, WS_XCTX) + (size_t)(r - NLAT) * 1024;
#pragma unroll
            for (int j = 0; j < 4; ++j) vv[u][j] = ld_bf4(xr + 4 * F.lane + 256 * j); }
        float gs[16];
#pragma unroll
        for (int u = 0; u < 3; ++u) { const int r = row[u], ms = msel_of(r);
            float ss = 0.f;
#pragma unroll
            for (int j = 0; j < 4; ++j) ss += dot4(vv[u][j], vv[u][j]);
            const float rstd = rsqrtf(wave_sum(ss) * (1.0f / 1024.0f) + EPS);
            if (ms != msc) { msc = ms;
#pragma unroll
                for (int j = 0; j < 4; ++j) { sc4[j] = *(const f32x4*)(mod + ms * 6144 + 4096 + 4 * F.lane + 256 * j); sh4[j] = *(const f32x4*)(mod + ms * 6144 + 3072 + 4 * F.lane + 256 * j); } }
#pragma unroll
            for (int j = 0; j < 4; ++j) { const int k = 4 * F.lane + 256 * j;
                vv[u][j] = vv[u][j] * rstd * gn4[j] * (sc4[j] + 1.0f) + sh4[j];
                if (!dry) st_bf4(H2 + (size_t)r * 1024 + k, vv[u][j]); }
#pragma unroll
            for (int gi = 0; gi < 4; ++gi) { float a = 0.f;
#pragma unroll
                for (int j = 0; j < 4; ++j) a += dot4(vv[u][j], wg[gi][j]);
                gs[u * 4 + gi] = a; } }
        gs[12] = 0.f; gs[13] = 0.f; gs[14] = 0.f; gs[15] = 0.f;
        const float gz = treduce16(gs, F.lane);
        int grp_[3]; float pg_[3]; float es[3][8];
#pragma unroll
        for (int u = 0; u < 3; ++u) {
            float lg[4];
#pragma unroll
            for (int gi = 0; gi < 4; ++gi) lg[gi] = rdlane_f(gz, BR4(u * 4 + gi)) + brg[gi];
            int grp = 0; float lmax = lg[0];
#pragma unroll
            for (int gi = 1; gi < 4; ++gi) if (lg[gi] > lmax) { lmax = lg[gi]; grp = gi; }
            float den = 0.f;
#pragma unroll
            for (int gi = 0; gi < 4; ++gi) den += expf(lg[gi] - lmax);
            pg_[u] = 1.0f / den;
            grp = __builtin_amdgcn_readfirstlane(grp); grp_[u] = grp;
#pragma unroll
            for (int e = 0; e < 8; ++e) { float a = 0.f;
#pragma unroll
                for (int j = 0; j < 4; ++j) a += dot4(vv[u][j], *(const LAS f32x4*)(WET + (grp * 8 + e) * 1024 + 4 * F.lane + 256 * j));
                es[u][e] = a; } }
        float e01[16];
#pragma unroll
        for (int e = 0; e < 8; ++e) { e01[e] = es[0][e]; e01[8 + e] = es[1][e]; }
        const float ez01 = treduce16(e01, F.lane), ez2 = treduce8(es[2], F.lane);
#pragma unroll
        for (int u = 0; u < 3; ++u) { const int r = row[u], grp = grp_[u]; const float pg_sel = pg_[u];
            float le[8];
#pragma unroll
            for (int e = 0; e < 8; ++e) le[e] = (u == 2 ? rdlane_f(ez2, BR3(e)) : rdlane_f(ez01, BR4(u * 8 + e))) + bre[grp * 8 + e];
            int i1 = 0; float l1 = le[0];
#pragma unroll
            for (int e = 1; e < 8; ++e) if (le[e] > l1) { l1 = le[e]; i1 = e; }
            int i2 = -1; float l2 = -INFINITY;
#pragma unroll
            for (int e = 0; e < 8; ++e) if (e != i1 && le[e] > l2) { l2 = le[e]; i2 = e; }
            const float p2 = expf(l2 - l1), inv = 1.0f / (1.0f + p2);
            if (F.lane == 0 && valid[u] && !dry) { const int e0 = grp * 8 + i1, e1 = grp * 8 + i2; EID[r * 2] = e0; EID[r * 2 + 1] = e1; WTS[r * 2] = pg_sel * inv; WTS[r * 2 + 1] = pg_sel * p2 * inv;
                __hip_atomic_fetch_add(&hist[e0], 1, __ATOMIC_RELAXED, __HIP_MEMORY_SCOPE_WORKGROUP); __hip_atomic_fetch_add(&hist[e1], 1, __ATOMIC_RELAXED, __HIP_MEMORY_SCOPE_WORKGROUP); }
        }
    ROW_BATCH_END
    __syncthreads();
    if (F.tid < 32 && hist[F.tid] != 0) atomicAdd(wsp<int>(F, WS_CTL) + CW_CNT + layer * 32 + F.tid, hist[F.tid]);
}

__device__ __forceinline__ void phase_slots(Frame& F, const Args& A, int layer) {
    relane(F);
    const int nrows = layer == 0 ? NTOK : NLAT;
    LAS int* li = (LAS int*)F.lds;
    int* ctl = wsp<int>(F, WS_CTL);
    if (F.tid < 32) { li[F.tid] = 0; li[32 + F.tid] = 0; }
    if (F.tid < 64) {
        const int e = F.tid & 31; const int c = __hip_atomic_load(ctl + CW_CNT + layer * 32 + e, __ATOMIC_RELAXED, __HIP_MEMORY_SCOPE_AGENT); const int nt = (c + 255) >> 8; int incl = nt;
#pragma unroll
        for (int o = 1; o < 32; o <<= 1) { const int t = __shfl_up(incl, o, 32); if (e >= o) incl += t; }
        const int excl = incl - nt;
        if (F.tid < 32) { li[64 + e] = excl * 256; li[128 + e] = c;
            if (blockIdx.x == 0) { for (int t = 0; t < nt; ++t) ctl[CW_TE + layer * 256 + excl + t] = e; if (e == 31) ctl[CW_NT + layer] = incl; } } }
    __syncthreads();
    const int* EID = wsp<int>(F, WS_EID); int* SLOT = wsp<int>(F, WS_SLOT);
    { const int RPW = (nrows + F.NGW - 1) / F.NGW, r0 = F.gw * RPW, r1 = (r0 + RPW < nrows) ? r0 + RPW : nrows;
      for (int i = r0 * 2 + F.lane; i < r1 * 2; i += 64) __hip_atomic_fetch_add(&li[EID[i]], 1, __ATOMIC_RELAXED, __HIP_MEMORY_SCOPE_WORKGROUP); }
    __syncthreads();
    if (F.tid < 32) li[96 + F.tid] = li[F.tid] ? atomicAdd(ctl + CW_CUR + layer * 32 + F.tid, li[F.tid]) : 0;
    __syncthreads();
    int* STOK = wsp<int>(F, WS_STOK);
    if (blockIdx.x == 0) {
        for (int e = 0; e < 32; ++e) { const int c = li[128 + e]; const int base = li[64 + e], pad = ((c + 255) & ~255);
            for (int s = c + F.tid; s < pad; s += NTHR) STOK[base + s] = 0; } }
    { const int RPW = (nrows + F.NGW - 1) / F.NGW, r0 = F.gw * RPW, r1 = (r0 + RPW < nrows) ? r0 + RPW : nrows;
      for (int i = r0 * 2 + F.lane; i < r1 * 2; i += 64) { const int e = EID[i]; const int slot = li[64 + e] + li[96 + e] + __hip_atomic_fetch_add(&li[32 + e], 1, __ATOMIC_RELAXED, __HIP_MEMORY_SCOPE_WORKGROUP);
          SLOT[i] = slot; STOK[slot] = i >> 1; } }
}

__device__ __forceinline__ void phase_final(Frame& F, const Args& A, bool dry = false) {
    relane(F);
    const float* mod = wsp<float>(F, WS_MOD) + 3 * 6144; const float* gf = A.in[29];
    const int* SLOT = wsp<int>(F, WS_SLOT); const float* WTS = wsp<float>(F, WS_WTS); const bf16* Y = wsp<bf16>(F, WS_GDN);
    f32x4 gf4[4], g24[4]; int msc = -1;
#pragma unroll
    for (int j = 0; j < 4; ++j) gf4[j] = *(const f32x4*)(gf + 4 * F.lane + 256 * j);
    ROW_RANGE(NLAT)
    int sl_all = 0; float wt_all = 0.f;
    if (rbeg_ * 2 + F.lane < rend_ * 2) { sl_all = SLOT[rbeg_ * 2 + F.lane]; wt_all = WTS[rbeg_ * 2 + F.lane]; }
    ROW_BATCH_LOOP
        f32x4 v[3][4]; v2u y0[3][4], y1[3][4]; float w0[3], w1[3];
#pragma unroll
        for (int u = 0; u < 3; ++u) { const int r = row[u]; const bf16* xr = wsp<bf16>(F, WS_P) + (size_t)r * 1024; const int li_ = (r - rbeg_) * 2; const int s0 = __builtin_amdgcn_readlane(sl_all, li_), s1 = __builtin_amdgcn_readlane(sl_all, li_ + 1);
            w0[u] = __int_as_float(__builtin_amdgcn_readlane(__float_as_int(wt_all), li_)); w1[u] = __int_as_float(__builtin_amdgcn_readlane(__float_as_int(wt_all), li_ + 1));
#pragma unroll
            for (int j = 0; j < 4; ++j) { const int k = 4 * F.lane + 256 * j; v[u][j] = ld_bf4(xr + k); y0[u][j] = *(const v2u*)(Y + (size_t)s0 * 1024 + k); y1[u][j] = *(const v2u*)(Y + (size_t)s1 * 1024 + k); } }
#pragma unroll
        for (int u = 0; u < 3; ++u) { const int r = row[u], ms = r >> 13; float* xr = F.out + (size_t)r * 1024; float ss = 0.f;
            if (ms != msc) { msc = ms;
#pragma unroll
                for (int j = 0; j < 4; ++j) g24[j] = *(const f32x4*)(mod + ms * 6144 + 5120 + 4 * F.lane + 256 * j); }
#pragma unroll
            for (int j = 0; j < 4; ++j) { const int k = 4 * F.lane + 256 * j;
                const f32x4 a0 = {bflo(y0[u][j].x), bfhi(y0[u][j].x), bflo(y0[u][j].y), bfhi(y0[u][j].y)}, a1 = {bflo(y1[u][j].x), bfhi(y1[u][j].x), bflo(y1[u][j].y), bfhi(y1[u][j].y)};
                v[u][j] = v[u][j] + g24[j] * (a0 * w0[u] + a1 * w1[u]); ss += dot4(v[u][j], v[u][j]); }
            const float rstd = rsqrtf(wave_sum(ss) * (1.0f / 1024.0f) + EPS);
            if (valid[u] && !dry) {
#pragma unroll
                for (int j = 0; j < 4; ++j) { const int k = 4 * F.lane + 256 * j; *(f32x4*)(xr + k) = v[u][j] * rstd * gf4[j]; } } }
    ROW_BATCH_END
}

#ifndef MK_MULTI
#define MK_MULTI 0
#endif
#ifndef MK_ONLY
#define MK_ONLY -1
#endif
#define EN(c) (MK_ONLY < 0 || MK_ONLY == (c))
#ifndef MK_EXTRA_BARRIERS
#define MK_EXTRA_BARRIERS 0
#endif
#ifndef MK_ATT_DV
#define MK_ATT_DV 0
#endif
#ifndef MK_FORCE_NOMAX
#define MK_FORCE_NOMAX 0
#endif
#ifndef MK_REP_MASK
#define MK_REP_MASK 0
#endif
#define REPS(c) (((MK_REP_MASK >> (c)) & 1) ? 2 : 1)
constexpr int N_PHASES = 22;

__device__ __forceinline__ void phase_mixers(Frame& F, const Args& A, int layer) {
    if (EN(6) && blockIdx.x < NSCANBLK) for (int rep = 0; rep < REPS(6); ++rep) phase_gdn_scan(F, A, layer);
    if (EN(7)) {
        const int M = layer == 0 ? NTOK : NLAT;
        pg8::Gemm g{wsp<bf16>(F, WS_CF), wsp<bf16>(F, WS_WPW) + (size_t)layer * 65536, M, 256, 256, nullptr};
        pg8::StaticOrder S; S.init(M, 256, F.G, (int)blockIdx.x - NSCANBLK);
        pg8::EpiBf16<true> E{wsp<bf16>(F, WS_H), 1024, A.in[14] + layer * 256};
        pg8::gemm_phase<pg8::EpiBf16<true>, pg8::StaticOrder, true, true>(F.lds, g, S, E);
        __syncthreads();
    }
    if (EN(8)) for (int rep = 0; rep < REPS(8); ++rep) {
        using abf = attn_body::bf16;
        const abf* Q = (const abf*)wsp<bf16>(F, WS_Q); const abf* K = (const abf*)wsp<bf16>(F, WS_K); const abf* V = (const abf*)wsp<bf16>(F, WS_V); abf* MIX = (abf*)wsp<bf16>(F, WS_H);
        const bool split_ok = (F.G == 256);
        const float* gqp = A.in[19] + layer * 64; const float* gkp = A.in[20] + layer * 64;
#define ATTN_CALL(OPITCH, ...) do { float M0; { const int l6 = opaque_tid() & 63; float gq = fabsf(gqp[l6]), gk = fabsf(gkp[l6]); \
            _Pragma("unroll") for (int o = 1; o < 64; o <<= 1) { gq = fmaxf(gq, __shfl_xor(gq, o)); gk = fmaxf(gk, __shfl_xor(gk, o)); } \
            M0 = 8.0f * 1.4426950408889634f * gq * gk; } \
        if (MK_FORCE_NOMAX || __builtin_amdgcn_readfirstlane((int)(M0 < 56.0f))) { if (MK_ATT_DV && rep + 1 < REPS(8)) attn_body::attn_unit<8, OPITCH, true, MK_ATT_DV>(__VA_ARGS__, M0); else attn_body::attn_unit<8, OPITCH, true>(__VA_ARGS__, M0); } else attn_body::attn_unit<8, OPITCH, false>(__VA_ARGS__, 0.f); } while (0)
        bf16* PO = wsp<bf16>(F, WS_PARTO); float* PL = wsp<float>(F, WS_PARTL);
        for (int U = F.vcu; U < 512; U += F.G) {
            const int x = (U & 255) >> 5, j = U & 31, i = U >> 8, pair = x >> 1, b = pair >> 1, kvh = pair & 1, head = kvh * 4 + (x & 1) * 2 + i;
            const size_t qrow = (size_t)b * SEQ + (size_t)j * 256;
            const bool split = split_ok && i == 1 && (int)blockIdx.x < NSCANBLK;
            ATTN_CALL(1024, Q + qrow * 512 + head * 64, K + (size_t)b * KVROWS * 128 + kvh * 64, V + (size_t)b * KVROWS * 128 + kvh * 64, MIX + qrow * 1024 + 512 + head * 64,
                                          split ? ATT_SPLIT_MAIN : ATT_NT, (char*)F.lds_g, split ? PL + ((size_t)blockIdx.x * 4) * 256 : nullptr);
        }
        if (split_ok && (int)blockIdx.x >= NSCANBLK) {
            const int hb = (int)blockIdx.x - NSCANBLK, su = hb / 3, part = hb % 3;
            const int vs = (su % 8) * (F.G / 8) + su / 8, U = vs + F.G;
            const int x = (U & 255) >> 5, j = U & 31, i = U >> 8, pair = x >> 1, b = pair >> 1, kvh = pair & 1, head = kvh * 4 + (x & 1) * 2 + i;
            const size_t qrow = (size_t)b * SEQ + (size_t)j * 256; const size_t koff = (size_t)b * KVROWS * 128 + (size_t)(ATT_SPLIT_MAIN + ATT_SPLIT_PART * part) * 64 * 128 + kvh * 64;
            ATTN_CALL(64, Q + qrow * 512 + head * 64, K + koff, V + koff, (abf*)(PO + ((size_t)su * 3 + part) * 256 * 64), ATT_SPLIT_PART, (char*)F.lds_g, PL + ((size_t)su * 4 + 1 + part) * 256);
        }
        if (layer == 0) {
            for (int U = F.vcu; U < 16; U += F.G) {
                const int b = U >> 3, head = U & 7, kvh = head >> 2; const size_t qrow = (size_t)NLAT + (size_t)b * CTXL;
                ATTN_CALL(1024, Q + qrow * 512 + head * 64, K + (size_t)b * KVROWS * 128 + kvh * 64, V + (size_t)b * KVROWS * 128 + kvh * 64, MIX + qrow * 1024 + 512 + head * 64, 4, (char*)F.lds_g, nullptr);
            }
        }
    }
}

__device__ __forceinline__ void run_layer(Frame& F, const Args& A, const XcdBarrier& bar, const int layer, const int lo, const int hi) {
#define RUN(p) (lo <= (p) && (p) < hi)
#define SEAM(p) do { if (RUN(p) && RUN((p) + 1)) { xcd_barrier(bar); } } while (0)
        const int pb = 1 + 10 * layer;
        if (EN(1) && RUN(pb + 0)) for (int rep = 0; rep < REPS(1); ++rep) { phase_norm1(F, A, layer, rep + 1 < REPS(1)); __syncthreads(); }
        SEAM(pb + 0);
        if (EN(2) && RUN(pb + 1)) for (int rep = 0; rep < REPS(2); ++rep) {
            pg8::Gemm g{wsp<bf16>(F, WS_H), wsp<bf16>(F, WS_WIN) + (size_t)layer * PNW * 1024, NTOK, PNW, 1024, nullptr};
            pg8::StaticOrder S; S.init(NTOK, PNW, F.G, (int)blockIdx.x);
            pg8::EpiInProj E{wsp<bf16>(F, WS_P), PN, wsp<float>(F, WS_AB)};
            pg8::gemm_phase<pg8::EpiInProj, pg8::StaticOrder, true, true>(F.lds, g, S, E);
            { const int nu = (NTOK / 256) * (PNW / 256); const int idle = max_units(nu, F.G) - my_units(nu, F.G, (int)blockIdx.x); if (idle > 0) convert_pull(F, A, 2 * idle, 0, 1); }
        }
        SEAM(pb + 1);
        if (RUN(pb + 2)) { if (EN(3)) for (int rep = 0; rep < REPS(3); ++rep) phase_attn_prep(F, A, layer); if (EN(4)) for (int rep = 0; rep < REPS(4); ++rep) phase_conformer(F, A, layer); __syncthreads(); if (EN(5)) for (int rep = 0; rep < REPS(5); ++rep) phase_gdn_prep(F, A, layer); }
        SEAM(pb + 2);
        if (RUN(pb + 3)) phase_mixers(F, A, layer);
        SEAM(pb + 3);
        if (EN(9) && RUN(pb + 4)) { phase_attn_merge(F); for (int rep = 0; rep < REPS(9); ++rep) phase_gdn_out(F, A, layer); }
        SEAM(pb + 4);
        if (EN(10) && RUN(pb + 5)) for (int rep = 0; rep < (layer == 0 ? REPS(10) : 1); ++rep) {
            const int M = layer == 0 ? NTOK : NLAT;
            pg8::Gemm g{wsp<bf16>(F, WS_H), wsp<bf16>(F, WS_WOUT) + (size_t)layer * 1024 * 1024, M, 1024, 1024, nullptr};
            pg8::StaticOrder S; S.init(M, 1024, F.G, (int)blockIdx.x);
            bf16* xb0 = (bf16*)F.out; bf16* xcb = wsp<bf16>(F, WS_XCTX); bf16* xb1 = wsp<bf16>(F, WS_P);
            if (layer == 0) { pg8::EpiResid<true> E{A.in[0], A.in[2], xb0, xcb, wsp<float>(F, WS_MOD) + 2048};
                pg8::gemm_phase<pg8::EpiResid<true>, pg8::StaticOrder, true, true>(F.lds, g, S, E); }
            else { pg8::EpiResid<false> E{xb0, xcb, xb1, xcb, wsp<float>(F, WS_MOD) + 3 * 6144 + 2048};
                pg8::gemm_phase<pg8::EpiResid<false>, pg8::StaticOrder, true, true>(F.lds, g, S, E); }
            { const int nu = (M / 256) * 4; const int idle = max_units(nu, F.G) - my_units(nu, F.G, (int)blockIdx.x); if (idle > 0) convert_pull(F, A, 3 * idle, 0, 1); }
        }
        SEAM(pb + 5);
        if (EN(11) && RUN(pb + 6)) for (int rep = 0; rep < REPS(11); ++rep) { phase_route(F, A, layer, rep + 1 < REPS(11)); __syncthreads(); }
        SEAM(pb + 6);
        if (EN(12) && RUN(pb + 7)) { phase_slots(F, A, layer); __syncthreads(); convert_pull(F, A, CONV_CHUNKS, layer, layer); }
        SEAM(pb + 7);
        if (EN(13) && RUN(pb + 8)) for (int rep = 0; rep < REPS(13); ++rep) {
            const int* ctl = wsp<int>(F, WS_CTL);
            const int nt = __builtin_amdgcn_readfirstlane(__hip_atomic_load(ctl + CW_NT + layer, __ATOMIC_RELAXED, __HIP_MEMORY_SCOPE_AGENT));
            pg8::Gemm g{wsp<bf16>(F, WS_H), wsp<bf16>(F, WS_WGU) + (size_t)layer * 32 * 1024 * 1024, NSLOT_MAX, 32 * 1024, 1024, wsp<int>(F, WS_STOK)};
            pg8::MoeOrder S{ctl + CW_TE + layer * 256, nt, F.G, F.vcu};
            pg8::EpiSwiGLU E{wsp<bf16>(F, WS_OG), 512};
            pg8::gemm_phase<pg8::EpiSwiGLU, pg8::MoeOrder, true, true, true>(F.lds, g, S, E);
            { const int idle = max_units(nt * 4, F.G) - my_units(nt * 4, F.G, F.vcu); if (idle > 0) convert_pull(F, A, 2 * idle, 0, 1); }
        }
        SEAM(pb + 8);
        if (EN(14) && RUN(pb + 9)) for (int rep = 0; rep < REPS(14); ++rep) {
            const int* ctl = wsp<int>(F, WS_CTL);
            const int nt = __builtin_amdgcn_readfirstlane(__hip_atomic_load(ctl + CW_NT + layer, __ATOMIC_RELAXED, __HIP_MEMORY_SCOPE_AGENT));
            pg8::Gemm g{wsp<bf16>(F, WS_OG), wsp<bf16>(F, WS_WD) + (size_t)layer * 32 * 1024 * 512, NSLOT_MAX, 32 * 1024, 512, nullptr};
            pg8::MoeOrder S{ctl + CW_TE + layer * 256, nt, F.G, F.vcu};
            pg8::EpiBf16<false> E{wsp<bf16>(F, WS_GDN), 1024, nullptr};
            pg8::gemm_phase<pg8::EpiBf16<false>, pg8::MoeOrder, true, true>(F.lds, g, S, E);
            { const int idle = max_units(nt * 4, F.G) - my_units(nt * 4, F.G, F.vcu); if (idle > 0) convert_pull(F, A, idle, 0, 1); }
        }
        SEAM(pb + 9);
#undef RUN
#undef SEAM
}

__global__ void __launch_bounds__(NTHR, 2) mk_fwd(const Args A) {
    extern __shared__ __attribute__((aligned(16))) unsigned char lds[];
    Frame F;
    F.lds = (LAS unsigned char*)lds; F.lds_g = lds;
    F.tid = threadIdx.x; F.lane = F.tid & 63; F.wave = __builtin_amdgcn_readfirstlane(F.tid >> 6);
    F.G = gridDim.x; { const int bx = blockIdx.x; F.vcu = (F.G % 8 == 0) ? (bx % 8) * (F.G / 8) + bx / 8 : bx; }
    F.gw = blockIdx.x * NWAVES + F.wave; F.NGW = F.G * NWAVES;
    F.out = A.out; F.ws = A.ws;
    const int lo = A.ph_lo, hi = A.ph_hi;
    for (int u = F.tid; u < (LDS_BYTES - RING_BYTES) / 4; u += NTHR) ((LAS unsigned*)(F.lds + RING_BYTES))[u] = 0u;
    __syncthreads();
    XcdBarrier bar = xcd_barrier_post((unsigned*)(F.ws + WS_CTL) + CW_BAR, (volatile XLAS unsigned*)(F.lds + MISC_OFF + 32));
#define RUN(p) (lo <= (p) && (p) < hi)
#define SEAM(p) do { if (RUN(p) && RUN((p) + 1)) { xcd_barrier(bar); } } while (0)
    if (hi > N_PHASES + 1) cg::this_grid().sync();

    if (EN(0) && RUN(0)) for (int rep = 0; rep < REPS(0); ++rep) { p0_prologue(F, A); __syncthreads(); }
    SEAM(0);
    run_layer(F, A, bar, 0, lo, hi);
    run_layer(F, A, bar, 1, lo, hi);
    for (int xb_ = 0; xb_ < MK_EXTRA_BARRIERS; ++xb_) xcd_barrier(bar);
    if (EN(15) && RUN(21)) for (int rep = 0; rep < REPS(15); ++rep) phase_final(F, A, rep + 1 < REPS(15));
#undef RUN
#undef SEAM
}

extern "C" void kernel_launch(void* const* d_in, const int* in_sizes, int n_in, void* d_out, int out_size, void* d_ws, size_t ws_size, hipStream_t stream) {
    static int grid = 0;
    if (grid == 0) {
        if (n_in != 30 || out_size != NLAT * DM || ws_size < WS_END) { fprintf(stderr, "kernel_launch: unexpected shapes: n_in %d out %d ws %zu (need %zu)\n", n_in, out_size, ws_size, (size_t)WS_END); grid = -1; return; }
        int dev = 0, cus = 0, per_cu = 0;
        hipGetDevice(&dev); hipDeviceGetAttribute(&cus, hipDeviceAttributeMultiprocessorCount, dev);
        if (hipFuncSetAttribute((const void*)mk_fwd, hipFuncAttributeMaxDynamicSharedMemorySize, LDS_BYTES) != hipSuccess) { fprintf(stderr, "kernel_launch: hipFuncSetAttribute failed\n"); grid = -1; return; }
        if (hipOccupancyMaxActiveBlocksPerMultiprocessor(&per_cu, (const void*)mk_fwd, NTHR, LDS_BYTES) != hipSuccess || per_cu < 1) { fprintf(stderr, "kernel_launch: occupancy query says %d blocks per CU\n", per_cu); (void)hipGetLastError(); per_cu = 1; }
        grid = cus;
        fprintf(stderr, "kernel_launch: %d CUs, occupancy %d per CU, grid %d\n", cus, per_cu, grid);
    }
    if (grid < 0) return;
    hipMemsetAsync((char*)d_ws + WS_CTL, 0, CTL_ZERO_BYTES, stream);
    Args a{};
    for (int i = 0; i < 30; ++i) a.in[i] = (const float*)d_in[i];
    a.out = (float*)d_out; a.ws = (unsigned char*)d_ws;
#if MK_MULTI
    for (int p = 0; p < N_PHASES; ++p) { a.ph_lo = p; a.ph_hi = p + 1; hipLaunchKernelGGL(mk_fwd, dim3(grid), dim3(NTHR), LDS_BYTES, stream, a); }
#else
    a.ph_lo = 0; a.ph_hi = N_PHASES;
    void* kargs[] = {&a};
    hipError_t e = hipLaunchCooperativeKernel((const void*)mk_fwd, dim3(grid), dim3(NTHR), kargs, LDS_BYTES, stream);
    if (e != hipSuccess) fprintf(stderr, "kernel_launch: cooperative launch failed: %s (grid %d)\n", hipGetErrorString(e), grid);
#endif
}
```
